# Optimizing an MI355X kernel written in HIP

```python
import functools
import jax, jax.numpy as jnp
from jax import lax
import numpy as np

D_MODEL = 1024
BATCH = 16
SEQ = 256
DEPTH = 1
DEC_BATCH = 2
DEC_SEQ = 4096
PAST_LEN = 256

GRID_W = 64
FOURIER_WIDTH = 512
FOURIER_GROUPS = 4
FOURIER_GROUP_DIM = FOURIER_WIDTH // FOURIER_GROUPS
RWKV_WIDTH = 1024
HEAD_DIM = 64
N_HEADS = RWKV_WIDTH // HEAD_DIM
DECAY_RANK = 64
AAA_RANK = 64
N_DIR = 2
N_BRANCH = 2
SHIFT_WIDTH = 3 * RWKV_WIDTH + DECAY_RANK + AAA_RANK
IN_WIDTH = 2 * FOURIER_WIDTH + SHIFT_WIDTH + RWKV_WIDTH + N_BRANCH * D_MODEL
RMS_EPS = 1e-6
GN_EPS = 64e-5

kernel_name = "hybrid_fnet_rwkv7_flow_step"


def _rmsnorm(x, g):
    xf = x.astype(jnp.float32)
    y = xf * lax.rsqrt(jnp.mean(xf * xf, axis=-1, keepdims=True) + RMS_EPS)
    return (y * g.astype(jnp.float32)).astype(x.dtype)


def _shift_context(u):
    B, T, C = u.shape
    v = u.reshape(B, T, C // 2, 2)
    prev = jnp.pad(v[:, :-1, :, 0], ((0, 0), (1, 0), (0, 0)))
    nxt = jnp.pad(v[:, 1:, :, 1], ((0, 0), (0, 1), (0, 0)))
    return jnp.stack([prev, nxt], axis=-1).reshape(B, T, C)


def _shift_grid(u, rows):
    B, T, C = u.shape
    v = u.reshape(B, rows, GRID_W, C // 4, 4)
    left = jnp.pad(v[:, :, :-1, :, 0], ((0, 0), (0, 0), (1, 0), (0, 0)))
    right = jnp.pad(v[:, :, 1:, :, 1], ((0, 0), (0, 0), (0, 1), (0, 0)))
    up = jnp.pad(v[:, :-1, :, :, 2], ((0, 0), (1, 0), (0, 0), (0, 0)))
    down = jnp.pad(v[:, 1:, :, :, 3], ((0, 0), (0, 1), (0, 0), (0, 0)))
    return jnp.stack([left, right, up, down], axis=-1).reshape(B, T, C)


def _fourier_mix(u):
    B, T, _ = u.shape
    ug = u.astype(jnp.float32).reshape(B, T, FOURIER_GROUPS, FOURIER_GROUP_DIM)
    f = jnp.fft.fftn(ug, axes=(1, 3), norm="ortho").real
    return f.reshape(B, T, FOURIER_WIDTH).astype(u.dtype)


def _rwkv7_scan(S0, r, w, k, v, a_vec, b_vec):
    def step(S, inp):
        r_t, w_t, k_t, v_t, a_t, b_t = inp
        sa = jnp.einsum('bhij,bhj->bhi', S, a_t)
        S = S * w_t[:, :, None, :] + sa[..., None] * b_t[:, :, None, :] + v_t[..., None] * k_t[:, :, None, :]
        y = jnp.einsum('bhij,bhj->bhi', S, r_t)
        return S, y
    xs = tuple(jnp.moveaxis(t, 1, 0) for t in (r, w, k, v, a_vec, b_vec))
    S_fin, ys = lax.scan(step, S0.astype(jnp.float32), xs)
    return S_fin, jnp.moveaxis(ys, 0, 1)


def _mixer(h, S0, shift_fn, w_in, mu_shift, w0, w_up, a0, a_up, k_k, k_a, r_k,
           lnx_g, lnx_b, w_proj_f, w_proj_r, w_out):
    B, T, _ = h.shape
    f32 = jnp.float32
    u = h @ w_in
    offs = [FOURIER_WIDTH, 2 * FOURIER_WIDTH, 2 * FOURIER_WIDTH + SHIFT_WIDTH,
            2 * FOURIER_WIDTH + SHIFT_WIDTH + RWKV_WIDTH]
    xf, gf, sh, gr, mg = jnp.split(u, offs, axis=-1)

    out_f = (_fourier_mix(xf) * jax.nn.silu(gf)) @ w_proj_f

    sh = sh + mu_shift * (shift_fn(sh) - sh)
    r, k, v, wd, ad = jnp.split(
        sh, [RWKV_WIDTH, 2 * RWKV_WIDTH, 3 * RWKV_WIDTH, 3 * RWKV_WIDTH + DECAY_RANK], axis=-1)
    heads = lambda t: t.astype(f32).reshape(t.shape[:-1] + (N_HEADS, HEAD_DIM))
    wl = (jnp.einsum('btr,zrc->zbtc', jnp.tanh(wd), w_up) + w0[:, None, None, :]).astype(f32)
    decay = heads(jnp.exp(-jnp.exp(-jax.nn.softplus(-wl) - 0.5)))
    a = heads(jax.nn.sigmoid(jnp.einsum('btr,zrc->zbtc', ad, a_up) + a0[:, None, None, :]))
    rh, kh, vh = heads(r), heads(k), heads(v)
    kk = heads(k * k_k)
    kk = kk / jnp.maximum(jnp.sqrt(jnp.sum(kk * kk, axis=-1, keepdims=True)), 1e-12)
    k_dir = kh[None] * (1.0 + (a - 1.0) * k_a.astype(f32).reshape(N_HEADS, HEAD_DIM))
    b_dir = kk[None] * a
    S_f, y_f = _rwkv7_scan(S0[:, 0], rh, decay[0], k_dir[0], vh, -kk, b_dir[0])
    flip = lambda t: jnp.flip(t, axis=1)
    S_b, y_b = _rwkv7_scan(S0[:, 1], flip(rh), flip(decay[1]), flip(k_dir[1]), flip(vh),
                           flip(-kk), flip(b_dir[1]))
    y = y_f + flip(y_b)
    mean = jnp.mean(y, axis=-1, keepdims=True)
    var = jnp.mean((y - mean) ** 2, axis=-1, keepdims=True)
    yn = ((y - mean) * lax.rsqrt(var + GN_EPS)).reshape(B, T, RWKV_WIDTH)
    yn = yn * lnx_g.astype(f32) + lnx_b.astype(f32)
    bonus = (jnp.sum(rh * kh * r_k.astype(f32), axis=-1, keepdims=True) * vh).reshape(B, T, RWKV_WIDTH)
    out_r = ((yn + bonus).astype(h.dtype) * jax.nn.silu(gr)) @ w_proj_r

    gates = jax.nn.sigmoid(mg.reshape(B, T, N_BRANCH, D_MODEL))
    merged = gates[..., 0, :] * out_f + gates[..., 1, :] * out_r
    return merged @ w_out, jnp.stack([S_f, S_b], axis=1)


def setup_inputs(seed: int = 0) -> dict:
    key = jax.random.key(seed)
    ks = jax.random.split(key, 24)
    nrm = lambda k, s, sc: jax.random.normal(k, s, jnp.float32) * sc
    D = D_MODEL
    return {
        "x_prompt": nrm(ks[0], (BATCH, SEQ, D), 1.0),
        "x_sample": nrm(ks[1], (DEC_BATCH, DEC_SEQ, D), 1.0),
        "state_rwkv": nrm(ks[2], (DEC_BATCH, DEPTH, N_DIR, N_HEADS, HEAD_DIM, HEAD_DIM), 0.3),
        "c": nrm(ks[3], (DEC_BATCH, D), 1.0),
        "c_ctx": nrm(ks[4], (D,), 1.0),
        "norm_g": 1.0 + nrm(ks[5], (DEPTH, D), 0.01),
        "w_ada": nrm(ks[6], (DEPTH, D, 3 * D), 0.5 * D ** -0.5),
        "b_ada": nrm(ks[7], (DEPTH, 3 * D), 0.01),
        "w_in": nrm(ks[8], (DEPTH, D, IN_WIDTH), D ** -0.5),
        "mu_shift": jax.random.uniform(ks[9], (DEPTH, SHIFT_WIDTH), jnp.float32),
        "w0": jax.random.uniform(ks[10], (DEPTH, N_DIR, RWKV_WIDTH), jnp.float32, -6.0, 1.0),
        "w_up": nrm(ks[11], (DEPTH, N_DIR, DECAY_RANK, RWKV_WIDTH), 0.1 * DECAY_RANK ** -0.5),
        "a0": nrm(ks[12], (DEPTH, N_DIR, RWKV_WIDTH), 0.5),
        "a_up": nrm(ks[13], (DEPTH, N_DIR, AAA_RANK, RWKV_WIDTH), 0.1 * AAA_RANK ** -0.5),
        "k_k": 0.85 + nrm(ks[14], (DEPTH, RWKV_WIDTH), 0.05),
        "k_a": 1.0 + nrm(ks[15], (DEPTH, RWKV_WIDTH), 0.05),
        "r_k": nrm(ks[16], (DEPTH, N_HEADS, HEAD_DIM), 0.1),
        "lnx_g": 1.0 + nrm(ks[17], (DEPTH, RWKV_WIDTH), 0.01),
        "lnx_b": nrm(ks[18], (DEPTH, RWKV_WIDTH), 0.01),
        "w_proj_f": nrm(ks[19], (DEPTH, FOURIER_WIDTH, D), FOURIER_WIDTH ** -0.5),
        "w_proj_r": nrm(ks[20], (DEPTH, RWKV_WIDTH, D), RWKV_WIDTH ** -0.5),
        "w_out": nrm(ks[21], (DEPTH, D, D), D ** -0.5),
        "final_g": 1.0 + nrm(ks[22], (D,), 0.01),
    }


def reference(x_prompt, x_sample, state_rwkv, c, c_ctx, norm_g, w_ada, b_ada, w_in, mu_shift,
              w0, w_up, a0, a_up, k_k, k_a, r_k, lnx_g, lnx_b, w_proj_f, w_proj_r, w_out, final_g):
    rows = x_sample.shape[1] // GRID_W
    grid_shift = functools.partial(_shift_grid, rows=rows)
    xp, xs = x_prompt, x_sample
    S_ctx0 = jnp.zeros((xp.shape[0], N_DIR, N_HEADS, HEAD_DIM, HEAD_DIM), jnp.float32)
    new_states = []
    for l in range(DEPTH):
        params = (w_in[l], mu_shift[l], w0[l], w_up[l], a0[l], a_up[l], k_k[l], k_a[l], r_k[l],
                  lnx_g[l], lnx_b[l], w_proj_f[l], w_proj_r[l], w_out[l])
        m_ctx = jax.nn.silu(c_ctx) @ w_ada[l] + b_ada[l]
        sft, scl, gte = jnp.split(m_ctx, 3, axis=-1)
        hp = _rmsnorm(xp, norm_g[l]) * (1.0 + scl) + sft
        op, S_ctx = _mixer(hp, S_ctx0, _shift_context, *params)
        xp = xp + gte * op
        new_states.append(S_ctx)
        m_lat = jax.nn.silu(c) @ w_ada[l] + b_ada[l]
        sft_s, scl_s, gte_s = jnp.split(m_lat[:, None, :], 3, axis=-1)
        hs = _rmsnorm(xs, norm_g[l]) * (1.0 + scl_s) + sft_s
        os_, _ = _mixer(hs, state_rwkv[:, l], grid_shift, *params)
        xs = xs + gte_s * os_
    y_prompt = _rmsnorm(xp, final_g)
    y_sample = _rmsnorm(xs, final_g)
    new_state_rwkv = jnp.stack(new_states, axis=1)
    return (y_prompt, y_sample, new_state_rwkv)
```

```cpp
#include <hip/hip_runtime.h>
#include <hip/hip_cooperative_groups.h>
#include <cstdio>
namespace cg = cooperative_groups;

#ifndef MULTI_LAUNCH
#define MULTI_LAUNCH 0
#endif

#define LAS __attribute__((address_space(3)))
typedef unsigned short bf16_t;
typedef short bf16x8 __attribute__((ext_vector_type(8)));
typedef float f32x4 __attribute__((ext_vector_type(4)));
typedef unsigned u32x4 __attribute__((ext_vector_type(4)));
typedef unsigned u32x2 __attribute__((ext_vector_type(2)));

constexpr int DM = 1024, NTOK_C = 4096, NTOK_L = 8192, NTOK = 12288;
constexpr int LDU = 7424;
constexpr int C_XF = 0, C_GF = 512, C_SH = 1024, C_GR = 4224, C_MG = 5248;
constexpr int C_MERGED = 1024;
constexpr float RMS_EPS = 1e-6f, GN_EPS = 64e-5f;
constexpr int NPH = 11;
constexpr int LDS_BYTES = 151040;

constexpr size_t WS_WINT = 0;
constexpr size_t WS_WPF  = WS_WINT + (size_t)7424 * 1024 * 2;
constexpr size_t WS_WPR  = WS_WPF + (size_t)1024 * 512 * 2;
constexpr size_t WS_WOUT = WS_WPR + (size_t)1024 * 1024 * 2;
constexpr size_t WS_MODP = WS_WOUT + (size_t)1024 * 1024 * 2;
constexpr size_t WS_MODF = WS_MODP + (size_t)16 * 3 * 3072 * 4;
constexpr size_t WS_TAB  = WS_MODF + (size_t)3 * 3072 * 4;
constexpr size_t WS_WUPT = WS_TAB + 131072;
constexpr size_t WS_AUPT = WS_WUPT + 262144;
constexpr size_t WS_H    = WS_AUPT + 262144;
constexpr size_t WS_U    = WS_H + (size_t)NTOK * 1024 * 2;
constexpr size_t WS_RLAT = WS_U + (size_t)NTOK * LDU * 2;
constexpr size_t WS_BAR  = WS_RLAT + (size_t)1024 * 64 * 128 * 2;
constexpr size_t WS_MIX  = WS_BAR + 16384;
constexpr size_t WS_ZB   = WS_MIX + (size_t)NTOK * 128 * 2;
constexpr size_t WS_SAB  = WS_ZB + (size_t)64 * 2048 * 64 * 2;
constexpr size_t WS_END  = WS_SAB + (size_t)64 * 64 * 64 * 2;
static_assert(WS_END <= (size_t)256 * 1024 * 1024, "workspace map exceeds the guaranteed 256 MiB");
constexpr int LDS_XB = 150528;
constexpr int T_W128 = 0, T_WB64 = 32768, T_WC64 = 49152, T_WB16 = 57344, T_WC16 = 58368, T_END = 58880;
constexpr size_t YF_OFF = 0, BON_OFF = (size_t)NTOK * DM;
constexpr size_t QLAT_ELEMS = (size_t)1024 * 64 * 128;

struct Args { const float* in[23]; float* out; unsigned char* ws; int ph_lo, ph_hi; };

__device__ __forceinline__ unsigned f2bf(float f) { unsigned u = __float_as_uint(f); u += 0x7FFFu + ((u >> 16) & 1u); return u >> 16; }
typedef __bf16 bf16x2_t __attribute__((ext_vector_type(2)));
typedef float f32x2_t __attribute__((ext_vector_type(2)));
__device__ __forceinline__ unsigned pk2(float lo, float hi) { f32x2_t v = {lo, hi}; bf16x2_t b = __builtin_convertvector(v, bf16x2_t); return __builtin_bit_cast(unsigned, b); }
__device__ __forceinline__ float bf2f(unsigned b) { return __uint_as_float(b << 16); }
__device__ __forceinline__ float bflo(unsigned w) { return __uint_as_float(w << 16); }
__device__ __forceinline__ float bfhi(unsigned w) { return __uint_as_float(w & 0xffff0000u); }
__device__ __forceinline__ float wave_sum(float v) {
#pragma unroll
    for (int o = 1; o < 64; o <<= 1) v += __shfl_xor(v, o);
    return v;
}
__device__ __forceinline__ float sigmoidf_(float x) { return __builtin_amdgcn_rcpf(1.0f + __expf(-x)); }
__device__ __forceinline__ float siluf_(float x) { return x * __builtin_amdgcn_rcpf(1.0f + __expf(-x)); }
#define LDS_WAIT() asm volatile("s_waitcnt lgkmcnt(0)" ::: "memory")

namespace pg8 {
constexpr int BM = 256, BK = 64, HALF = 128, HTB = HALF * BK * 2, STAGE_BYTES = 8 * HTB, NXCD = 8, WGM = 8;
__device__ __forceinline__ int lds_byte(int r, int c) { const int st = (r >> 4) * 2 + (c >> 5), rr = r & 15, cc = c & 31, ob = rr * 64 + cc * 2; return st * 1024 + (ob ^ (((ob >> 9) & 1) << 5)); }
__device__ __forceinline__ void stage_rc(int b, int& R, int& C) { const int st = b / 1024, sb = b % 1024, swz = sb ^ (((sb >> 9) & 1) << 5); R = (st >> 1) * 16 + swz / 64; C = (st & 1) * 32 + (swz % 64) / 2; }
__device__ __forceinline__ int perm32(int rho) { const int n = rho >> 4, i = rho & 15; return 8 * (i >> 2) + 4 * n + (i & 3); }
struct Unit { int pm, pn; };
struct Gemm { const bf16_t* A; const bf16_t* Bt; int M, N, K, lda, ldb; };
struct StaticOrder {
    int nM, nN, nwg, G, c;
    __device__ __forceinline__ void init(int M, int N, int G_, int c_) { nM = M / BM; nN = N / BM; nwg = nM * nN; G = G_; c = c_; }
    __device__ __forceinline__ bool next(int i, Unit& u) const {
        const long L = (long)i * G + c; if (L >= nwg) return false;
        int wgid = (int)L; { const int q = nwg / NXCD, r = nwg % NXCD, xcd = wgid % NXCD, off = wgid / NXCD; wgid = (xcd < r ? xcd * (q + 1) : r * (q + 1) + (xcd - r) * q) + off; }
        const int nig = WGM * nN, gid = wgid / nig, fm = gid * WGM, gsz = (nM - fm) < WGM ? (nM - fm) : WGM;
        u.pm = fm + ((wgid % nig) % gsz); u.pn = (wgid % nig) / gsz; return true;
    }
};

template <class Epi>
__device__ __forceinline__ void gemm_phase(LAS unsigned char* lds, const Gemm g, const StaticOrder& S, const Epi& E) {
    int tid_ = threadIdx.x; asm volatile("" : "+v"(tid_));
    const int tid = tid_, wid = __builtin_amdgcn_readfirstlane(tid >> 6), lane = tid & 63, wr = wid >> 2, wc = wid & 3, fr = lane & 15, fq = lane >> 4;
    const int K = g.K, nt = K / BK;
    unsigned voffA[2], voffB[2];
#pragma unroll
    for (int i = 0; i < 2; ++i) { int R, C; stage_rc(tid * 16 + i * 8192, R, C); const int Rb = Epi::PERM ? ((R & ~31) + perm32(R & 31)) : R;
        voffA[i] = (unsigned)(R * g.lda + C) * 2u; voffB[i] = (unsigned)(Rb * g.ldb + C) * 2u; }
    const size_t kstep = (size_t)(BK * 2);
    const size_t hstepA = (size_t)HALF * g.lda * 2, hstepB = (size_t)HALF * g.ldb * 2;
    const size_t tstepA = 2 * hstepA, tstepB = 2 * hstepB;
    const unsigned ldsw = (unsigned)wid * 1024u;
    const int aoff = lds_byte(wr * 64 + fr, fq * 8), boff = lds_byte(wc * 32 + fr, fq * 8);
#define PG8_SA(b, h) (((b) * 2 + (h)) * HTB)
#define PG8_SB(b, h) ((4 + (b) * 2 + (h)) * HTB)
#define PG8_STAGE(bufoff, gbase, voff) do { _Pragma("unroll") for (int _i = 0; _i < 2; ++_i) \
        __builtin_amdgcn_global_load_lds((const unsigned*)((const char*)(gbase) + (voff)[_i]), (LAS unsigned*)(lds + (bufoff) + ldsw + _i * 8192), 16, 0, 0); } while (0)
#define PG8_LDA(dst, b, h) do { _Pragma("unroll") for (int m = 0; m < 4; ++m) _Pragma("unroll") for (int k = 0; k < 2; ++k) dst[m][k] = *(const LAS bf16x8*)(lds + PG8_SA(b, h) + aoff + m * 2048 + k * 1024); } while (0)
#define PG8_LDB(dst, b, h) do { _Pragma("unroll") for (int n = 0; n < 2; ++n) _Pragma("unroll") for (int k = 0; k < 2; ++k) dst[n][k] = *(const LAS bf16x8*)(lds + PG8_SB(b, h) + boff + n * 2048 + k * 1024); } while (0)
#define PG8_MMA(ai, bj, At, Bt) do { __builtin_amdgcn_s_setprio(1); _Pragma("unroll") for (int m = 0; m < 4; ++m) _Pragma("unroll") for (int n = 0; n < 2; ++n) _Pragma("unroll") for (int k = 0; k < 2; ++k) \
        acc[ai][bj][m][n] = __builtin_amdgcn_mfma_f32_16x16x32_bf16(Bt[n][k], At[m][k], acc[ai][bj][m][n], 0, 0, 0); __builtin_amdgcn_s_setprio(0); } while (0)
#define PG8_WAIT_V(n) asm volatile("s_waitcnt vmcnt(" #n ")" ::: "memory")
#define PG8_WAIT_L(n) asm volatile("s_waitcnt lgkmcnt(" #n ")" ::: "memory")
#define PG8_BAR __builtin_amdgcn_s_barrier()
#define PG8_SCHED __builtin_amdgcn_sched_barrier(0)
    Unit cur, nxt; int ui = 0;
    if (!S.next(0, cur)) return;
    f32x4 acc[2][2][4][2];
#pragma unroll
    for (int a = 0; a < 2; ++a)
#pragma unroll
        for (int b = 0; b < 2; ++b)
#pragma unroll
            for (int m = 0; m < 4; ++m)
#pragma unroll
                for (int n = 0; n < 2; ++n) acc[a][b][m][n] = (f32x4){0.f, 0.f, 0.f, 0.f};
    bf16x8 At[4][2], B0[2][2], B1[2][2];
    const char* cA = (const char*)g.A + (size_t)cur.pm * tstepA; const char* cB = (const char*)g.Bt + (size_t)cur.pn * tstepB;
    PG8_STAGE(PG8_SB(0, 0), cB, voffB); PG8_STAGE(PG8_SA(0, 0), cA, voffA); PG8_STAGE(PG8_SB(0, 1), cB + hstepB, voffB); PG8_STAGE(PG8_SA(0, 1), cA + hstepA, voffA);
    if (wr == 1) PG8_BAR;
    PG8_WAIT_V(4); PG8_BAR;
    PG8_STAGE(PG8_SB(1, 0), cB + kstep, voffB); PG8_STAGE(PG8_SA(1, 0), cA + kstep, voffA); PG8_STAGE(PG8_SB(1, 1), cB + hstepB + kstep, voffB);
    PG8_WAIT_V(6); PG8_BAR;
    for (;;) {
        const bool has_next = S.next(ui + 1, nxt);
        const char* nA = has_next ? (const char*)g.A + (size_t)nxt.pm * tstepA : cA; const char* nB = has_next ? (const char*)g.Bt + (size_t)nxt.pn * tstepB : cB;
        for (int t = 0; t < nt; t += 2) {
            const bool last = (t == nt - 2);
            const char* a1 = cA + (size_t)(t + 1) * kstep;
            const char* a2 = last ? nA : cA + (size_t)(t + 2) * kstep; const char* b2 = last ? nB : cB + (size_t)(t + 2) * kstep;
            const char* a3 = a2 + kstep; const char* b3 = b2 + kstep;
            PG8_LDB(B0, 0, 0); PG8_SCHED; PG8_LDA(At, 0, 0); PG8_STAGE(PG8_SA(1, 1), a1 + hstepA, voffA);
            PG8_WAIT_L(8); PG8_BAR; PG8_WAIT_L(0); PG8_MMA(0, 0, At, B0); PG8_BAR; PG8_SCHED;
            PG8_LDB(B1, 0, 1); PG8_STAGE(PG8_SB(0, 0), b2, voffB);
            PG8_BAR; PG8_WAIT_L(0); PG8_MMA(0, 1, At, B1); PG8_BAR;
            PG8_LDA(At, 0, 1); PG8_STAGE(PG8_SA(0, 0), a2, voffA);
            PG8_BAR; PG8_WAIT_L(0); PG8_MMA(1, 0, At, B0); PG8_BAR; PG8_SCHED;
            PG8_STAGE(PG8_SB(0, 1), b2 + hstepB, voffB);
            PG8_WAIT_V(6); PG8_BAR; PG8_MMA(1, 1, At, B1); PG8_BAR;
            PG8_LDB(B0, 1, 0); PG8_SCHED; PG8_LDA(At, 1, 0); PG8_STAGE(PG8_SA(0, 1), a2 + hstepA, voffA);
            PG8_WAIT_L(8); PG8_BAR; PG8_WAIT_L(0); PG8_MMA(0, 0, At, B0); PG8_BAR; PG8_SCHED;
            PG8_LDB(B1, 1, 1); PG8_STAGE(PG8_SB(1, 0), b3, voffB);
            PG8_BAR; PG8_WAIT_L(0); PG8_MMA(0, 1, At, B1); PG8_BAR;
            PG8_LDA(At, 1, 1); PG8_STAGE(PG8_SA(1, 0), a3, voffA);
            PG8_BAR; PG8_WAIT_L(0); PG8_MMA(1, 0, At, B0); PG8_BAR; PG8_SCHED;
            PG8_STAGE(PG8_SB(1, 1), b3 + hstepB, voffB);
            PG8_WAIT_V(6); PG8_BAR; PG8_MMA(1, 1, At, B1); PG8_BAR;
        }
        E(acc, cur, wr, wc, fr, fq);
        if (!has_next) break;
#pragma unroll
        for (int a = 0; a < 2; ++a)
#pragma unroll
            for (int b = 0; b < 2; ++b)
#pragma unroll
                for (int m = 0; m < 4; ++m)
#pragma unroll
                    for (int n = 0; n < 2; ++n) acc[a][b][m][n] = (f32x4){0.f, 0.f, 0.f, 0.f};
        cur = nxt; cA = nA; cB = nB; ++ui;
    }
    PG8_WAIT_V(0);
    if (wr == 0) PG8_BAR;
    PG8_BAR;
#undef PG8_SA
#undef PG8_SB
#undef PG8_STAGE
#undef PG8_LDA
#undef PG8_LDB
#undef PG8_MMA
#undef PG8_WAIT_V
#undef PG8_WAIT_L
#undef PG8_BAR
#undef PG8_SCHED
}
}
using pg8::Unit;

struct Epi1 {
    static constexpr bool PERM = true;
    bf16_t* U;
    __device__ __forceinline__ void operator()(const f32x4 (&acc)[2][2][4][2], const Unit& u, int wr, int wc, int fr, int fq) const {
        const int row0 = u.pm * 256 + wr * 64 + fr, col0 = u.pn * 256 + wc * 32 + 8 * fq;
#pragma unroll
        for (int bj = 0; bj < 2; ++bj) {
            const int c = col0 + bj * 128;
            const int act = (c < C_GF) ? 0 : (c < C_SH) ? 1 : (c < C_GR) ? 0 : (c < C_MG) ? 1 : 2;
#pragma unroll
            for (int ai = 0; ai < 2; ++ai)
#pragma unroll
                for (int m = 0; m < 4; ++m) {
                    f32x4 v0 = acc[ai][bj][m][0], v1 = acc[ai][bj][m][1];
                    if (act == 1) {
#pragma unroll
                        for (int j = 0; j < 4; ++j) { v0[j] = siluf_(v0[j]); v1[j] = siluf_(v1[j]); }
                    } else if (act == 2) {
#pragma unroll
                        for (int j = 0; j < 4; ++j) { v0[j] = sigmoidf_(v0[j]); v1[j] = sigmoidf_(v1[j]); }
                    }
                    u32x4 w; w.x = pk2(v0[0], v0[1]); w.y = pk2(v0[2], v0[3]); w.z = pk2(v1[0], v1[1]); w.w = pk2(v1[2], v1[3]);
                    *(u32x4*)(U + (size_t)(row0 + ai * 128 + m * 16) * LDU + c) = w;
                }
        }
    }
};
template <int second> struct Epi2 {
    static constexpr bool PERM = true;
    bf16_t* U;
    __device__ __forceinline__ void operator()(const f32x4 (&acc)[2][2][4][2], const Unit& u, int wr, int wc, int fr, int fq) const {
        const int row0 = u.pm * 256 + wr * 64 + fr, col0 = u.pn * 256 + wc * 32 + 8 * fq;
#pragma unroll
        for (int bj = 0; bj < 2; ++bj) {
            const int c = col0 + bj * 128;
#pragma unroll
            for (int ai = 0; ai < 2; ++ai)
#pragma unroll
                for (int m = 0; m < 4; ++m) {
                    bf16_t* rowp = U + (size_t)(row0 + ai * 128 + m * 16) * LDU;
                    const u32x4 gw = *(const u32x4*)(rowp + C_MG + (second ? 1024 : 0) + c);
                    const f32x4 v0 = acc[ai][bj][m][0], v1 = acc[ai][bj][m][1];
                    float o[8];
                    o[0] = v0[0] * bflo(gw.x); o[1] = v0[1] * bfhi(gw.x); o[2] = v0[2] * bflo(gw.y); o[3] = v0[3] * bfhi(gw.y);
                    o[4] = v1[0] * bflo(gw.z); o[5] = v1[1] * bfhi(gw.z); o[6] = v1[2] * bflo(gw.w); o[7] = v1[3] * bfhi(gw.w);
                    if (second) {
                        const u32x4 pw = *(const u32x4*)(rowp + C_MERGED + c);
                        o[0] += bflo(pw.x); o[1] += bfhi(pw.x); o[2] += bflo(pw.y); o[3] += bfhi(pw.y);
                        o[4] += bflo(pw.z); o[5] += bfhi(pw.z); o[6] += bflo(pw.w); o[7] += bfhi(pw.w);
                    }
                    u32x4 w; w.x = pk2(o[0], o[1]); w.y = pk2(o[2], o[3]); w.z = pk2(o[4], o[5]); w.w = pk2(o[6], o[7]);
                    *(u32x4*)(rowp + C_MERGED + c) = w;
                    asm volatile("" ::: "memory");
                }
        }
    }
};
struct Epi3 {
    static constexpr bool PERM = false;
    const float* xp; const float* xs; const float* modf; float* out;
    __device__ __forceinline__ void operator()(const f32x4 (&acc)[2][2][4][2], const Unit& u, int wr, int wc, int fr, int fq) const {
        const int row0 = u.pm * 256 + wr * 64 + fr, col0 = u.pn * 256 + wc * 32 + 4 * fq;
#pragma unroll
        for (int ai = 0; ai < 2; ++ai)
#pragma unroll
            for (int m = 0; m < 4; ++m) {
                const int row = row0 + ai * 128 + m * 16;
                const int set = row < NTOK_C ? 0 : 1 + ((row - NTOK_C) >> 12);
                const float* xr = row < NTOK_C ? xp + (size_t)row * DM : xs + (size_t)(row - NTOK_C) * DM;
                const float* gt = modf + set * 3072 + 2048;
#pragma unroll
                for (int bj = 0; bj < 2; ++bj)
#pragma unroll
                    for (int n = 0; n < 2; ++n) {
                        const int c = col0 + bj * 128 + n * 16;
                        const f32x4 xv = *(const f32x4*)(xr + c), gv = *(const f32x4*)(gt + c);
                        *(f32x4*)(out + (size_t)row * DM + c) = xv + gv * acc[ai][bj][m][n];
                    }
            }
    }
};

template <int MT, int NT, int KS, int UNR = 1>
__device__ __forceinline__ void wave_mma(const bf16_t* const (&ap)[MT], const bf16_t* const (&bp)[NT], f32x4 (&acc)[MT][NT], int fq) {
#pragma unroll UNR
    for (int ks = 0; ks < KS; ++ks) {
        bf16x8 av[MT], bv[NT];
#pragma unroll
        for (int mi = 0; mi < MT; ++mi) av[mi] = *(const bf16x8*)(ap[mi] + ks * 32 + fq * 8);
#pragma unroll
        for (int ni = 0; ni < NT; ++ni) bv[ni] = *(const bf16x8*)(bp[ni] + ks * 32 + fq * 8);
#pragma unroll
        for (int mi = 0; mi < MT; ++mi)
#pragma unroll
            for (int ni = 0; ni < NT; ++ni) acc[mi][ni] = __builtin_amdgcn_mfma_f32_16x16x32_bf16(av[mi], bv[ni], acc[mi][ni], 0, 0, 0);
    }
}
template <int MT, int NT, int KS, int LDB, int UNR = 1>
__device__ __forceinline__ void wave_mma_lb(const bf16_t* const (&ap)[MT], const LAS bf16_t* bl, f32x4 (&acc)[MT][NT], int fr, int fq) {
#pragma unroll UNR
    for (int ks = 0; ks < KS; ++ks) {
        bf16x8 av[MT], bv[NT];
#pragma unroll
        for (int mi = 0; mi < MT; ++mi) av[mi] = *(const bf16x8*)(ap[mi] + ks * 32 + fq * 8);
#pragma unroll
        for (int ni = 0; ni < NT; ++ni) bv[ni] = *(const LAS bf16x8*)(bl + (16 * ni + fr) * LDB + ks * 32 + fq * 8);
#pragma unroll
        for (int mi = 0; mi < MT; ++mi)
#pragma unroll
            for (int ni = 0; ni < NT; ++ni) acc[mi][ni] = __builtin_amdgcn_mfma_f32_16x16x32_bf16(av[mi], bv[ni], acc[mi][ni], 0, 0, 0);
    }
}
template <int LDB>
__device__ __forceinline__ void stage_table(LAS bf16_t* dst, const bf16_t* src, int rows, int cols) {
    const int per = cols / 8;
    for (int i = threadIdx.x; i < rows * per; i += 512) { const int r = i / per, c8 = i % per; *(LAS u32x4*)(dst + r * LDB + c8 * 8) = *(const u32x4*)(src + (size_t)r * cols + c8 * 8); }
}
__device__ __forceinline__ void st4l(LAS bf16_t* p, const f32x4 v) { u32x2 w; w.x = pk2(v[0], v[1]); w.y = pk2(v[2], v[3]); *(LAS u32x2*)p = w; }
__device__ __forceinline__ void st4bf(bf16_t* p, const f32x4 v) { u32x2 w; w.x = pk2(v[0], v[1]); w.y = pk2(v[2], v[3]); *(u32x2*)p = w; }

struct Ctx {
    const Args& a; LAS unsigned char* lds; int tid, lane, wv, gw, ngw;
};

__device__ __forceinline__ void transpose_item(const float* W, int K, int N, bf16_t* WT, LAS float* scr, int item, int lane) {
    const int nblk = N / 32, kb = item / nblk, nb = item % nblk, k0 = 64 * kb, n0 = 32 * nb;
#pragma unroll 8
    for (int i = 0; i < 32; ++i) { const int kk = 2 * i + (lane >> 5); scr[kk * 33 + (lane & 31)] = W[(size_t)(k0 + kk) * N + n0 + (lane & 31)]; }
    LDS_WAIT();
    const int c = lane & 7;
#pragma unroll
    for (int j = 0; j < 4; ++j) { const int n = (lane >> 3) + 8 * j; const LAS float* s = scr + (8 * c) * 33 + n;
        u32x4 o; o.x = pk2(s[0 * 33], s[1 * 33]); o.y = pk2(s[2 * 33], s[3 * 33]); o.z = pk2(s[4 * 33], s[5 * 33]); o.w = pk2(s[6 * 33], s[7 * 33]);
        *(u32x4*)(WT + (size_t)(n0 + n) * K + k0 + 8 * c) = o; }
    LDS_WAIT();
}
__device__ __forceinline__ void phase0(const Args& a, LAS unsigned char* lds) {
    const int tid = threadIdx.x, lane = tid & 63, wv = tid >> 6, gw = blockIdx.x * 8 + wv, ngw = gridDim.x * 8;
    unsigned char* ws = a.ws;
    for (int cb = blockIdx.x; cb < 256; cb += gridDim.x) {
        LAS float* sv = (LAS float*)(lds + 8 * 8448);
        LAS float* pr = sv + 3072;
        __syncthreads();
        for (int i = tid; i < 3072; i += 512) { const int v = i >> 10, k = i & 1023; sv[i] = siluf_((v == 0) ? a.in[4][k] : a.in[3][(v - 1) * 1024 + k]); }
        __syncthreads();
        const int kk = tid >> 2, cq = tid & 3, col = cb * 12 + 3 * cq;
        float acc[3][3];
#pragma unroll
        for (int v = 0; v < 3; ++v)
#pragma unroll
            for (int j = 0; j < 3; ++j) acc[v][j] = 0.f;
#pragma unroll
        for (int i = 0; i < 8; ++i) {
            const int k = kk + 128 * i;
            const float* w = a.in[6] + (size_t)k * 3072 + col;
            const float w0 = w[0], w1 = w[1], w2 = w[2];
#pragma unroll
            for (int v = 0; v < 3; ++v) { const float sk = sv[v * 1024 + k]; acc[v][0] += sk * w0; acc[v][1] += sk * w1; acc[v][2] += sk * w2; }
        }
#pragma unroll
        for (int v = 0; v < 3; ++v)
#pragma unroll
            for (int j = 0; j < 3; ++j) { float x = acc[v][j]; x += __shfl_xor(x, 4); x += __shfl_xor(x, 8); x += __shfl_xor(x, 16); x += __shfl_xor(x, 32); acc[v][j] = x; }
        if (lane < 4) {
#pragma unroll
            for (int v = 0; v < 3; ++v)
#pragma unroll
                for (int j = 0; j < 3; ++j) pr[(wv * 4 + lane) * 9 + v * 3 + j] = acc[v][j];
        }
        __syncthreads();
        if (tid < 36) {
            const int q = tid / 9, r = tid % 9, v = r / 3, j = r % 3;
            float sum = 0.f;
#pragma unroll
            for (int w8 = 0; w8 < 8; ++w8) sum += pr[(w8 * 4 + q) * 9 + r];
            const int c = cb * 12 + 3 * q + j;
            ((float*)(ws + WS_MODF))[v * 3072 + c] = sum + a.in[7][c];
        }
    }
    __syncthreads();
}
__device__ __forceinline__ void phase0_conv(const Args& a, LAS unsigned char* lds) {
    const int tid = threadIdx.x, lane = tid & 63, wv = tid >> 6, gw = blockIdx.x * 8 + wv, ngw = gridDim.x * 8;
    unsigned char* ws = a.ws;
    LAS float* scr = (LAS float*)(lds + wv * 8448);
    for (int it = gw; it < 16 * 228; it += ngw) transpose_item(a.in[8], 1024, 7296, (bf16_t*)(ws + WS_WINT), scr, it, lane);
    u32x4* padp = (u32x4*)((bf16_t*)(ws + WS_WINT) + (size_t)7296 * 1024);
    for (int i = blockIdx.x * 512 + tid; i < 128 * 1024 / 8; i += gridDim.x * 512) padp[i] = (u32x4){0u, 0u, 0u, 0u};
}
__device__ __forceinline__ void conv_rest(const Args& a, LAS unsigned char* lds, int wb, int nwb) {
    const int tid = threadIdx.x, lane = tid & 63, wv = tid >> 6, gw = wb * 8 + wv, ngw = nwb * 8;
    unsigned char* ws = a.ws;
    {
        LAS float* scr = (LAS float*)(lds + wv * 8448);
        constexpr int I_PF = 8 * 32, I_PR = 16 * 32, I_OUT = 16 * 32;
        for (int it = gw; it < I_PF + I_PR + I_OUT; it += ngw) {
            int r = it;
            if (r < I_PF) { transpose_item(a.in[19], 512, 1024, (bf16_t*)(ws + WS_WPF), scr, r, lane); continue; } r -= I_PF;
            if (r < I_PR) { transpose_item(a.in[20], 1024, 1024, (bf16_t*)(ws + WS_WPR), scr, r, lane); continue; } r -= I_PR;
            transpose_item(a.in[21], 1024, 1024, (bf16_t*)(ws + WS_WOUT), scr, r, lane);
        }
    }
    {
        bf16_t* wt = (bf16_t*)(ws + WS_WUPT); bf16_t* at = (bf16_t*)(ws + WS_AUPT);
        for (int i = wb * 512 + tid; i < 2 * 1024 * 64; i += nwb * 512) {
            const int rk = i & 63, C = (i >> 6) & 1023, d = i >> 16;
            wt[i] = (bf16_t)f2bf(a.in[11][(size_t)(d * 64 + rk) * 1024 + C]);
            at[i] = (bf16_t)f2bf(a.in[13][(size_t)(d * 64 + rk) * 1024 + C]);
        }
    }
    {
        bf16_t* tab = (bf16_t*)(ws + WS_TAB);
        for (int i = wb * 512 + tid; i < T_END; i += nwb * 512) {
            float val;
            if (i < T_WB64) {
                const int n = i >> 7, c = i & 127, part = n >> 7, kc = n & 127, m = (kc * c) & 127;
                const float x = (float)m * (1.0f / 64.0f);
                val = part ? -sinpif(x) : cospif(x);
            } else if (i < T_WC64) {
                const int j = i - T_WB64, n = j >> 7, k = j & 127, pp = n >> 6, k1 = n & 63, p = k >> 6, t1 = k & 63, m = (k1 * t1) & 63;
                const float x = (float)m * (1.0f / 32.0f), cs = cospif(x), sn = sinpif(x);
                val = (pp == p) ? cs : (pp == 0 ? sn : -sn);
            } else if (i < T_WB16) {
                const int j = i - T_WC64, k2 = j >> 7, k = j & 127, p = k >> 6, t2 = k & 63, m = (k2 * t2) & 63;
                const float x = (float)m * (1.0f / 32.0f);
                val = p ? sinpif(x) : cospif(x);
            } else if (i < T_WC16) {
                const int j = i - T_WB16, n = j >> 5, k = j & 31, pp = n >> 4, k1 = n & 15, p = k >> 4, t1 = k & 15, m = (k1 * t1) & 15;
                const float x = (float)m * (1.0f / 8.0f), cs = cospif(x), sn = sinpif(x);
                val = (pp == p) ? cs : (pp == 0 ? sn : -sn);
            } else {
                const int j = i - T_WC16, k2 = j >> 5, k = j & 31, p = k >> 4, t2 = k & 15, m = (k2 * t2) & 15;
                const float x = (float)m * (1.0f / 8.0f);
                val = p ? sinpif(x) : cospif(x);
            }
            tab[i] = (bf16_t)f2bf(val);
        }
    }
}

__device__ __forceinline__ void phase1(const Args& a, LAS unsigned char* lds) {
    const int tid = threadIdx.x, lane = tid & 63, wv = tid >> 6, gw = blockIdx.x * 8 + wv, ngw = gridDim.x * 8;
    unsigned char* ws = a.ws;
    LAS float* ml = (LAS float*)lds;
    const float* mf = (const float*)(ws + WS_MODF);
    for (int i = tid; i < 9216; i += 512) ml[i] = mf[i];
    __syncthreads();
    bf16_t* H = (bf16_t*)(ws + WS_H);
    const float* ng = a.in[5];
    for (int row0 = gw; row0 < NTOK; row0 += 3 * ngw) {
        f32x4 v[3][4];
#pragma unroll
        for (int u = 0; u < 3; ++u) {
            const int row = row0 + u * ngw < NTOK ? row0 + u * ngw : row0;
            const float* xr = row < NTOK_C ? a.in[0] + (size_t)row * DM : a.in[1] + (size_t)(row - NTOK_C) * DM;
#pragma unroll
            for (int j = 0; j < 4; ++j) v[u][j] = *(const f32x4*)(xr + lane * 4 + 256 * j);
        }
#pragma unroll
        for (int u = 0; u < 3; ++u) {
            const int row = row0 + u * ngw;
            if (row < NTOK) {
                const int set = row < NTOK_C ? 0 : 1 + ((row - NTOK_C) >> 12);
                float ss = 0.f;
#pragma unroll
                for (int j = 0; j < 4; ++j) ss += (v[u][j][0] * v[u][j][0] + v[u][j][1] * v[u][j][1]) + (v[u][j][2] * v[u][j][2] + v[u][j][3] * v[u][j][3]);
                const float rstd = rsqrtf(wave_sum(ss) * (1.0f / DM) + RMS_EPS);
#pragma unroll
                for (int j = 0; j < 4; ++j) {
                    const int c = lane * 4 + 256 * j;
                    const f32x4 g4 = *(const f32x4*)(ng + c);
                    float o[4];
#pragma unroll
                    for (int e = 0; e < 4; ++e) o[e] = (v[u][j][e] * rstd * g4[e]) * (1.0f + ml[set * 3072 + 1024 + c + e]) + ml[set * 3072 + c + e];
                    u32x2 w; w.x = pk2(o[0], o[1]); w.y = pk2(o[2], o[3]);
                    *(u32x2*)(H + (size_t)row * DM + c) = w;
                }
            }
        }
    }
}

__device__ __forceinline__ void fourier_l1(const Args& a, LAS unsigned char* lds) {
    const int tid = threadIdx.x, lane = tid & 63, wv = tid >> 6, gw = blockIdx.x * 8 + wv, ngw = gridDim.x * 8, fr = lane & 15, fq = lane >> 4;
    unsigned char* ws = a.ws;
    const bf16_t* U = (const bf16_t*)(ws + WS_U);
    const bf16_t* W128 = (const bf16_t*)(ws + WS_TAB) + T_W128;
    bf16_t* Qlat = (bf16_t*)(ws + WS_H);
    bf16_t* Qctx = Qlat + QLAT_ELEMS;
    LAS bf16_t* Wl = (LAS bf16_t*)lds;
    __syncthreads(); stage_table<136>(Wl, W128, 256, 128); __syncthreads();
    for (int wt = gw; wt < 2048 + 1024; wt += ngw) {
        const bf16_t* ap[4]; f32x4 acc[4][4];
#pragma unroll
        for (int mi = 0; mi < 4; ++mi)
#pragma unroll
            for (int ni = 0; ni < 4; ++ni) acc[mi][ni] = (f32x4){0.f, 0.f, 0.f, 0.f};
        if (wt < 2048) {
            const int nb = wt & 3, t2 = (wt >> 2) & 63, bg = wt >> 8, b = bg >> 2, g = bg & 3;
#pragma unroll
            for (int mi = 0; mi < 4; ++mi) ap[mi] = U + (size_t)(NTOK_C + b * 4096 + 64 * (16 * mi + fr) + t2) * LDU + C_XF + g * 128;
            wave_mma_lb<4, 4, 4, 136, 2>(ap, Wl + (nb * 64) * 136, acc, fr, fq);
            LAS bf16_t* Tl = (LAS bf16_t*)(lds + 256 * 136 * 2) + wv * (64 * 72);
#pragma unroll
            for (int mi = 0; mi < 4; ++mi)
#pragma unroll
                for (int ni = 0; ni < 4; ++ni) st4l(Tl + (16 * ni + fr) * 72 + 16 * mi + 4 * fq, acc[mi][ni]);
            LDS_WAIT();
#pragma unroll
            for (int i = 0; i < 8; ++i) {
                const int pc = lane + 64 * i, cl = pc >> 3, ch = pc & 7, cn = nb * 64 + cl, part = cn >> 7, kc = cn & 127;
                *(u32x4*)(Qlat + ((((size_t)(bg * 128 + kc) * 64 + t2) * 2 + part) * 64 + 8 * ch)) = *(const LAS u32x4*)(Tl + cl * 72 + 8 * ch);
            }
            LDS_WAIT();
        } else {
            const int w2 = wt - 2048, nb = w2 & 3, tg = (w2 >> 2) & 3, bg = w2 >> 4, b = bg >> 2, g = bg & 3;
#pragma unroll
            for (int mi = 0; mi < 4; ++mi) ap[mi] = U + (size_t)(b * 256 + 16 * fr + (tg * 4 + mi)) * LDU + C_XF + g * 128;
            wave_mma_lb<4, 4, 4, 136, 2>(ap, Wl + (nb * 64) * 136, acc, fr, fq);
#pragma unroll
            for (int mi = 0; mi < 4; ++mi)
#pragma unroll
                for (int ni = 0; ni < 4; ++ni) {
                    const int cn = nb * 64 + 16 * ni + fr, part = cn >> 7, kc = cn & 127, t2 = tg * 4 + mi;
                    st4bf(Qctx + ((((size_t)(bg * 128 + kc) * 16 + t2) * 2 + part) * 16 + 4 * fq), acc[mi][ni]);
                }
        }
    }
}
__device__ __forceinline__ void fourier_l2(const Args& a, LAS unsigned char* lds) {
    const int tid = threadIdx.x, lane = tid & 63, wv = tid >> 6, gw = blockIdx.x * 8 + wv, ngw = gridDim.x * 8, fr = lane & 15, fq = lane >> 4;
    unsigned char* ws = a.ws;
    const bf16_t* tab = (const bf16_t*)(ws + WS_TAB);
    const bf16_t* Qlat = (const bf16_t*)(ws + WS_H);
    const bf16_t* Qctx = Qlat + QLAT_ELEMS;
    bf16_t* Rlat = (bf16_t*)(ws + WS_RLAT);
    bf16_t* Rctx = (bf16_t*)(ws + WS_WINT);
    LAS bf16_t* Bl64 = (LAS bf16_t*)lds;
    LAS bf16_t* Bl16 = Bl64 + 128 * 136;
    __syncthreads(); stage_table<136>(Bl64, tab + T_WB64, 128, 128); stage_table<40>(Bl16, tab + T_WB16, 32, 32); __syncthreads();
    for (int wt = gw; wt < 2048 + 2048; wt += ngw) {
        if (wt < 2048) {
            const int bgkc = wt >> 1, mh = wt & 1;
            const bf16_t* ap[2]; f32x4 acc[2][8];
#pragma unroll
            for (int mi = 0; mi < 2; ++mi)
#pragma unroll
                for (int ni = 0; ni < 8; ++ni) acc[mi][ni] = (f32x4){0.f, 0.f, 0.f, 0.f};
#pragma unroll
            for (int mi = 0; mi < 2; ++mi) ap[mi] = Qlat + ((size_t)bgkc * 64 + 32 * mh + 16 * mi + fr) * 128;
            wave_mma_lb<2, 8, 4, 136>(ap, Bl64, acc, fr, fq);
#pragma unroll
            for (int mi = 0; mi < 2; ++mi)
#pragma unroll
                for (int ni = 0; ni < 4; ++ni) {
                    const int k1 = 16 * ni + fr;
                    f32x4 orr, oi;
#pragma unroll
                    for (int r = 0; r < 4; ++r) {
                        const int t2 = 32 * mh + 16 * mi + 4 * fq + r, m = (t2 * k1) & 4095;
                        const float x = (float)m * (1.0f / 2048.0f), cs = cospif(x), sn = sinpif(x);
                        const float br = acc[mi][ni][r], bi = acc[mi][ni + 4][r];
                        orr[r] = br * cs + bi * sn; oi[r] = bi * cs - br * sn;
                    }
                    bf16_t* dst = Rlat + ((size_t)bgkc * 64 + k1) * 128 + 32 * mh + 16 * mi + 4 * fq;
                    st4bf(dst, orr); st4bf(dst + 64, oi);
                }
        } else {
            const int bgkc0 = (wt - 2048) * 4;
            const bf16_t* ap[4]; f32x4 acc[4][2];
#pragma unroll
            for (int mi = 0; mi < 4; ++mi)
#pragma unroll
                for (int ni = 0; ni < 2; ++ni) acc[mi][ni] = (f32x4){0.f, 0.f, 0.f, 0.f};
#pragma unroll
            for (int mi = 0; mi < 4; ++mi) ap[mi] = Qctx + ((size_t)(bgkc0 + mi) * 16 + fr) * 32;
            wave_mma_lb<4, 2, 1, 40>(ap, Bl16, acc, fr, fq);
#pragma unroll
            for (int mi = 0; mi < 4; ++mi) {
                const int k1 = fr;
                f32x4 orr, oi;
#pragma unroll
                for (int r = 0; r < 4; ++r) {
                    const int t2 = 4 * fq + r, m = (t2 * k1) & 255;
                    const float x = (float)m * (1.0f / 128.0f), cs = cospif(x), sn = sinpif(x);
                    const float br = acc[mi][0][r], bi = acc[mi][1][r];
                    orr[r] = br * cs + bi * sn; oi[r] = bi * cs - br * sn;
                }
                bf16_t* dst = Rctx + ((size_t)(bgkc0 + mi) * 16 + k1) * 32 + 4 * fq;
                st4bf(dst, orr); st4bf(dst + 16, oi);
            }
        }
    }
}
__device__ __forceinline__ void fourier_l3(const Args& a, LAS unsigned char* lds) {
    const int skipb = (gridDim.x >= 128 && gridDim.x < 256) ? 64 : 0;
    if ((int)blockIdx.x < skipb) return;
    const int tid = threadIdx.x, lane = tid & 63, wv = tid >> 6, gw = ((int)blockIdx.x - skipb) * 8 + wv, ngw = ((int)gridDim.x - skipb) * 8, fr = lane & 15, fq = lane >> 4;
    unsigned char* ws = a.ws;
    const bf16_t* tab = (const bf16_t*)(ws + WS_TAB);
    const bf16_t* Rlat = (const bf16_t*)(ws + WS_RLAT);
    const bf16_t* Rctx = (const bf16_t*)(ws + WS_WINT);
    bf16_t* U = (bf16_t*)(ws + WS_U);
    LAS bf16_t* Cl64 = (LAS bf16_t*)lds;
    LAS bf16_t* Cl16 = Cl64 + 64 * 136;
    stage_table<136>(Cl64, tab + T_WC64, 64, 128); stage_table<40>(Cl16, tab + T_WC16, 16, 32); __syncthreads();
    for (int wt = gw; wt < 1024 + 2048; wt += ngw) {
        if (wt < 1024) {
            const int kb = wt & 1, k1 = (wt >> 1) & 63, bg = wt >> 7, b = bg >> 2, g = bg & 3;
            const bf16_t* ap[4]; f32x4 acc[4][4];
#pragma unroll
            for (int mi = 0; mi < 4; ++mi)
#pragma unroll
                for (int ni = 0; ni < 4; ++ni) acc[mi][ni] = (f32x4){0.f, 0.f, 0.f, 0.f};
#pragma unroll
            for (int mi = 0; mi < 4; ++mi) ap[mi] = Rlat + ((size_t)(bg * 128 + kb * 64 + 16 * mi + fr) * 64 + k1) * 128;
            wave_mma_lb<4, 4, 4, 136, 2>(ap, Cl64, acc, fr, fq);
            const float scale = 0.0013810679320049757f;
#pragma unroll
            for (int mi = 0; mi < 4; ++mi)
#pragma unroll
                for (int ni = 0; ni < 4; ++ni) {
                    const int k2 = 16 * ni + fr, kt = k1 + 64 * k2, row = NTOK_C + b * 4096 + kt, col = g * 128 + kb * 64 + 16 * mi + 4 * fq;
                    bf16_t* rp = U + (size_t)row * LDU;
                    const u32x2 gt = *(const u32x2*)(rp + C_GF + col);
                    f32x4 o; o[0] = acc[mi][ni][0] * scale * bflo(gt.x); o[1] = acc[mi][ni][1] * scale * bfhi(gt.x);
                    o[2] = acc[mi][ni][2] * scale * bflo(gt.y); o[3] = acc[mi][ni][3] * scale * bfhi(gt.y);
                    st4bf(rp + C_XF + col, o);
                }
        } else {
            const int w2 = wt - 1024, kb = w2 & 1, k1 = (w2 >> 1) & 15, bg = w2 >> 5, b = bg >> 2, g = bg & 3;
            const bf16_t* ap[4]; f32x4 acc[4][1];
#pragma unroll
            for (int mi = 0; mi < 4; ++mi) acc[mi][0] = (f32x4){0.f, 0.f, 0.f, 0.f};
#pragma unroll
            for (int mi = 0; mi < 4; ++mi) ap[mi] = Rctx + ((size_t)(bg * 128 + kb * 64 + 16 * mi + fr) * 16 + k1) * 32;
            wave_mma_lb<4, 1, 1, 40>(ap, Cl16, acc, fr, fq);
            const float scale = 0.005524271728019903f;
#pragma unroll
            for (int mi = 0; mi < 4; ++mi) {
                const int k2 = fr, kt = k1 + 16 * k2, row = b * 256 + kt, col = g * 128 + kb * 64 + 16 * mi + 4 * fq;
                bf16_t* rp = U + (size_t)row * LDU;
                const u32x2 gt = *(const u32x2*)(rp + C_GF + col);
                f32x4 o; o[0] = acc[mi][0][0] * scale * bflo(gt.x); o[1] = acc[mi][0][1] * scale * bfhi(gt.x);
                o[2] = acc[mi][0][2] * scale * bflo(gt.y); o[3] = acc[mi][0][3] * scale * bfhi(gt.y);
                st4bf(rp + C_XF + col, o);
            }
        }
    }
}

__device__ __forceinline__ float sh_mixed(const bf16_t* U, const float* mu, int row, int cs, int lat, int t) {
    int nb; bool valid;
    if (lat) {
        const int d = cs & 3, cg_ = t & 63, rg = t >> 6;
        if (d == 0) { valid = cg_ > 0; nb = row - 1; } else if (d == 1) { valid = cg_ < 63; nb = row + 1; }
        else if (d == 2) { valid = rg > 0; nb = row - 64; } else { valid = rg < 63; nb = row + 64; }
    } else {
        if (cs & 1) { valid = t < 255; nb = row + 1; } else { valid = t > 0; nb = row - 1; }
    }
    const float x = bf2f(U[(size_t)row * LDU + C_SH + cs]);
    const float s = valid ? bf2f(U[(size_t)nb * LDU + C_SH + cs]) : 0.0f;
    return x + mu[cs] * (s - x);
}

constexpr int LDP = 72;
constexpr int SC_X = 0, SC_AAK = 16384, SC_ARK = 25600, SC_ARB = 34816, SC_TM = 44032, SC_TW = 53248, SC_AD = 62464,
              SC_AT = 71680, SC_RT = 80896, SC_BT = 90112, SC_KT = 99328, SC_BH = 108544, SC_KH = 117888, SC_VT = 127232, SC_SB = 136576, SC_EGL = 145792, SC_ABA = 146048, SC_PAR = 148608;
constexpr int LDQ = 40;
__device__ __forceinline__ bf16x8 ldfrag(const LAS bf16_t* arr, int row, int ks, int fq) { return *(const LAS bf16x8*)(arr + row * LDP + ks * 32 + fq * 8); }
__device__ __forceinline__ int tskew(int row) { return row * LDP + 8 * (row >> 3); }
__device__ __forceinline__ bf16x8 ldfragT(const LAS bf16_t* arr, int row, int ks, int fq) { return *(const LAS bf16x8*)(arr + tskew(row) + ks * 32 + fq * 8); }
__device__ __forceinline__ void st4lds(LAS bf16_t* p, const f32x4 v) { u32x2 w; w.x = pk2(v[0], v[1]); w.y = pk2(v[2], v[3]); *(LAS u32x2*)p = w; }
#define SBAR() do { asm volatile("s_waitcnt lgkmcnt(0)" ::: "memory"); __builtin_amdgcn_s_barrier(); asm volatile("" ::: "memory"); } while (0)
#define MMA16(a_, b_, c_) (c_) = __builtin_amdgcn_mfma_f32_16x16x32_bf16((a_), (b_), (c_), 0, 0, 0)

__device__ __forceinline__ float bfel(const u32x4 w, int e) { const unsigned x = w[e >> 1]; return (e & 1) ? bfhi(x) : bflo(x); }
__device__ __forceinline__ void mix8(const u32x4 self, const u32x4 (&nb)[4], const bool (&vl)[4], int lat, const f32x4 mu0, const f32x4 mu1, float (&out)[8]) {
#pragma unroll
    for (int e = 0; e < 8; ++e) {
        const float x = bfel(self, e);
        float s;
        if (lat) { const int d = e & 3; s = vl[d] ? bfel(nb[d], e) : 0.f; }
        else { const int d = e & 1; s = vl[d] ? bfel(nb[d], e) : 0.f; }
        const float m = (e < 4) ? mu0[e] : mu1[e - 4];
        out[e] = x + m * (s - x);
    }
}
__device__ __forceinline__ u32x4 pack8(const float (&v)[8]) { u32x4 w; w.x = pk2(v[0], v[1]); w.y = pk2(v[2], v[3]); w.z = pk2(v[4], v[5]); w.w = pk2(v[6], v[7]); return w; }
__device__ __forceinline__ float tanh_fast(float x) { const float e = __expf(2.0f * x); return 1.0f - 2.0f * __builtin_amdgcn_rcpf(e + 1.0f); }

__device__ __forceinline__ void phase_premix(const Args& a) {
    const bf16_t* U = (const bf16_t*)(a.ws + WS_U);
    bf16_t* MIX = (bf16_t*)(a.ws + WS_MIX);
    const float* mu = a.in[9];
    for (int idx = blockIdx.x * 512 + threadIdx.x; idx < NTOK * 16; idx += gridDim.x * 512) {
        const int row = idx >> 4, c0 = (idx & 15) * 8;
        const int lat = row >= NTOK_C, t = lat ? ((row - NTOK_C) & 4095) : (row & 255);
        bool nv[4]; int nrow[4];
        if (lat) { const int cx = t & 63, rg = t >> 6; nv[0] = cx > 0; nv[1] = cx < 63; nv[2] = rg > 0; nv[3] = rg < 63;
            nrow[0] = nv[0] ? row - 1 : row; nrow[1] = nv[1] ? row + 1 : row; nrow[2] = nv[2] ? row - 64 : row; nrow[3] = nv[3] ? row + 64 : row; }
        else { nv[0] = t > 0; nv[1] = t < 255; nv[2] = false; nv[3] = false; nrow[0] = nv[0] ? row - 1 : row; nrow[1] = nv[1] ? row + 1 : row; nrow[2] = row; nrow[3] = row; }
        const u32x4 Ws = *(const u32x4*)(U + (size_t)row * LDU + C_SH + 3072 + c0);
        u32x4 Wn[4];
#pragma unroll
        for (int d = 0; d < 4; ++d) { if (d < 2 || lat) Wn[d] = *(const u32x4*)(U + (size_t)nrow[d] * LDU + C_SH + 3072 + c0); else Wn[d] = Ws; }
        float o[8];
        mix8(Ws, Wn, nv, lat, *(const f32x4*)(mu + 3072 + c0), *(const f32x4*)(mu + 3072 + c0 + 4), o);
        if (c0 < 64) {
#pragma unroll
            for (int e = 0; e < 8; ++e) o[e] = tanh_fast(o[e]);
        }
        *(u32x4*)(MIX + (size_t)row * 128 + c0) = pack8(o);
    }
}

__device__ __forceinline__ void scan_chain(const Args& a, LAS unsigned char* lds, int lat, int b, int h, int dir, float ysc, int cbeg, int cend, int mode) {
    const int tid = threadIdx.x, lane = tid & 63, wv = __builtin_amdgcn_readfirstlane(tid >> 6), fr = lane & 15, fq = lane >> 4;
    const int T = lat ? 4096 : 256, row_base = lat ? NTOK_C + b * 4096 : b * 256;
    const bf16_t* U = (const bf16_t*)(a.ws + WS_U);
    const float* mu = a.in[9];
    LAS float* Gf = (LAS float*)(lds + SC_X); LAS float* AGf = (LAS float*)(lds + SC_X + 16384); LAS float* Aab = (LAS float*)(lds + SC_X);
    LAS bf16_t* Aak = (LAS bf16_t*)(lds + SC_AAK); LAS bf16_t* Ark = (LAS bf16_t*)(lds + SC_ARK); LAS bf16_t* Arb = (LAS bf16_t*)(lds + SC_ARB);
    LAS bf16_t* Tm = (LAS bf16_t*)(lds + SC_TM); LAS bf16_t* TW = (LAS bf16_t*)(lds + SC_TW); LAS bf16_t* AD = (LAS bf16_t*)(lds + SC_AD);
    LAS bf16_t* PT = TW; LAS bf16_t* UT = AD;
    LAS bf16_t* At = (LAS bf16_t*)(lds + SC_AT); LAS bf16_t* Rt = (LAS bf16_t*)(lds + SC_RT); LAS bf16_t* Bt = (LAS bf16_t*)(lds + SC_BT);
    LAS bf16_t* Kt = (LAS bf16_t*)(lds + SC_KT); LAS bf16_t* BhT = (LAS bf16_t*)(lds + SC_BH); LAS bf16_t* KhT = (LAS bf16_t*)(lds + SC_KH);
    LAS bf16_t* VT = (LAS bf16_t*)(lds + SC_VT); LAS bf16_t* Sb = (LAS bf16_t*)(lds + SC_SB); LAS float* EGL = (LAS float*)(lds + SC_EGL);
    const int nio = wv & 3, mo0 = 2 * (wv >> 2);
    f32x4 Sacc[2];
    {
        const int i = 16 * nio + fr;
#pragma unroll
        for (int mm = 0; mm < 2; ++mm) {
            const int j0 = 16 * (mo0 + mm) + 4 * fq;
            if (mode == 2) { Sacc[mm] = (f32x4){0.f, 0.f, 0.f, 0.f};
#pragma unroll
                for (int r = 0; r < 4; ++r) if (j0 + r == i) Sacc[mm][r] = 1.0f; }
            else if (lat && mode == 0) Sacc[mm] = *(const f32x4*)(a.in[2] + ((((size_t)b * 2 + dir) * 16 + h) * 64 + i) * 64 + j0);
            else Sacc[mm] = (f32x4){0.f, 0.f, 0.f, 0.f};
            st4lds(Sb + i * LDP + j0, Sacc[mm]);
        }
    }
    const int lr_strip = wv & 3;
    const bool lr_lo = wv < 4;
    const int lr_c = h * 64 + 16 * lr_strip + fr;
    const float lr_w0 = a.in[10][dir * 1024 + lr_c], lr_a0 = a.in[12][dir * 1024 + lr_c];
    const bf16_t* lr_bw = (const bf16_t*)(a.ws + WS_WUPT) + ((size_t)dir * 1024 + lr_c) * 64;
    const bf16_t* lr_ba = (const bf16_t*)(a.ws + WS_AUPT) + ((size_t)dir * 1024 + lr_c) * 64;
    u32x4 Rs, Ks, Vs, Rn[4], Kn[4], Vn[4]; bf16x8 Wf[2][4]; int nvm = 0;
    const bf16_t* MIXp = (const bf16_t*)(a.ws + WS_MIX);
    const int nch = cend;
#define SCAN_ISSUE(cidx) do { \
        const int l2_ = threadIdx.x & 63, p2_ = (l2_ >> 3) + 8 * wv, g2_ = l2_ & 7; \
        const int pos_ = (cidx) * 64 + p2_, t_ = dir ? T - 1 - pos_ : pos_, row_ = row_base + t_; \
        int n0_, n1_, n2_, n3_, m_ = 0; \
        if (lat) { const int cx = t_ & 63, rg = t_ >> 6; m_ = (cx > 0 ? 1 : 0) | (cx < 63 ? 2 : 0) | (rg > 0 ? 4 : 0) | (rg < 63 ? 8 : 0); \
            n0_ = (m_ & 1) ? row_ - 1 : row_; n1_ = (m_ & 2) ? row_ + 1 : row_; n2_ = (m_ & 4) ? row_ - 64 : row_; n3_ = (m_ & 8) ? row_ + 64 : row_; } \
        else { m_ = (t_ > 0 ? 1 : 0) | (t_ < 255 ? 2 : 0); n0_ = (m_ & 1) ? row_ - 1 : row_; n1_ = (m_ & 2) ? row_ + 1 : row_; n2_ = row_; n3_ = row_; } \
        nvm = m_; \
        const int colr_ = h * 64 + 8 * g2_; \
        const bf16_t* sp_ = U + (size_t)row_ * LDU + C_SH + colr_; \
        Rs = *(const u32x4*)(sp_); Ks = *(const u32x4*)(sp_ + 1024); Vs = *(const u32x4*)(sp_ + 2048); \
        { const bf16_t* q_ = U + (size_t)n0_ * LDU + C_SH + colr_; Rn[0] = *(const u32x4*)(q_); Kn[0] = *(const u32x4*)(q_ + 1024); Vn[0] = *(const u32x4*)(q_ + 2048); } \
        { const bf16_t* q_ = U + (size_t)n1_ * LDU + C_SH + colr_; Rn[1] = *(const u32x4*)(q_); Kn[1] = *(const u32x4*)(q_ + 1024); Vn[1] = *(const u32x4*)(q_ + 2048); } \
        if (lat) { \
            { const bf16_t* q_ = U + (size_t)n2_ * LDU + C_SH + colr_; Rn[2] = *(const u32x4*)(q_); Kn[2] = *(const u32x4*)(q_ + 1024); Vn[2] = *(const u32x4*)(q_ + 2048); } \
            { const bf16_t* q_ = U + (size_t)n3_ * LDU + C_SH + colr_; Rn[3] = *(const u32x4*)(q_); Kn[3] = *(const u32x4*)(q_ + 1024); Vn[3] = *(const u32x4*)(q_ + 2048); } \
        } else { Rn[2] = Rs; Kn[2] = Ks; Vn[2] = Vs; Rn[3] = Rs; Kn[3] = Ks; Vn[3] = Vs; } \
        _Pragma("unroll") for (int mi_ = 0; mi_ < 4; ++mi_) { \
            const int pw_ = (cidx) * 64 + 16 * mi_ + (l2_ & 15), tw_ = dir ? T - 1 - pw_ : pw_; \
            const bf16_t* wp_ = MIXp + (size_t)(row_base + tw_) * 128 + (((mi_ < 2) == lr_lo) ? 0 : 64) + (l2_ >> 4) * 8; \
            Wf[0][mi_] = *(const bf16x8*)(wp_); Wf[1][mi_] = *(const bf16x8*)(wp_ + 32); } \
    } while (0)
    {
        LAS float* PAR = (LAS float*)(lds + SC_PAR);
        const int tt = threadIdx.x;
        if (tt < 384) { const int w_ = tt >> 6, cc_ = h * 64 + (tt & 63);
            PAR[tt] = (w_ == 0) ? mu[cc_] : (w_ == 1) ? mu[1024 + cc_] : (w_ == 2) ? mu[2048 + cc_] : (w_ == 3) ? a.in[14][cc_] : (w_ == 4) ? a.in[15][cc_] : a.in[16][cc_]; }
    }
    for (int i_ = threadIdx.x; i_ < 32 * 32; i_ += 512) Tm[(i_ >> 5) * LDP + 32 + (i_ & 31)] = (bf16_t)0;
    SCAN_ISSUE(cbeg);
    for (int chunk = cbeg; chunk < nch; ++chunk) {
        int lv_ = threadIdx.x & 63; asm volatile("" : "+v"(lv_));
        const int lane = lv_, fr = lv_ & 15, fq = lv_ >> 4;
        const int tk_p = (lv_ >> 3) + 8 * wv, tk_cg = lv_ & 7;
        const int colr = h * 64 + 8 * tk_cg;
        {
            const int dmi = lr_lo ? 0 : 2, ami = lr_lo ? 2 : 0;
            f32x4 accd[2], acca[2];
#pragma unroll
            for (int mm = 0; mm < 2; ++mm) { accd[mm] = (f32x4){lr_w0, lr_w0, lr_w0, lr_w0}; acca[mm] = (f32x4){lr_a0, lr_a0, lr_a0, lr_a0}; }
#pragma unroll
            for (int ks = 0; ks < 2; ++ks) {
                const bf16x8 bw = *(const bf16x8*)(lr_bw + ks * 32 + fq * 8), ba = *(const bf16x8*)(lr_ba + ks * 32 + fq * 8);
                if (lr_lo) { MMA16(Wf[ks][0], bw, accd[0]); MMA16(Wf[ks][1], bw, accd[1]); MMA16(Wf[ks][2], ba, acca[0]); MMA16(Wf[ks][3], ba, acca[1]); }
                else       { MMA16(Wf[ks][2], bw, accd[0]); MMA16(Wf[ks][3], bw, accd[1]); MMA16(Wf[ks][0], ba, acca[0]); MMA16(Wf[ks][1], ba, acca[1]); }
            }
            const int ch = 16 * lr_strip + fr;
            float carry = 0.f;
#pragma unroll
            for (int mm = 0; mm < 2; ++mm) {
                float c[4];
#pragma unroll
                for (int r = 0; r < 4; ++r) {
                    const float lw = -0.87503878f * sigmoidf_(accd[mm][r]);
                    c[r] = (r ? c[r - 1] : 0.f) + lw;
                }
                const float t0 = __shfl(c[3], fr), t1 = __shfl(c[3], fr + 16), t2 = __shfl(c[3], fr + 32), t3 = __shfl(c[3], fr + 48);
                const float off = carry + (fq > 0 ? t0 : 0.f) + (fq > 1 ? t1 : 0.f) + (fq > 2 ? t2 : 0.f);
#pragma unroll
                for (int r = 0; r < 4; ++r) Gf[(16 * (dmi + mm) + 4 * fq + r) * 64 + ch] = off + c[r];
                carry += (t0 + t1) + (t2 + t3);
            }
#pragma unroll
            for (int mm = 0; mm < 2; ++mm)
#pragma unroll
                for (int r = 0; r < 4; ++r) AGf[(16 * (ami + mm) + 4 * fq + r) * 64 + ch] = sigmoidf_(acca[mm][r]);
        }
        SBAR();
        {
            const int c0 = 8 * tk_cg, p = tk_p;
            float rr[8], kx[8], vv[8];
            const bool nv[4] = {(nvm & 1) != 0, (nvm & 2) != 0, (nvm & 4) != 0, (nvm & 8) != 0};
            {
                const LAS float* PAR = (const LAS float*)(lds + SC_PAR) + c0;
                const f32x4 a0 = *(const LAS f32x4*)(PAR), a1 = *(const LAS f32x4*)(PAR + 4);
                mix8(Rs, Rn, nv, lat, a0, a1, rr);
                const f32x4 b0 = *(const LAS f32x4*)(PAR + 64), b1 = *(const LAS f32x4*)(PAR + 68);
                mix8(Ks, Kn, nv, lat, b0, b1, kx);
                const f32x4 d0 = *(const LAS f32x4*)(PAR + 128), d1 = *(const LAS f32x4*)(PAR + 132);
                mix8(Vs, Vn, nv, lat, d0, d1, vv);
                if (mode == 2) {
#pragma unroll
                    for (int e = 0; e < 8; ++e) vv[e] = 0.f; }
            }
            f32x4 g0 = *(const LAS f32x4*)(Gf + p * 64 + c0), g1 = *(const LAS f32x4*)(Gf + p * 64 + c0 + 4);
            const int pm = p > 0 ? p - 1 : 0;
            f32x4 q0 = *(const LAS f32x4*)(Gf + pm * 64 + c0), q1 = *(const LAS f32x4*)(Gf + pm * 64 + c0 + 4);
            const f32x4 h0 = *(const LAS f32x4*)(Gf + 31 * 64 + c0), h1 = *(const LAS f32x4*)(Gf + 31 * 64 + c0 + 4);
            if (p == 0) { q0 = (f32x4){0.f, 0.f, 0.f, 0.f}; q1 = q0; }
            if (p >= 32) { g0 += h0; g1 += h1; }
            if (p >= 33) { q0 += h0; q1 += h1; }
            const f32x4 ag0 = *(const LAS f32x4*)(AGf + p * 64 + c0), ag1 = *(const LAS f32x4*)(AGf + p * 64 + c0 + 4);
            const f32x4 l0 = *(const LAS f32x4*)(Gf + 63 * 64 + c0) + h0, l1 = *(const LAS f32x4*)(Gf + 63 * 64 + c0 + 4) + h1;
            const f32x4 kk0 = *(const LAS f32x4*)((const LAS float*)(lds + SC_PAR) + 192 + c0), kk1 = *(const LAS f32x4*)((const LAS float*)(lds + SC_PAR) + 196 + c0);
            const f32x4 ka0 = *(const LAS f32x4*)((const LAS float*)(lds + SC_PAR) + 256 + c0), ka1 = *(const LAS f32x4*)((const LAS float*)(lds + SC_PAR) + 260 + c0);
            float kkv[8], n2 = 0.f;
#pragma unroll
            for (int e = 0; e < 8; ++e) { kkv[e] = kx[e] * (e < 4 ? kk0[e] : kk1[e - 4]); n2 += kkv[e] * kkv[e]; }
            n2 += __shfl_xor(n2, 1); n2 += __shfl_xor(n2, 2); n2 += __shfl_xor(n2, 4);
            if (dir == 0 && mode != 2) {
                const f32x4 rk0 = *(const LAS f32x4*)((const LAS float*)(lds + SC_PAR) + 320 + c0), rk1 = *(const LAS f32x4*)((const LAS float*)(lds + SC_PAR) + 324 + c0);
                float bs = 0.f;
#pragma unroll
                for (int e = 0; e < 8; ++e) bs += rr[e] * kx[e] * (e < 4 ? rk0[e] : rk1[e - 4]);
                bs += __shfl_xor(bs, 1); bs += __shfl_xor(bs, 2); bs += __shfl_xor(bs, 4);
                float bo[8];
#pragma unroll
                for (int e = 0; e < 8; ++e) bo[e] = bs * vv[e];
                const int bpos = chunk * 64 + p, bt = bpos;
                *(u32x4*)((bf16_t*)a.out + BON_OFF + (size_t)(row_base + bt) * DM + h * 64 + c0) = pack8(bo);
            }
            const float inv = __builtin_amdgcn_rcpf(fmaxf(__builtin_amdgcn_sqrtf(n2), 1e-12f));
            float oa[8], orr[8], ob[8], ok[8];
#pragma unroll
            for (int e = 0; e < 8; ++e) {
                const float g = e < 4 ? g0[e] : g1[e - 4], gp = e < 4 ? q0[e] : q1[e - 4], ag = e < 4 ? ag0[e] : ag1[e - 4], gl = e < 4 ? l0[e] : l1[e - 4];
                const float kac = e < 4 ? ka0[e] : ka1[e - 4];
                const float kkn = kkv[e] * inv, kd = kx[e] * (1.0f + (ag - 1.0f) * kac), bb = kkn * ag;
                const float emg = __builtin_amdgcn_exp2f(-g), eh = __builtin_amdgcn_exp2f(gl - g);
                oa[e] = -kkn * __builtin_amdgcn_exp2f(gp); orr[e] = rr[e] * __builtin_amdgcn_exp2f(g); ob[e] = bb * emg; ok[e] = kd * emg;
                BhT[tskew(c0 + e) + p] = (bf16_t)f2bf(bb * eh);
                KhT[tskew(c0 + e) + p] = (bf16_t)f2bf(kd * eh);
                VT[tskew(c0 + e) + p] = (bf16_t)f2bf(vv[e]);
                if (p == 0) EGL[c0 + e] = __builtin_amdgcn_exp2f(gl);
            }
            *(LAS u32x4*)(At + p * LDP + c0) = pack8(oa); *(LAS u32x4*)(Rt + p * LDP + c0) = pack8(orr);
            *(LAS u32x4*)(Bt + p * LDP + c0) = pack8(ob); *(LAS u32x4*)(Kt + p * LDP + c0) = pack8(ok);
        }
        SBAR();
        {
#pragma unroll
            for (int rep = 0; rep < 2; ++rep) {
                const int tix = wv + 8 * rep;
                if (tix < 10) {
                    const int mi = tix < 4 ? 0 : tix < 7 ? 1 : tix < 9 ? 2 : 3, ni = tix < 4 ? tix : tix < 7 ? tix - 3 : tix < 9 ? tix - 5 : 3;
                    const bf16x8 x0 = ldfrag(Bt, 16 * mi + fr, 0, fq), x1 = ldfrag(Bt, 16 * mi + fr, 1, fq), y0 = ldfrag(At, 16 * ni + fr, 0, fq), y1 = ldfrag(At, 16 * ni + fr, 1, fq);
                    f32x4 c = (f32x4){0.f, 0.f, 0.f, 0.f};
                    MMA16(x0, y0, c); MMA16(x1, y1, c);
                    const int t = 16 * ni + fr, tau0 = 16 * mi + 4 * fq;
#pragma unroll
                    for (int r = 0; r < 4; ++r) if (tau0 + r >= t) c[r] = 0.f;
                    *(LAS f32x4*)(Aab + t * 64 + tau0) = c;
                    if (mi < 2 && ni >= 2) st4lds((LAS bf16_t*)(lds + SC_ABA) + (t - 32) * LDQ + tau0, c);
                }
            }
        }
        SBAR();
        if (wv != 0) {
#pragma unroll 1
            for (int idx = wv - 1; idx < 48; idx += 7) {
                const int mat = 1 + (idx >> 4), mi = (idx >> 2) & 3, ni = idx & 3;
                const LAS bf16_t* X = (mat == 2) ? Bt : Kt;
                const LAS bf16_t* Y = (mat == 1) ? At : Rt;
                LAS bf16_t* dst = (mat == 1) ? Aak : (mat == 2) ? Arb : Ark;
                f32x4 c = (f32x4){0.f, 0.f, 0.f, 0.f};
                if (mi <= ni) {
                    const bf16x8 x0 = ldfrag(X, 16 * mi + fr, 0, fq), x1 = ldfrag(X, 16 * mi + fr, 1, fq), y0 = ldfrag(Y, 16 * ni + fr, 0, fq), y1 = ldfrag(Y, 16 * ni + fr, 1, fq);
                    MMA16(x0, y0, c); MMA16(x1, y1, c);
                }
                const int t = 16 * ni + fr, tau0 = 16 * mi + 4 * fq;
#pragma unroll
                for (int r = 0; r < 4; ++r) { const int tau = tau0 + r; if ((mat != 1) ? (tau > t) : (tau >= t)) c[r] = 0.f; }
                st4lds(dst + t * LDP + tau0, c);
            }
        }
        if (wv == 0) {
            LAS bf16_t* AbBA = (LAS bf16_t*)(lds + SC_ABA); LAS bf16_t* TT = UT; LAS bf16_t* WsT = UT + 32 * LDQ;
            const int hb = lane >> 5, c = lane & 31;
            const float cf = (float)c;
            float Tr[32];
#pragma unroll
            for (int t = 0; t < 32; ++t) Tr[t] = 0.f;
            {
                const int abase_i = (32 * hb) * 64 + 32 * hb;
                f32x2_t TP[16];
#pragma unroll
                for (int q = 0; q < 16; ++q) TP[q] = (f32x2_t){0.f, 0.f};
                Tr[0] = 1.0f - fminf(cf, 1.0f); TP[0][0] = Tr[0];
                const f32x4 r1_0 = *(const LAS f32x4*)(Aab + abase_i + 64);
                const f32x4 r2_0 = *(const LAS f32x4*)(Aab + abase_i + 128);
                int o3 = abase_i + 192; asm volatile("" : "+v"(o3) : "v"(Tr[0]));
                const f32x4 r3_0 = *(const LAS f32x4*)(Aab + o3 + 0);
                __builtin_amdgcn_sched_barrier(0);
                { const f32x2_t pa = (f32x2_t){r1_0[0], r1_0[1]} * TP[0]; const f32x2_t pb = (f32x2_t){0.f, 0.f}; const f32x2_t ps = pa + pb;
                  Tr[1] = (ps[0] + ps[1]) + (1.0f - fminf(fabsf(cf - 1.0f), 1.0f)); TP[0][1] = Tr[1]; }
                __builtin_amdgcn_sched_barrier(0);
                int o4 = abase_i + 256; asm volatile("" : "+v"(o4) : "v"(Tr[1]));
                const f32x4 r4_0 = *(const LAS f32x4*)(Aab + o4 + 0);
                __builtin_amdgcn_sched_barrier(0);
                { const f32x2_t pa = (f32x2_t){r2_0[0], r2_0[1]} * TP[0]; const f32x2_t pb = (f32x2_t){0.f, 0.f}; const f32x2_t ps = pa + pb;
                  Tr[2] = (ps[0] + ps[1]) + (1.0f - fminf(fabsf(cf - 2.0f), 1.0f)); TP[1][0] = Tr[2]; }
                __builtin_amdgcn_sched_barrier(0);
                int o5 = abase_i + 320; asm volatile("" : "+v"(o5) : "v"(Tr[2]));
                const f32x4 r5_0 = *(const LAS f32x4*)(Aab + o5 + 0); const f32x4 r5_1 = *(const LAS f32x4*)(Aab + o5 + 4);
                __builtin_amdgcn_sched_barrier(0);
                { const f32x2_t pa = (f32x2_t){r3_0[0], r3_0[1]} * TP[0]; const f32x2_t pb = (f32x2_t){r3_0[2], r3_0[3]} * TP[1]; const f32x2_t ps = pa + pb;
                  Tr[3] = (ps[0] + ps[1]) + (1.0f - fminf(fabsf(cf - 3.0f), 1.0f)); TP[1][1] = Tr[3]; }
                __builtin_amdgcn_sched_barrier(0);
                int o6 = abase_i + 384; asm volatile("" : "+v"(o6) : "v"(Tr[3]));
                const f32x4 r6_0 = *(const LAS f32x4*)(Aab + o6 + 0); const f32x4 r6_1 = *(const LAS f32x4*)(Aab + o6 + 4);
                __builtin_amdgcn_sched_barrier(0);
                { const f32x2_t pa = (f32x2_t){r4_0[0], r4_0[1]} * TP[0]; const f32x2_t pb = (f32x2_t){r4_0[2], r4_0[3]} * TP[1]; const f32x2_t ps = pa + pb;
                  Tr[4] = (ps[0] + ps[1]) + (1.0f - fminf(fabsf(cf - 4.0f), 1.0f)); TP[2][0] = Tr[4]; }
                __builtin_amdgcn_sched_barrier(0);
                int o7 = abase_i + 448; asm volatile("" : "+v"(o7) : "v"(Tr[4]));
                const f32x4 r7_0 = *(const LAS f32x4*)(Aab + o7 + 0); const f32x4 r7_1 = *(const LAS f32x4*)(Aab + o7 + 4);
                __builtin_amdgcn_sched_barrier(0);
                { const f32x2_t pa = (f32x2_t){r5_0[0], r5_0[1]} * TP[0] + (f32x2_t){r5_1[0], r5_1[1]} * TP[2]; const f32x2_t pb = (f32x2_t){r5_0[2], r5_0[3]} * TP[1]; const f32x2_t ps = pa + pb;
                  Tr[5] = (ps[0] + ps[1]) + (1.0f - fminf(fabsf(cf - 5.0f), 1.0f)); TP[2][1] = Tr[5]; }
                __builtin_amdgcn_sched_barrier(0);
                int o8 = abase_i + 512; asm volatile("" : "+v"(o8) : "v"(Tr[5]));
                const f32x4 r8_0 = *(const LAS f32x4*)(Aab + o8 + 0); const f32x4 r8_1 = *(const LAS f32x4*)(Aab + o8 + 4);
                __builtin_amdgcn_sched_barrier(0);
                { const f32x2_t pa = (f32x2_t){r6_0[0], r6_0[1]} * TP[0] + (f32x2_t){r6_1[0], r6_1[1]} * TP[2]; const f32x2_t pb = (f32x2_t){r6_0[2], r6_0[3]} * TP[1]; const f32x2_t ps = pa + pb;
                  Tr[6] = (ps[0] + ps[1]) + (1.0f - fminf(fabsf(cf - 6.0f), 1.0f)); TP[3][0] = Tr[6]; }
                __builtin_amdgcn_sched_barrier(0);
                int o9 = abase_i + 576; asm volatile("" : "+v"(o9) : "v"(Tr[6]));
                const f32x4 r9_0 = *(const LAS f32x4*)(Aab + o9 + 0); const f32x4 r9_1 = *(const LAS f32x4*)(Aab + o9 + 4); const f32x4 r9_2 = *(const LAS f32x4*)(Aab + o9 + 8);
                __builtin_amdgcn_sched_barrier(0);
                { const f32x2_t pa = (f32x2_t){r7_0[0], r7_0[1]} * TP[0] + (f32x2_t){r7_1[0], r7_1[1]} * TP[2]; const f32x2_t pb = (f32x2_t){r7_0[2], r7_0[3]} * TP[1] + (f32x2_t){r7_1[2], r7_1[3]} * TP[3]; const f32x2_t ps = pa + pb;
                  Tr[7] = (ps[0] + ps[1]) + (1.0f - fminf(fabsf(cf - 7.0f), 1.0f)); TP[3][1] = Tr[7]; }
                __builtin_amdgcn_sched_barrier(0);
                int o10 = abase_i + 640; asm volatile("" : "+v"(o10) : "v"(Tr[7]));
                const f32x4 r10_0 = *(const LAS f32x4*)(Aab + o10 + 0); const f32x4 r10_1 = *(const LAS f32x4*)(Aab + o10 + 4); const f32x4 r10_2 = *(const LAS f32x4*)(Aab + o10 + 8);
                __builtin_amdgcn_sched_barrier(0);
                { const f32x2_t pa = (f32x2_t){r8_0[0], r8_0[1]} * TP[0] + (f32x2_t){r8_1[0], r8_1[1]} * TP[2]; const f32x2_t pb = (f32x2_t){r8_0[2], r8_0[3]} * TP[1] + (f32x2_t){r8_1[2], r8_1[3]} * TP[3]; const f32x2_t ps = pa + pb;
                  Tr[8] = (ps[0] + ps[1]) + (1.0f - fminf(fabsf(cf - 8.0f), 1.0f)); TP[4][0] = Tr[8]; }
                __builtin_amdgcn_sched_barrier(0);
                int o11 = abase_i + 704; asm volatile("" : "+v"(o11) : "v"(Tr[8]));
                const f32x4 r11_0 = *(const LAS f32x4*)(Aab + o11 + 0); const f32x4 r11_1 = *(const LAS f32x4*)(Aab + o11 + 4); const f32x4 r11_2 = *(const LAS f32x4*)(Aab + o11 + 8);
                __builtin_amdgcn_sched_barrier(0);
                { const f32x2_t pa = (f32x2_t){r9_0[0], r9_0[1]} * TP[0] + (f32x2_t){r9_1[0], r9_1[1]} * TP[2] + (f32x2_t){r9_2[0], r9_2[1]} * TP[4]; const f32x2_t pb = (f32x2_t){r9_0[2], r9_0[3]} * TP[1] + (f32x2_t){r9_1[2], r9_1[3]} * TP[3]; const f32x2_t ps = pa + pb;
                  Tr[9] = (ps[0] + ps[1]) + (1.0f - fminf(fabsf(cf - 9.0f), 1.0f)); TP[4][1] = Tr[9]; }
                __builtin_amdgcn_sched_barrier(0);
                int o12 = abase_i + 768; asm volatile("" : "+v"(o12) : "v"(Tr[9]));
                const f32x4 r12_0 = *(const LAS f32x4*)(Aab + o12 + 0); const f32x4 r12_1 = *(const LAS f32x4*)(Aab + o12 + 4); const f32x4 r12_2 = *(const LAS f32x4*)(Aab + o12 + 8);
                __builtin_amdgcn_sched_barrier(0);
                { const f32x2_t pa = (f32x2_t){r10_0[0], r10_0[1]} * TP[0] + (f32x2_t){r10_1[0], r10_1[1]} * TP[2] + (f32x2_t){r10_2[0], r10_2[1]} * TP[4]; const f32x2_t pb = (f32x2_t){r10_0[2], r10_0[3]} * TP[1] + (f32x2_t){r10_1[2], r10_1[3]} * TP[3]; const f32x2_t ps = pa + pb;
                  Tr[10] = (ps[0] + ps[1]) + (1.0f - fminf(fabsf(cf - 10.0f), 1.0f)); TP[5][0] = Tr[10]; }
                __builtin_amdgcn_sched_barrier(0);
                int o13 = abase_i + 832; asm volatile("" : "+v"(o13) : "v"(Tr[10]));
                const f32x4 r13_0 = *(const LAS f32x4*)(Aab + o13 + 0); const f32x4 r13_1 = *(const LAS f32x4*)(Aab + o13 + 4); const f32x4 r13_2 = *(const LAS f32x4*)(Aab + o13 + 8); const f32x4 r13_3 = *(const LAS f32x4*)(Aab + o13 + 12);
                __builtin_amdgcn_sched_barrier(0);
                { const f32x2_t pa = (f32x2_t){r11_0[0], r11_0[1]} * TP[0] + (f32x2_t){r11_1[0], r11_1[1]} * TP[2] + (f32x2_t){r11_2[0], r11_2[1]} * TP[4]; const f32x2_t pb = (f32x2_t){r11_0[2], r11_0[3]} * TP[1] + (f32x2_t){r11_1[2], r11_1[3]} * TP[3] + (f32x2_t){r11_2[2], r11_2[3]} * TP[5]; const f32x2_t ps = pa + pb;
                  Tr[11] = (ps[0] + ps[1]) + (1.0f - fminf(fabsf(cf - 11.0f), 1.0f)); TP[5][1] = Tr[11]; }
                __builtin_amdgcn_sched_barrier(0);
                int o14 = abase_i + 896; asm volatile("" : "+v"(o14) : "v"(Tr[11]));
                const f32x4 r14_0 = *(const LAS f32x4*)(Aab + o14 + 0); const f32x4 r14_1 = *(const LAS f32x4*)(Aab + o14 + 4); const f32x4 r14_2 = *(const LAS f32x4*)(Aab + o14 + 8); const f32x4 r14_3 = *(const LAS f32x4*)(Aab + o14 + 12);
                __builtin_amdgcn_sched_barrier(0);
                { const f32x2_t pa = (f32x2_t){r12_0[0], r12_0[1]} * TP[0] + (f32x2_t){r12_1[0], r12_1[1]} * TP[2] + (f32x2_t){r12_2[0], r12_2[1]} * TP[4]; const f32x2_t pb = (f32x2_t){r12_0[2], r12_0[3]} * TP[1] + (f32x2_t){r12_1[2], r12_1[3]} * TP[3] + (f32x2_t){r12_2[2], r12_2[3]} * TP[5]; const f32x2_t ps = pa + pb;
                  Tr[12] = (ps[0] + ps[1]) + (1.0f - fminf(fabsf(cf - 12.0f), 1.0f)); TP[6][0] = Tr[12]; }
                __builtin_amdgcn_sched_barrier(0);
                int o15 = abase_i + 960; asm volatile("" : "+v"(o15) : "v"(Tr[12]));
                const f32x4 r15_0 = *(const LAS f32x4*)(Aab + o15 + 0); const f32x4 r15_1 = *(const LAS f32x4*)(Aab + o15 + 4); const f32x4 r15_2 = *(const LAS f32x4*)(Aab + o15 + 8); const f32x4 r15_3 = *(const LAS f32x4*)(Aab + o15 + 12);
                __builtin_amdgcn_sched_barrier(0);
                { const f32x2_t pa = (f32x2_t){r13_0[0], r13_0[1]} * TP[0] + (f32x2_t){r13_1[0], r13_1[1]} * TP[2] + (f32x2_t){r13_2[0], r13_2[1]} * TP[4] + (f32x2_t){r13_3[0], r13_3[1]} * TP[6]; const f32x2_t pb = (f32x2_t){r13_0[2], r13_0[3]} * TP[1] + (f32x2_t){r13_1[2], r13_1[3]} * TP[3] + (f32x2_t){r13_2[2], r13_2[3]} * TP[5]; const f32x2_t ps = pa + pb;
                  Tr[13] = (ps[0] + ps[1]) + (1.0f - fminf(fabsf(cf - 13.0f), 1.0f)); TP[6][1] = Tr[13]; }
                __builtin_amdgcn_sched_barrier(0);
                int o16 = abase_i + 1024; asm volatile("" : "+v"(o16) : "v"(Tr[13]));
                const f32x4 r16_0 = *(const LAS f32x4*)(Aab + o16 + 0); const f32x4 r16_1 = *(const LAS f32x4*)(Aab + o16 + 4); const f32x4 r16_2 = *(const LAS f32x4*)(Aab + o16 + 8); const f32x4 r16_3 = *(const LAS f32x4*)(Aab + o16 + 12);
                __builtin_amdgcn_sched_barrier(0);
                { const f32x2_t pa = (f32x2_t){r14_0[0], r14_0[1]} * TP[0] + (f32x2_t){r14_1[0], r14_1[1]} * TP[2] + (f32x2_t){r14_2[0], r14_2[1]} * TP[4] + (f32x2_t){r14_3[0], r14_3[1]} * TP[6]; const f32x2_t pb = (f32x2_t){r14_0[2], r14_0[3]} * TP[1] + (f32x2_t){r14_1[2], r14_1[3]} * TP[3] + (f32x2_t){r14_2[2], r14_2[3]} * TP[5]; const f32x2_t ps = pa + pb;
                  Tr[14] = (ps[0] + ps[1]) + (1.0f - fminf(fabsf(cf - 14.0f), 1.0f)); TP[7][0] = Tr[14]; }
                __builtin_amdgcn_sched_barrier(0);
                int o17 = abase_i + 1088; asm volatile("" : "+v"(o17) : "v"(Tr[14]));
                const f32x4 r17_0 = *(const LAS f32x4*)(Aab + o17 + 0); const f32x4 r17_1 = *(const LAS f32x4*)(Aab + o17 + 4); const f32x4 r17_2 = *(const LAS f32x4*)(Aab + o17 + 8); const f32x4 r17_3 = *(const LAS f32x4*)(Aab + o17 + 12); const f32x4 r17_4 = *(const LAS f32x4*)(Aab + o17 + 16);
                __builtin_amdgcn_sched_barrier(0);
                { const f32x2_t pa = (f32x2_t){r15_0[0], r15_0[1]} * TP[0] + (f32x2_t){r15_1[0], r15_1[1]} * TP[2] + (f32x2_t){r15_2[0], r15_2[1]} * TP[4] + (f32x2_t){r15_3[0], r15_3[1]} * TP[6]; const f32x2_t pb = (f32x2_t){r15_0[2], r15_0[3]} * TP[1] + (f32x2_t){r15_1[2], r15_1[3]} * TP[3] + (f32x2_t){r15_2[2], r15_2[3]} * TP[5] + (f32x2_t){r15_3[2], r15_3[3]} * TP[7]; const f32x2_t ps = pa + pb;
                  Tr[15] = (ps[0] + ps[1]) + (1.0f - fminf(fabsf(cf - 15.0f), 1.0f)); TP[7][1] = Tr[15]; }
                __builtin_amdgcn_sched_barrier(0);
                int o18 = abase_i + 1152; asm volatile("" : "+v"(o18) : "v"(Tr[15]));
                const f32x4 r18_0 = *(const LAS f32x4*)(Aab + o18 + 0); const f32x4 r18_1 = *(const LAS f32x4*)(Aab + o18 + 4); const f32x4 r18_2 = *(const LAS f32x4*)(Aab + o18 + 8); const f32x4 r18_3 = *(const LAS f32x4*)(Aab + o18 + 12); const f32x4 r18_4 = *(const LAS f32x4*)(Aab + o18 + 16);
                __builtin_amdgcn_sched_barrier(0);
                { const f32x2_t pa = (f32x2_t){r16_0[0], r16_0[1]} * TP[0] + (f32x2_t){r16_1[0], r16_1[1]} * TP[2] + (f32x2_t){r16_2[0], r16_2[1]} * TP[4] + (f32x2_t){r16_3[0], r16_3[1]} * TP[6]; const f32x2_t pb = (f32x2_t){r16_0[2], r16_0[3]} * TP[1] + (f32x2_t){r16_1[2], r16_1[3]} * TP[3] + (f32x2_t){r16_2[2], r16_2[3]} * TP[5] + (f32x2_t){r16_3[2], r16_3[3]} * TP[7]; const f32x2_t ps = pa + pb;
                  Tr[16] = (ps[0] + ps[1]) + (1.0f - fminf(fabsf(cf - 16.0f), 1.0f)); TP[8][0] = Tr[16]; }
                __builtin_amdgcn_sched_barrier(0);
                int o19 = abase_i + 1216; asm volatile("" : "+v"(o19) : "v"(Tr[16]));
                const f32x4 r19_0 = *(const LAS f32x4*)(Aab + o19 + 0); const f32x4 r19_1 = *(const LAS f32x4*)(Aab + o19 + 4); const f32x4 r19_2 = *(const LAS f32x4*)(Aab + o19 + 8); const f32x4 r19_3 = *(const LAS f32x4*)(Aab + o19 + 12); const f32x4 r19_4 = *(const LAS f32x4*)(Aab + o19 + 16);
                __builtin_amdgcn_sched_barrier(0);
                { const f32x2_t pa = (f32x2_t){r17_0[0], r17_0[1]} * TP[0] + (f32x2_t){r17_1[0], r17_1[1]} * TP[2] + (f32x2_t){r17_2[0], r17_2[1]} * TP[4] + (f32x2_t){r17_3[0], r17_3[1]} * TP[6] + (f32x2_t){r17_4[0], r17_4[1]} * TP[8]; const f32x2_t pb = (f32x2_t){r17_0[2], r17_0[3]} * TP[1] + (f32x2_t){r17_1[2], r17_1[3]} * TP[3] + (f32x2_t){r17_2[2], r17_2[3]} * TP[5] + (f32x2_t){r17_3[2], r17_3[3]} * TP[7]; const f32x2_t ps = pa + pb;
                  Tr[17] = (ps[0] + ps[1]) + (1.0f - fminf(fabsf(cf - 17.0f), 1.0f)); TP[8][1] = Tr[17]; }
                __builtin_amdgcn_sched_barrier(0);
                int o20 = abase_i + 1280; asm volatile("" : "+v"(o20) : "v"(Tr[17]));
                const f32x4 r20_0 = *(const LAS f32x4*)(Aab + o20 + 0); const f32x4 r20_1 = *(const LAS f32x4*)(Aab + o20 + 4); const f32x4 r20_2 = *(const LAS f32x4*)(Aab + o20 + 8); const f32x4 r20_3 = *(const LAS f32x4*)(Aab + o20 + 12); const f32x4 r20_4 = *(const LAS f32x4*)(Aab + o20 + 16);
                __builtin_amdgcn_sched_barrier(0);
                { const f32x2_t pa = (f32x2_t){r18_0[0], r18_0[1]} * TP[0] + (f32x2_t){r18_1[0], r18_1[1]} * TP[2] + (f32x2_t){r18_2[0], r18_2[1]} * TP[4] + (f32x2_t){r18_3[0], r18_3[1]} * TP[6] + (f32x2_t){r18_4[0], r18_4[1]} * TP[8]; const f32x2_t pb = (f32x2_t){r18_0[2], r18_0[3]} * TP[1] + (f32x2_t){r18_1[2], r18_1[3]} * TP[3] + (f32x2_t){r18_2[2], r18_2[3]} * TP[5] + (f32x2_t){r18_3[2], r18_3[3]} * TP[7]; const f32x2_t ps = pa + pb;
                  Tr[18] = (ps[0] + ps[1]) + (1.0f - fminf(fabsf(cf - 18.0f), 1.0f)); TP[9][0] = Tr[18]; }
                __builtin_amdgcn_sched_barrier(0);
                int o21 = abase_i + 1344; asm volatile("" : "+v"(o21) : "v"(Tr[18]));
                const f32x4 r21_0 = *(const LAS f32x4*)(Aab + o21 + 0); const f32x4 r21_1 = *(const LAS f32x4*)(Aab + o21 + 4); const f32x4 r21_2 = *(const LAS f32x4*)(Aab + o21 + 8); const f32x4 r21_3 = *(const LAS f32x4*)(Aab + o21 + 12); const f32x4 r21_4 = *(const LAS f32x4*)(Aab + o21 + 16); const f32x4 r21_5 = *(const LAS f32x4*)(Aab + o21 + 20);
                __builtin_amdgcn_sched_barrier(0);
                { const f32x2_t pa = (f32x2_t){r19_0[0], r19_0[1]} * TP[0] + (f32x2_t){r19_1[0], r19_1[1]} * TP[2] + (f32x2_t){r19_2[0], r19_2[1]} * TP[4] + (f32x2_t){r19_3[0], r19_3[1]} * TP[6] + (f32x2_t){r19_4[0], r19_4[1]} * TP[8]; const f32x2_t pb = (f32x2_t){r19_0[2], r19_0[3]} * TP[1] + (f32x2_t){r19_1[2], r19_1[3]} * TP[3] + (f32x2_t){r19_2[2], r19_2[3]} * TP[5] + (f32x2_t){r19_3[2], r19_3[3]} * TP[7] + (f32x2_t){r19_4[2], r19_4[3]} * TP[9]; const f32x2_t ps = pa + pb;
                  Tr[19] = (ps[0] + ps[1]) + (1.0f - fminf(fabsf(cf - 19.0f), 1.0f)); TP[9][1] = Tr[19]; }
                __builtin_amdgcn_sched_barrier(0);
                int o22 = abase_i + 1408; asm volatile("" : "+v"(o22) : "v"(Tr[19]));
                const f32x4 r22_0 = *(const LAS f32x4*)(Aab + o22 + 0); const f32x4 r22_1 = *(const LAS f32x4*)(Aab + o22 + 4); const f32x4 r22_2 = *(const LAS f32x4*)(Aab + o22 + 8); const f32x4 r22_3 = *(const LAS f32x4*)(Aab + o22 + 12); const f32x4 r22_4 = *(const LAS f32x4*)(Aab + o22 + 16); const f32x4 r22_5 = *(const LAS f32x4*)(Aab + o22 + 20);
                __builtin_amdgcn_sched_barrier(0);
                { const f32x2_t pa = (f32x2_t){r20_0[0], r20_0[1]} * TP[0] + (f32x2_t){r20_1[0], r20_1[1]} * TP[2] + (f32x2_t){r20_2[0], r20_2[1]} * TP[4] + (f32x2_t){r20_3[0], r20_3[1]} * TP[6] + (f32x2_t){r20_4[0], r20_4[1]} * TP[8]; const f32x2_t pb = (f32x2_t){r20_0[2], r20_0[3]} * TP[1] + (f32x2_t){r20_1[2], r20_1[3]} * TP[3] + (f32x2_t){r20_2[2], r20_2[3]} * TP[5] + (f32x2_t){r20_3[2], r20_3[3]} * TP[7] + (f32x2_t){r20_4[2], r20_4[3]} * TP[9]; const f32x2_t ps = pa + pb;
                  Tr[20] = (ps[0] + ps[1]) + (1.0f - fminf(fabsf(cf - 20.0f), 1.0f)); TP[10][0] = Tr[20]; }
                __builtin_amdgcn_sched_barrier(0);
                int o23 = abase_i + 1472; asm volatile("" : "+v"(o23) : "v"(Tr[20]));
                const f32x4 r23_0 = *(const LAS f32x4*)(Aab + o23 + 0); const f32x4 r23_1 = *(const LAS f32x4*)(Aab + o23 + 4); const f32x4 r23_2 = *(const LAS f32x4*)(Aab + o23 + 8); const f32x4 r23_3 = *(const LAS f32x4*)(Aab + o23 + 12); const f32x4 r23_4 = *(const LAS f32x4*)(Aab + o23 + 16); const f32x4 r23_5 = *(const LAS f32x4*)(Aab + o23 + 20);
                __builtin_amdgcn_sched_barrier(0);
                { const f32x2_t pa = (f32x2_t){r21_0[0], r21_0[1]} * TP[0] + (f32x2_t){r21_1[0], r21_1[1]} * TP[2] + (f32x2_t){r21_2[0], r21_2[1]} * TP[4] + (f32x2_t){r21_3[0], r21_3[1]} * TP[6] + (f32x2_t){r21_4[0], r21_4[1]} * TP[8] + (f32x2_t){r21_5[0], r21_5[1]} * TP[10]; const f32x2_t pb = (f32x2_t){r21_0[2], r21_0[3]} * TP[1] + (f32x2_t){r21_1[2], r21_1[3]} * TP[3] + (f32x2_t){r21_2[2], r21_2[3]} * TP[5] + (f32x2_t){r21_3[2], r21_3[3]} * TP[7] + (f32x2_t){r21_4[2], r21_4[3]} * TP[9]; const f32x2_t ps = pa + pb;
                  Tr[21] = (ps[0] + ps[1]) + (1.0f - fminf(fabsf(cf - 21.0f), 1.0f)); TP[10][1] = Tr[21]; }
                __builtin_amdgcn_sched_barrier(0);
                int o24 = abase_i + 1536; asm volatile("" : "+v"(o24) : "v"(Tr[21]));
                const f32x4 r24_0 = *(const LAS f32x4*)(Aab + o24 + 0); const f32x4 r24_1 = *(const LAS f32x4*)(Aab + o24 + 4); const f32x4 r24_2 = *(const LAS f32x4*)(Aab + o24 + 8); const f32x4 r24_3 = *(const LAS f32x4*)(Aab + o24 + 12); const f32x4 r24_4 = *(const LAS f32x4*)(Aab + o24 + 16); const f32x4 r24_5 = *(const LAS f32x4*)(Aab + o24 + 20);
                __builtin_amdgcn_sched_barrier(0);
                { const f32x2_t pa = (f32x2_t){r22_0[0], r22_0[1]} * TP[0] + (f32x2_t){r22_1[0], r22_1[1]} * TP[2] + (f32x2_t){r22_2[0], r22_2[1]} * TP[4] + (f32x2_t){r22_3[0], r22_3[1]} * TP[6] + (f32x2_t){r22_4[0], r22_4[1]} * TP[8] + (f32x2_t){r22_5[0], r22_5[1]} * TP[10]; const f32x2_t pb = (f32x2_t){r22_0[2], r22_0[3]} * TP[1] + (f32x2_t){r22_1[2], r22_1[3]} * TP[3] + (f32x2_t){r22_2[2], r22_2[3]} * TP[5] + (f32x2_t){r22_3[2], r22_3[3]} * TP[7] + (f32x2_t){r22_4[2], r22_4[3]} * TP[9]; const f32x2_t ps = pa + pb;
                  Tr[22] = (ps[0] + ps[1]) + (1.0f - fminf(fabsf(cf - 22.0f), 1.0f)); TP[11][0] = Tr[22]; }
                __builtin_amdgcn_sched_barrier(0);
                int o25 = abase_i + 1600; asm volatile("" : "+v"(o25) : "v"(Tr[22]));
                const f32x4 r25_0 = *(const LAS f32x4*)(Aab + o25 + 0); const f32x4 r25_1 = *(const LAS f32x4*)(Aab + o25 + 4); const f32x4 r25_2 = *(const LAS f32x4*)(Aab + o25 + 8); const f32x4 r25_3 = *(const LAS f32x4*)(Aab + o25 + 12); const f32x4 r25_4 = *(const LAS f32x4*)(Aab + o25 + 16); const f32x4 r25_5 = *(const LAS f32x4*)(Aab + o25 + 20); const f32x4 r25_6 = *(const LAS f32x4*)(Aab + o25 + 24);
                __builtin_amdgcn_sched_barrier(0);
                { const f32x2_t pa = (f32x2_t){r23_0[0], r23_0[1]} * TP[0] + (f32x2_t){r23_1[0], r23_1[1]} * TP[2] + (f32x2_t){r23_2[0], r23_2[1]} * TP[4] + (f32x2_t){r23_3[0], r23_3[1]} * TP[6] + (f32x2_t){r23_4[0], r23_4[1]} * TP[8] + (f32x2_t){r23_5[0], r23_5[1]} * TP[10]; const f32x2_t pb = (f32x2_t){r23_0[2], r23_0[3]} * TP[1] + (f32x2_t){r23_1[2], r23_1[3]} * TP[3] + (f32x2_t){r23_2[2], r23_2[3]} * TP[5] + (f32x2_t){r23_3[2], r23_3[3]} * TP[7] + (f32x2_t){r23_4[2], r23_4[3]} * TP[9] + (f32x2_t){r23_5[2], r23_5[3]} * TP[11]; const f32x2_t ps = pa + pb;
                  Tr[23] = (ps[0] + ps[1]) + (1.0f - fminf(fabsf(cf - 23.0f), 1.0f)); TP[11][1] = Tr[23]; }
                __builtin_amdgcn_sched_barrier(0);
                int o26 = abase_i + 1664; asm volatile("" : "+v"(o26) : "v"(Tr[23]));
                const f32x4 r26_0 = *(const LAS f32x4*)(Aab + o26 + 0); const f32x4 r26_1 = *(const LAS f32x4*)(Aab + o26 + 4); const f32x4 r26_2 = *(const LAS f32x4*)(Aab + o26 + 8); const f32x4 r26_3 = *(const LAS f32x4*)(Aab + o26 + 12); const f32x4 r26_4 = *(const LAS f32x4*)(Aab + o26 + 16); const f32x4 r26_5 = *(const LAS f32x4*)(Aab + o26 + 20); const f32x4 r26_6 = *(const LAS f32x4*)(Aab + o26 + 24);
                __builtin_amdgcn_sched_barrier(0);
                { const f32x2_t pa = (f32x2_t){r24_0[0], r24_0[1]} * TP[0] + (f32x2_t){r24_1[0], r24_1[1]} * TP[2] + (f32x2_t){r24_2[0], r24_2[1]} * TP[4] + (f32x2_t){r24_3[0], r24_3[1]} * TP[6] + (f32x2_t){r24_4[0], r24_4[1]} * TP[8] + (f32x2_t){r24_5[0], r24_5[1]} * TP[10]; const f32x2_t pb = (f32x2_t){r24_0[2], r24_0[3]} * TP[1] + (f32x2_t){r24_1[2], r24_1[3]} * TP[3] + (f32x2_t){r24_2[2], r24_2[3]} * TP[5] + (f32x2_t){r24_3[2], r24_3[3]} * TP[7] + (f32x2_t){r24_4[2], r24_4[3]} * TP[9] + (f32x2_t){r24_5[2], r24_5[3]} * TP[11]; const f32x2_t ps = pa + pb;
                  Tr[24] = (ps[0] + ps[1]) + (1.0f - fminf(fabsf(cf - 24.0f), 1.0f)); TP[12][0] = Tr[24]; }
                __builtin_amdgcn_sched_barrier(0);
                int o27 = abase_i + 1728; asm volatile("" : "+v"(o27) : "v"(Tr[24]));
                const f32x4 r27_0 = *(const LAS f32x4*)(Aab + o27 + 0); const f32x4 r27_1 = *(const LAS f32x4*)(Aab + o27 + 4); const f32x4 r27_2 = *(const LAS f32x4*)(Aab + o27 + 8); const f32x4 r27_3 = *(const LAS f32x4*)(Aab + o27 + 12); const f32x4 r27_4 = *(const LAS f32x4*)(Aab + o27 + 16); const f32x4 r27_5 = *(const LAS f32x4*)(Aab + o27 + 20); const f32x4 r27_6 = *(const LAS f32x4*)(Aab + o27 + 24);
                __builtin_amdgcn_sched_barrier(0);
                { const f32x2_t pa = (f32x2_t){r25_0[0], r25_0[1]} * TP[0] + (f32x2_t){r25_1[0], r25_1[1]} * TP[2] + (f32x2_t){r25_2[0], r25_2[1]} * TP[4] + (f32x2_t){r25_3[0], r25_3[1]} * TP[6] + (f32x2_t){r25_4[0], r25_4[1]} * TP[8] + (f32x2_t){r25_5[0], r25_5[1]} * TP[10] + (f32x2_t){r25_6[0], r25_6[1]} * TP[12]; const f32x2_t pb = (f32x2_t){r25_0[2], r25_0[3]} * TP[1] + (f32x2_t){r25_1[2], r25_1[3]} * TP[3] + (f32x2_t){r25_2[2], r25_2[3]} * TP[5] + (f32x2_t){r25_3[2], r25_3[3]} * TP[7] + (f32x2_t){r25_4[2], r25_4[3]} * TP[9] + (f32x2_t){r25_5[2], r25_5[3]} * TP[11]; const f32x2_t ps = pa + pb;
                  Tr[25] = (ps[0] + ps[1]) + (1.0f - fminf(fabsf(cf - 25.0f), 1.0f)); TP[12][1] = Tr[25]; }
                __builtin_amdgcn_sched_barrier(0);
                int o28 = abase_i + 1792; asm volatile("" : "+v"(o28) : "v"(Tr[25]));
                const f32x4 r28_0 = *(const LAS f32x4*)(Aab + o28 + 0); const f32x4 r28_1 = *(const LAS f32x4*)(Aab + o28 + 4); const f32x4 r28_2 = *(const LAS f32x4*)(Aab + o28 + 8); const f32x4 r28_3 = *(const LAS f32x4*)(Aab + o28 + 12); const f32x4 r28_4 = *(const LAS f32x4*)(Aab + o28 + 16); const f32x4 r28_5 = *(const LAS f32x4*)(Aab + o28 + 20); const f32x4 r28_6 = *(const LAS f32x4*)(Aab + o28 + 24);
                __builtin_amdgcn_sched_barrier(0);
                { const f32x2_t pa = (f32x2_t){r26_0[0], r26_0[1]} * TP[0] + (f32x2_t){r26_1[0], r26_1[1]} * TP[2] + (f32x2_t){r26_2[0], r26_2[1]} * TP[4] + (f32x2_t){r26_3[0], r26_3[1]} * TP[6] + (f32x2_t){r26_4[0], r26_4[1]} * TP[8] + (f32x2_t){r26_5[0], r26_5[1]} * TP[10] + (f32x2_t){r26_6[0], r26_6[1]} * TP[12]; const f32x2_t pb = (f32x2_t){r26_0[2], r26_0[3]} * TP[1] + (f32x2_t){r26_1[2], r26_1[3]} * TP[3] + (f32x2_t){r26_2[2], r26_2[3]} * TP[5] + (f32x2_t){r26_3[2], r26_3[3]} * TP[7] + (f32x2_t){r26_4[2], r26_4[3]} * TP[9] + (f32x2_t){r26_5[2], r26_5[3]} * TP[11]; const f32x2_t ps = pa + pb;
                  Tr[26] = (ps[0] + ps[1]) + (1.0f - fminf(fabsf(cf - 26.0f), 1.0f)); TP[13][0] = Tr[26]; }
                __builtin_amdgcn_sched_barrier(0);
                int o29 = abase_i + 1856; asm volatile("" : "+v"(o29) : "v"(Tr[26]));
                const f32x4 r29_0 = *(const LAS f32x4*)(Aab + o29 + 0); const f32x4 r29_1 = *(const LAS f32x4*)(Aab + o29 + 4); const f32x4 r29_2 = *(const LAS f32x4*)(Aab + o29 + 8); const f32x4 r29_3 = *(const LAS f32x4*)(Aab + o29 + 12); const f32x4 r29_4 = *(const LAS f32x4*)(Aab + o29 + 16); const f32x4 r29_5 = *(const LAS f32x4*)(Aab + o29 + 20); const f32x4 r29_6 = *(const LAS f32x4*)(Aab + o29 + 24); const f32x4 r29_7 = *(const LAS f32x4*)(Aab + o29 + 28);
                __builtin_amdgcn_sched_barrier(0);
                { const f32x2_t pa = (f32x2_t){r27_0[0], r27_0[1]} * TP[0] + (f32x2_t){r27_1[0], r27_1[1]} * TP[2] + (f32x2_t){r27_2[0], r27_2[1]} * TP[4] + (f32x2_t){r27_3[0], r27_3[1]} * TP[6] + (f32x2_t){r27_4[0], r27_4[1]} * TP[8] + (f32x2_t){r27_5[0], r27_5[1]} * TP[10] + (f32x2_t){r27_6[0], r27_6[1]} * TP[12]; const f32x2_t pb = (f32x2_t){r27_0[2], r27_0[3]} * TP[1] + (f32x2_t){r27_1[2], r27_1[3]} * TP[3] + (f32x2_t){r27_2[2], r27_2[3]} * TP[5] + (f32x2_t){r27_3[2], r27_3[3]} * TP[7] + (f32x2_t){r27_4[2], r27_4[3]} * TP[9] + (f32x2_t){r27_5[2], r27_5[3]} * TP[11] + (f32x2_t){r27_6[2], r27_6[3]} * TP[13]; const f32x2_t ps = pa + pb;
                  Tr[27] = (ps[0] + ps[1]) + (1.0f - fminf(fabsf(cf - 27.0f), 1.0f)); TP[13][1] = Tr[27]; }
                __builtin_amdgcn_sched_barrier(0);
                int o30 = abase_i + 1920; asm volatile("" : "+v"(o30) : "v"(Tr[27]));
                const f32x4 r30_0 = *(const LAS f32x4*)(Aab + o30 + 0); const f32x4 r30_1 = *(const LAS f32x4*)(Aab + o30 + 4); const f32x4 r30_2 = *(const LAS f32x4*)(Aab + o30 + 8); const f32x4 r30_3 = *(const LAS f32x4*)(Aab + o30 + 12); const f32x4 r30_4 = *(const LAS f32x4*)(Aab + o30 + 16); const f32x4 r30_5 = *(const LAS f32x4*)(Aab + o30 + 20); const f32x4 r30_6 = *(const LAS f32x4*)(Aab + o30 + 24); const f32x4 r30_7 = *(const LAS f32x4*)(Aab + o30 + 28);
                __builtin_amdgcn_sched_barrier(0);
                { const f32x2_t pa = (f32x2_t){r28_0[0], r28_0[1]} * TP[0] + (f32x2_t){r28_1[0], r28_1[1]} * TP[2] + (f32x2_t){r28_2[0], r28_2[1]} * TP[4] + (f32x2_t){r28_3[0], r28_3[1]} * TP[6] + (f32x2_t){r28_4[0], r28_4[1]} * TP[8] + (f32x2_t){r28_5[0], r28_5[1]} * TP[10] + (f32x2_t){r28_6[0], r28_6[1]} * TP[12]; const f32x2_t pb = (f32x2_t){r28_0[2], r28_0[3]} * TP[1] + (f32x2_t){r28_1[2], r28_1[3]} * TP[3] + (f32x2_t){r28_2[2], r28_2[3]} * TP[5] + (f32x2_t){r28_3[2], r28_3[3]} * TP[7] + (f32x2_t){r28_4[2], r28_4[3]} * TP[9] + (f32x2_t){r28_5[2], r28_5[3]} * TP[11] + (f32x2_t){r28_6[2], r28_6[3]} * TP[13]; const f32x2_t ps = pa + pb;
                  Tr[28] = (ps[0] + ps[1]) + (1.0f - fminf(fabsf(cf - 28.0f), 1.0f)); TP[14][0] = Tr[28]; }
                __builtin_amdgcn_sched_barrier(0);
                int o31 = abase_i + 1984; asm volatile("" : "+v"(o31) : "v"(Tr[28]));
                const f32x4 r31_0 = *(const LAS f32x4*)(Aab + o31 + 0); const f32x4 r31_1 = *(const LAS f32x4*)(Aab + o31 + 4); const f32x4 r31_2 = *(const LAS f32x4*)(Aab + o31 + 8); const f32x4 r31_3 = *(const LAS f32x4*)(Aab + o31 + 12); const f32x4 r31_4 = *(const LAS f32x4*)(Aab + o31 + 16); const f32x4 r31_5 = *(const LAS f32x4*)(Aab + o31 + 20); const f32x4 r31_6 = *(const LAS f32x4*)(Aab + o31 + 24); const f32x4 r31_7 = *(const LAS f32x4*)(Aab + o31 + 28);
                __builtin_amdgcn_sched_barrier(0);
                { const f32x2_t pa = (f32x2_t){r29_0[0], r29_0[1]} * TP[0] + (f32x2_t){r29_1[0], r29_1[1]} * TP[2] + (f32x2_t){r29_2[0], r29_2[1]} * TP[4] + (f32x2_t){r29_3[0], r29_3[1]} * TP[6] + (f32x2_t){r29_4[0], r29_4[1]} * TP[8] + (f32x2_t){r29_5[0], r29_5[1]} * TP[10] + (f32x2_t){r29_6[0], r29_6[1]} * TP[12] + (f32x2_t){r29_7[0], r29_7[1]} * TP[14]; const f32x2_t pb = (f32x2_t){r29_0[2], r29_0[3]} * TP[1] + (f32x2_t){r29_1[2], r29_1[3]} * TP[3] + (f32x2_t){r29_2[2], r29_2[3]} * TP[5] + (f32x2_t){r29_3[2], r29_3[3]} * TP[7] + (f32x2_t){r29_4[2], r29_4[3]} * TP[9] + (f32x2_t){r29_5[2], r29_5[3]} * TP[11] + (f32x2_t){r29_6[2], r29_6[3]} * TP[13]; const f32x2_t ps = pa + pb;
                  Tr[29] = (ps[0] + ps[1]) + (1.0f - fminf(fabsf(cf - 29.0f), 1.0f)); TP[14][1] = Tr[29]; }
                __builtin_amdgcn_sched_barrier(0);
                __builtin_amdgcn_sched_barrier(0);
                { const f32x2_t pa = (f32x2_t){r30_0[0], r30_0[1]} * TP[0] + (f32x2_t){r30_1[0], r30_1[1]} * TP[2] + (f32x2_t){r30_2[0], r30_2[1]} * TP[4] + (f32x2_t){r30_3[0], r30_3[1]} * TP[6] + (f32x2_t){r30_4[0], r30_4[1]} * TP[8] + (f32x2_t){r30_5[0], r30_5[1]} * TP[10] + (f32x2_t){r30_6[0], r30_6[1]} * TP[12] + (f32x2_t){r30_7[0], r30_7[1]} * TP[14]; const f32x2_t pb = (f32x2_t){r30_0[2], r30_0[3]} * TP[1] + (f32x2_t){r30_1[2], r30_1[3]} * TP[3] + (f32x2_t){r30_2[2], r30_2[3]} * TP[5] + (f32x2_t){r30_3[2], r30_3[3]} * TP[7] + (f32x2_t){r30_4[2], r30_4[3]} * TP[9] + (f32x2_t){r30_5[2], r30_5[3]} * TP[11] + (f32x2_t){r30_6[2], r30_6[3]} * TP[13]; const f32x2_t ps = pa + pb;
                  Tr[30] = (ps[0] + ps[1]) + (1.0f - fminf(fabsf(cf - 30.0f), 1.0f)); TP[15][0] = Tr[30]; }
                __builtin_amdgcn_sched_barrier(0);
                __builtin_amdgcn_sched_barrier(0);
                { const f32x2_t pa = (f32x2_t){r31_0[0], r31_0[1]} * TP[0] + (f32x2_t){r31_1[0], r31_1[1]} * TP[2] + (f32x2_t){r31_2[0], r31_2[1]} * TP[4] + (f32x2_t){r31_3[0], r31_3[1]} * TP[6] + (f32x2_t){r31_4[0], r31_4[1]} * TP[8] + (f32x2_t){r31_5[0], r31_5[1]} * TP[10] + (f32x2_t){r31_6[0], r31_6[1]} * TP[12] + (f32x2_t){r31_7[0], r31_7[1]} * TP[14]; const f32x2_t pb = (f32x2_t){r31_0[2], r31_0[3]} * TP[1] + (f32x2_t){r31_1[2], r31_1[3]} * TP[3] + (f32x2_t){r31_2[2], r31_2[3]} * TP[5] + (f32x2_t){r31_3[2], r31_3[3]} * TP[7] + (f32x2_t){r31_4[2], r31_4[3]} * TP[9] + (f32x2_t){r31_5[2], r31_5[3]} * TP[11] + (f32x2_t){r31_6[2], r31_6[3]} * TP[13] + (f32x2_t){r31_7[2], r31_7[3]} * TP[15]; const f32x2_t ps = pa + pb;
                  Tr[31] = (ps[0] + ps[1]) + (1.0f - fminf(fabsf(cf - 31.0f), 1.0f)); TP[15][1] = Tr[31]; }
                __builtin_amdgcn_sched_barrier(0);
            }
#pragma unroll
            for (int t = 0; t < 32; ++t) {
                Tm[(32 * hb + t) * LDP + 32 * hb + c] = (bf16_t)f2bf(Tr[t]);
            }
            if (hb == 0) {
#pragma unroll
                for (int q = 0; q < 4; ++q) { u32x4 w; w.x = pk2(Tr[8 * q], Tr[8 * q + 1]); w.y = pk2(Tr[8 * q + 2], Tr[8 * q + 3]); w.z = pk2(Tr[8 * q + 4], Tr[8 * q + 5]); w.w = pk2(Tr[8 * q + 6], Tr[8 * q + 7]);
                    *(LAS u32x4*)(TT + c * LDQ + 8 * q) = w; }
            }
            LDS_WAIT();
            f32x4 W[2][2];
#pragma unroll
            for (int mi = 0; mi < 2; ++mi)
#pragma unroll
                for (int ni = 0; ni < 2; ++ni) {
                    W[mi][ni] = (f32x4){0.f, 0.f, 0.f, 0.f};
                    MMA16(*(const LAS bf16x8*)(AbBA + (16 * mi + fr) * LDQ + fq * 8), *(const LAS bf16x8*)(TT + (16 * ni + fr) * LDQ + fq * 8), W[mi][ni]);
                    st4lds(WsT + (16 * ni + fr) * LDQ + 16 * mi + 4 * fq, W[mi][ni]);
                }
            LDS_WAIT();
#pragma unroll
            for (int mi = 0; mi < 2; ++mi)
#pragma unroll
                for (int ni = 0; ni < 2; ++ni) {
                    f32x4 r4 = (f32x4){0.f, 0.f, 0.f, 0.f};
                    MMA16(*(const LAS bf16x8*)(WsT + (16 * mi + fr) * LDQ + fq * 8), *(const LAS bf16x8*)(Tm + (32 + 16 * ni + fr) * LDP + 32 + fq * 8), r4);
                    st4lds(Tm + (32 + 16 * ni + fr) * LDP + 16 * mi + 4 * fq, r4);
                }
        }
        SBAR();
        {
            const int i0 = 16 * nio + fr;
            const bf16x8 s0 = ldfrag(Sb, i0, 0, fq), s1 = ldfrag(Sb, i0, 1, fq), v0 = ldfragT(VT, i0, 0, fq), v1 = ldfragT(VT, i0, 1, fq);
            bf16x8 fa[2][2], fk[2][2], fh[2][2]; f32x4 eg[2];
#pragma unroll
            for (int mm = 0; mm < 2; ++mm) {
                const int m0 = 16 * (mo0 + mm) + fr;
                fa[mm][0] = ldfrag(At, m0, 0, fq); fa[mm][1] = ldfrag(At, m0, 1, fq);
                fk[mm][0] = ldfrag(Aak, m0, 0, fq); fk[mm][1] = ldfrag(Aak, m0, 1, fq);
                fh[mm][0] = ldfragT(KhT, m0, 0, fq); fh[mm][1] = ldfragT(KhT, m0, 1, fq);
                eg[mm] = *(const LAS f32x4*)(EGL + 16 * (mo0 + mm) + 4 * fq);
            }
            __builtin_amdgcn_sched_barrier(0);
            f32x4 Pacc[2];
#pragma unroll
            for (int mm = 0; mm < 2; ++mm) {
                Pacc[mm] = (f32x4){0.f, 0.f, 0.f, 0.f};
                MMA16(fa[mm][0], s0, Pacc[mm]); MMA16(fa[mm][1], s1, Pacc[mm]);
                MMA16(fk[mm][0], v0, Pacc[mm]); MMA16(fk[mm][1], v1, Pacc[mm]);
                Sacc[mm] = Sacc[mm] * eg[mm];
                MMA16(fh[mm][0], v0, Sacc[mm]); MMA16(fh[mm][1], v1, Sacc[mm]);
            }
            __builtin_amdgcn_sched_barrier(0);
#pragma unroll
            for (int mm = 0; mm < 2; ++mm) st4lds(PT + i0 * LDP + 16 * (mo0 + mm) + 4 * fq, Pacc[mm]);
        }
        SBAR();
        { const int nc_ = chunk + 1 < nch ? chunk + 1 : chunk; SCAN_ISSUE(nc_); }
        {
            const int i0 = 16 * nio + fr;
            const bf16x8 p0 = ldfrag(PT, i0, 0, fq), p1 = ldfrag(PT, i0, 1, fq);
            bf16x8 ft[2][2];
#pragma unroll
            for (int mm = 0; mm < 2; ++mm) { ft[mm][0] = ldfrag(Tm, 16 * (mo0 + mm) + fr, 0, fq); ft[mm][1] = ldfrag(Tm, 16 * (mo0 + mm) + fr, 1, fq); }
            __builtin_amdgcn_sched_barrier(0);
            f32x4 Uacc[2];
#pragma unroll
            for (int mm = 0; mm < 2; ++mm) {
                Uacc[mm] = (f32x4){0.f, 0.f, 0.f, 0.f};
                MMA16(ft[mm][0], p0, Uacc[mm]); MMA16(ft[mm][1], p1, Uacc[mm]);
            }
            __builtin_amdgcn_sched_barrier(0);
#pragma unroll
            for (int mm = 0; mm < 2; ++mm) st4lds(UT + i0 * LDP + 16 * (mo0 + mm) + 4 * fq, Uacc[mm]);
        }
        SBAR();
        {
            const int i0 = 16 * nio + fr;
            const bf16x8 u0 = ldfrag(UT, i0, 0, fq), u1 = ldfrag(UT, i0, 1, fq);
            const int tl = 16 * nio + fr;
            const bf16x8 rt0 = ldfrag(Rt, tl, 0, fq), rt1 = ldfrag(Rt, tl, 1, fq), ak0 = ldfrag(Ark, tl, 0, fq), ak1 = ldfrag(Ark, tl, 1, fq), ab0 = ldfrag(Arb, tl, 0, fq), ab1 = ldfrag(Arb, tl, 1, fq);
            bf16x8 fb[2][2], fs[2][2], fv[2][2], fu[2][2];
#pragma unroll
            for (int mm = 0; mm < 2; ++mm) {
                const int m0 = 16 * (mo0 + mm) + fr;
                fb[mm][0] = ldfragT(BhT, m0, 0, fq); fb[mm][1] = ldfragT(BhT, m0, 1, fq);
                fs[mm][0] = ldfrag(Sb, m0, 0, fq); fs[mm][1] = ldfrag(Sb, m0, 1, fq);
                fv[mm][0] = ldfragT(VT, m0, 0, fq); fv[mm][1] = ldfragT(VT, m0, 1, fq);
                fu[mm][0] = ldfrag(UT, m0, 0, fq); fu[mm][1] = ldfrag(UT, m0, 1, fq);
            }
            __builtin_amdgcn_sched_barrier(0);
            f32x4 Yacc[2];
#pragma unroll
            for (int mm = 0; mm < 2; ++mm) {
                MMA16(fb[mm][0], u0, Sacc[mm]); MMA16(fb[mm][1], u1, Sacc[mm]);
                Yacc[mm] = (f32x4){0.f, 0.f, 0.f, 0.f};
                MMA16(fs[mm][0], rt0, Yacc[mm]); MMA16(fs[mm][1], rt1, Yacc[mm]);
                MMA16(fv[mm][0], ak0, Yacc[mm]); MMA16(fv[mm][1], ak1, Yacc[mm]);
                MMA16(fu[mm][0], ab0, Yacc[mm]); MMA16(fu[mm][1], ab1, Yacc[mm]);
            }
            __builtin_amdgcn_sched_barrier(0);
            SBAR();
            const int ypos = chunk * 64 + tl, yt = dir ? T - 1 - ypos : ypos;
            const size_t yoff = (size_t)(row_base + yt) * DM + h * 64;
#pragma unroll
            for (int mm = 0; mm < 2; ++mm) {
                st4lds(Sb + i0 * LDP + 16 * (mo0 + mm) + 4 * fq, Sacc[mm]);
                const int ic = 16 * (mo0 + mm) + 4 * fq;
                if (mode == 2) {
                    const int tloc = dir ? yt : yt - 2048;
                    st4bf((bf16_t*)(a.ws + WS_ZB) + ((size_t)((b * 16 + h) * 2 + dir) * 2048 + tloc) * 64 + ic, Yacc[mm]);
                } else if (ysc != 0.f) {
                    st4bf((dir == 0 ? (bf16_t*)a.out + YF_OFF : (bf16_t*)(a.ws + WS_H)) + yoff + ic, Yacc[mm]);
                }
            }
        }
    }
    if (!lat) {
        const int i = 16 * nio + fr;
#pragma unroll
        for (int mm = 0; mm < 2; ++mm)
            *(f32x4*)(a.out + (size_t)NTOK * DM + ((((size_t)b * 2 + dir) * 16 + h) * 64 + i) * 64 + 16 * (mo0 + mm) + 4 * fq) = Sacc[mm];
    } else if (mode == 0 && cend < T / 64) {
        const int i = 16 * nio + fr;
#pragma unroll
        for (int mm = 0; mm < 2; ++mm)
            st4bf((bf16_t*)(a.ws + WS_SAB) + ((size_t)((b * 16 + h) * 2 + dir) * 64 + i) * 64 + 16 * (mo0 + mm) + 4 * fq, Sacc[mm]);
    }
    __syncthreads();
}
__device__ __forceinline__ void phase_scan(const Args& a, LAS unsigned char* lds) {
    const int nb = gridDim.x, bx = blockIdx.x;
    for (int it = 0;; ++it) {
        int lat, c, cbeg = 0, cend, mode = 0;
        if (nb >= 256) {
            if (bx < 192) { if (it) break; lat = 1; c = bx & 63; const int role = bx >> 6; cbeg = role ? 32 : 0; cend = role ? 64 : 32; mode = role; }
            else { c = (bx - 192) + it * (nb - 192); if (c >= 512) break; lat = 0; cend = 4; }
        } else if (nb >= 128) {
            if (bx < 64) { if (it) break; lat = 1; c = bx; cend = 64; }
            else { c = (bx - 64) + it * (nb - 64); if (c >= 512) break; lat = 0; cend = 4; }
        } else {
            const int task = bx + it * nb; if (task >= 64 + 512) break;
            lat = task < 64; c = lat ? task : task - 64; cend = lat ? 64 : 4;
        }
        scan_chain(a, lds, lat, c >> 5, (c >> 1) & 15, c & 1, 1.0f, cbeg, cend, mode);
    }
}
__device__ __forceinline__ void phase_fixup(const Args& a) {
    const int tid = threadIdx.x, lane = tid & 63, wv = tid >> 6, gw = blockIdx.x * 8 + wv, ngw = gridDim.x * 8, fr = lane & 15, fq = lane >> 4;
    const bf16_t* SAB = (const bf16_t*)(a.ws + WS_SAB); const bf16_t* ZB = (const bf16_t*)(a.ws + WS_ZB);
    for (int wt = gw; wt < 64 * 32; wt += ngw) {
        const int chain = wt >> 5, blk = wt & 31, dir = chain & 1, h = (chain >> 1) & 15, b = chain >> 5;
        const bf16_t* ap[4]; const bf16_t* bp[4]; f32x4 acc[4][4];
#pragma unroll
        for (int mi = 0; mi < 4; ++mi)
#pragma unroll
            for (int ni = 0; ni < 4; ++ni) acc[mi][ni] = (f32x4){0.f, 0.f, 0.f, 0.f};
#pragma unroll
        for (int mi = 0; mi < 4; ++mi) ap[mi] = SAB + ((size_t)chain * 64 + 16 * mi + fr) * 64;
#pragma unroll
        for (int ni = 0; ni < 4; ++ni) bp[ni] = ZB + ((size_t)chain * 2048 + blk * 64 + 16 * ni + fr) * 64;
        wave_mma<4, 4, 2>(ap, bp, acc, fq);
#pragma unroll
        for (int ni = 0; ni < 4; ++ni) {
            const int tloc = blk * 64 + 16 * ni + fr, t = dir ? tloc : 2048 + tloc;
            const size_t yoff = (size_t)(NTOK_C + b * 4096 + t) * DM + h * 64;
#pragma unroll
            for (int mi = 0; mi < 4; ++mi) {
                const int ic = 16 * mi + 4 * fq;
                bf16_t* p = (dir == 0 ? (bf16_t*)a.out + YF_OFF : (bf16_t*)(a.ws + WS_H)) + yoff + ic; const u32x2 w = *(const u32x2*)p;
                f32x4 o; o[0] = bflo(w.x) + acc[mi][ni][0]; o[1] = bfhi(w.x) + acc[mi][ni][1]; o[2] = bflo(w.y) + acc[mi][ni][2]; o[3] = bfhi(w.y) + acc[mi][ni][3];
                st4bf(p, o);
            }
        }
    }
}

__device__ __forceinline__ void phase_gn(const Args& a) {
    const int tid = threadIdx.x;
    bf16_t* U = (bf16_t*)(a.ws + WS_U);
    const bf16_t* YB = (const bf16_t*)(a.ws + WS_H);
    const bf16_t* YF = (const bf16_t*)a.out + YF_OFF;
    const bf16_t* BON = (const bf16_t*)a.out + BON_OFF;
    for (int idx = blockIdx.x * 512 + tid; idx < NTOK * 128; idx += gridDim.x * 512) {
        const int row = idx >> 7, c0 = (idx & 127) * 8;
        const u32x4 yfw = *(const u32x4*)(YF + (size_t)row * DM + c0), ybw = *(const u32x4*)(YB + (size_t)row * DM + c0);
        const u32x4 bw = *(const u32x4*)(BON + (size_t)row * DM + c0), gw = *(const u32x4*)(U + (size_t)row * LDU + C_GR + c0);
        const f32x4 lg0 = *(const f32x4*)(a.in[17] + c0), lg1 = *(const f32x4*)(a.in[17] + c0 + 4);
        const f32x4 lb0 = *(const f32x4*)(a.in[18] + c0), lb1 = *(const f32x4*)(a.in[18] + c0 + 4);
        float y[8], sm = 0.f;
#pragma unroll
        for (int e = 0; e < 8; ++e) { y[e] = bfel(yfw, e) + bfel(ybw, e); sm += y[e]; }
        sm += __shfl_xor(sm, 1); sm += __shfl_xor(sm, 2); sm += __shfl_xor(sm, 4);
        const float mean = sm * (1.0f / 64.0f);
        float vs = 0.f;
#pragma unroll
        for (int e = 0; e < 8; ++e) { y[e] -= mean; vs += y[e] * y[e]; }
        vs += __shfl_xor(vs, 1); vs += __shfl_xor(vs, 2); vs += __shfl_xor(vs, 4);
        const float rstd = rsqrtf(vs * (1.0f / 64.0f) + GN_EPS);
        float o[8];
#pragma unroll
        for (int e = 0; e < 8; ++e) { const float yn = y[e] * rstd * (e < 4 ? lg0[e] : lg1[e - 4]) + (e < 4 ? lb0[e] : lb1[e - 4]); o[e] = (yn + bfel(bw, e)) * bfel(gw, e); }
        *(u32x4*)(U + (size_t)row * LDU + C_GR + c0) = pack8(o);
    }
}

__device__ __forceinline__ void phase_final(const Args& a) {
    const int tid = threadIdx.x, lane = tid & 63, wv = tid >> 6, gw = blockIdx.x * 8 + wv, ngw = gridDim.x * 8;
    const float* fg = a.in[22];
    for (int row = gw; row < NTOK; row += ngw) {
        float* xr = a.out + (size_t)row * DM;
        f32x4 v[4]; float ss = 0.f;
#pragma unroll
        for (int j = 0; j < 4; ++j) { v[j] = *(const f32x4*)(xr + lane * 4 + 256 * j); ss += (v[j][0] * v[j][0] + v[j][1] * v[j][1]) + (v[j][2] * v[j][2] + v[j][3] * v[j][3]); }
        const float rstd = rsqrtf(wave_sum(ss) * (1.0f / DM) + RMS_EPS);
#pragma unroll
        for (int j = 0; j < 4; ++j) { const f32x4 g4 = *(const f32x4*)(fg + lane * 4 + 256 * j); *(f32x4*)(xr + lane * 4 + 256 * j) = v[j] * rstd * g4; }
    }
}

#define XB_TMO      128
#define XB_XCNT(j)  (256  + 64 * (j))
#define XB_XSUB(j)  (1280 + 64 * (j))
#define XB_XGEN(j)  (2304 + 64 * (j))
#define XB_TOP      3328
#define XB_TOPGEN   3392
#define XCD_BAR_WORDS 3456
#define XB_SPIN_CAP (1u << 18)
__device__ __forceinline__ unsigned xb_ld(unsigned* p)              { return __hip_atomic_load(p, __ATOMIC_RELAXED, __HIP_MEMORY_SCOPE_AGENT); }
__device__ __forceinline__ unsigned xb_add(unsigned* p, unsigned v) { return __hip_atomic_fetch_add(p, v, __ATOMIC_RELAXED, __HIP_MEMORY_SCOPE_AGENT); }
__device__ __forceinline__ unsigned xb_xcc_id() { return (unsigned)__builtin_amdgcn_s_getreg((3 << 11) | 20) & 0xFu; }
#define XB_SPIN(cond, bar) do { unsigned _sp = 0; while (cond) { __builtin_amdgcn_s_sleep(1); \
    if ((++_sp & 255u) == 0u) { if (xb_ld(&(bar)[XB_TMO])) break; if (_sp > XB_SPIN_CAP) { atomicAdd(&(bar)[XB_TMO], 1u); break; } } } } while (0)
struct XcdBarrier { unsigned* bar; unsigned x; volatile LAS unsigned* st; };
__device__ __forceinline__ XcdBarrier xcd_barrier_post(unsigned* bar, volatile LAS unsigned* st) {
    XcdBarrier b; b.bar = bar; b.x = xb_xcc_id(); b.st = st;
    if (threadIdx.x == 0) (void)xb_add(&bar[XB_XCNT(b.x)], 1u);
    return b;
}
__device__ __forceinline__ void xcd_barrier_complete(unsigned* bar, unsigned x, unsigned& nloc, unsigned& nx) {
    const unsigned G = gridDim.x * gridDim.y * gridDim.z;
    unsigned sum, cnt, mine, sp = 0u;
    for (;;) {
        sum = 0u; cnt = 0u; mine = 0u;
#pragma unroll
        for (unsigned j = 0; j < 16; ++j) { const unsigned c = xb_ld(&bar[XB_XCNT(j)]); sum += c; cnt += (c > 0u) ? 1u : 0u; mine = (j == x) ? c : mine; }
        if (sum == G) break;
        __builtin_amdgcn_s_sleep(1);
        if ((++sp & 255u) == 0u) { if (xb_ld(&bar[XB_TMO])) break; if (sp > XB_SPIN_CAP) { atomicAdd(&bar[XB_TMO], 1u); break; } }
    }
    nloc = mine > 0u ? mine : 1u; nx = cnt > 0u ? cnt : 1u;
}
__device__ __forceinline__ void xcd_barrier(const XcdBarrier& b) {
    asm volatile("s_waitcnt vmcnt(0)" ::: "memory");
    __syncthreads();
    if (threadIdx.x == 0) {
        unsigned* bar = b.bar;
        __builtin_amdgcn_s_waitcnt(0);
        unsigned nloc = b.st[0], nx = b.st[1];
        if (nloc == 0u) { xcd_barrier_complete(bar, b.x, nloc, nx); b.st[0] = nloc; b.st[1] = nx; }
        const unsigned old = xb_add(&bar[XB_XSUB(b.x)], 1u);
        const unsigned gen = old / nloc;
        if (old + 1u == (gen + 1u) * nloc) {
            __builtin_amdgcn_fence(__ATOMIC_RELEASE, "agent");
            asm volatile("s_waitcnt vmcnt(0)" ::: "memory");
            const unsigned og = xb_add(&bar[XB_TOP], 1u);
            const unsigned tg = og / nx;
            if (og + 1u == (tg + 1u) * nx) xb_add(&bar[XB_TOPGEN], 1u);
            else XB_SPIN(xb_ld(&bar[XB_TOPGEN]) == tg, bar);
            __builtin_amdgcn_fence(__ATOMIC_ACQUIRE, "agent");
            xb_add(&bar[XB_XGEN(b.x)], 1u);
            asm volatile("s_waitcnt vmcnt(0)" ::: "memory");
        } else {
            XB_SPIN(xb_ld(&bar[XB_XGEN(b.x)]) == gen, bar);
            __builtin_amdgcn_fence(__ATOMIC_ACQUIRE, "agent");
            asm volatile("s_waitcnt vmcnt(0)" ::: "memory");
        }
    }
    __syncthreads();
}

__global__ void __launch_bounds__(512) mega(Args a) {
    extern __shared__ __attribute__((aligned(16))) unsigned char lds_raw[];
    LAS unsigned char* lds = (LAS unsigned char*)lds_raw;
    unsigned char* ws = a.ws;
    bf16_t* U = (bf16_t*)(ws + WS_U);
    if (threadIdx.x < 4) ((LAS unsigned*)(lds + LDS_XB))[threadIdx.x] = 0u;
    __syncthreads();
    XcdBarrier xbar; xbar.bar = (unsigned*)(ws + WS_BAR); xbar.x = 0; xbar.st = (volatile LAS unsigned*)(lds + LDS_XB);
    if (a.ph_hi - a.ph_lo > 1) xbar = xcd_barrier_post((unsigned*)(ws + WS_BAR), (volatile LAS unsigned*)(lds + LDS_XB));
#define PH_BEGIN(k) if (a.ph_lo <= (k) && (k) < a.ph_hi) { if (a.ph_lo < (k)) { if (a.ph_lo == 0x7fff0000) cg::this_grid().sync(); else xcd_barrier(xbar); }
#define PH_END }
#ifndef REPMASK
#define REPMASK 0
#endif
#define NREP(k) (((REPMASK >> (k)) & 1) ? 2 : 1)
    PH_BEGIN(0) for (int r_ = 0; r_ < NREP(0); ++r_) { __syncthreads(); phase0(a, lds); } PH_END
    PH_BEGIN(1) for (int r_ = 0; r_ < NREP(1); ++r_) { __syncthreads(); phase0_conv(a, lds); __syncthreads(); phase1(a, lds); } PH_END
    PH_BEGIN(2)
        pg8::StaticOrder S; S.init(NTOK, LDU, gridDim.x, blockIdx.x);
        pg8::Gemm g{(const bf16_t*)(ws + WS_H), (const bf16_t*)(ws + WS_WINT), NTOK, LDU, 1024, 1024, 1024};
        Epi1 E{U};
#ifndef REP_PH2
#define REP_PH2 1
#endif
#pragma unroll 1
        for (int rep_ = 0; rep_ < REP_PH2; ++rep_) { if (rep_) __syncthreads(); pg8::gemm_phase(lds, g, S, E); }
        __syncthreads();
        if (gridDim.x == 256) { if (blockIdx.x >= 112) conv_rest(a, lds, blockIdx.x - 112, 144); } else conv_rest(a, lds, blockIdx.x, gridDim.x);
    PH_END
    PH_BEGIN(3) for (int r_ = 0; r_ < NREP(3); ++r_) fourier_l1(a, lds); PH_END
    PH_BEGIN(4) for (int r_ = 0; r_ < NREP(4); ++r_) fourier_l2(a, lds); phase_premix(a); PH_END
    PH_BEGIN(5) for (int r_ = 0; r_ < NREP(5); ++r_) fourier_l3(a, lds); __syncthreads(); PH_END
    if (a.ph_lo <= 6 && 6 < a.ph_hi) { if (a.ph_lo == 6) {} else if (!(a.ph_lo <= 5)) xcd_barrier(xbar);
#ifndef SCAN_REPS
#define SCAN_REPS 1
#endif
        for (int rep = 0; rep < SCAN_REPS; ++rep) {
            if (rep) {
                cg::this_grid().sync();
                { f32x4* yo = (f32x4*)a.out; for (int i = blockIdx.x * 512 + threadIdx.x; i < NTOK * DM / 4; i += gridDim.x * 512) yo[i] = (f32x4){0.f, 0.f, 0.f, 0.f}; }
                cg::this_grid().sync();
            }
            phase_scan(a, lds);
        }
    PH_END
    PH_BEGIN(7) if (gridDim.x >= 256 && a.ph_hi - a.ph_lo > 1) { phase_fixup(a); xcd_barrier(xbar); } phase_gn(a); PH_END
    PH_BEGIN(8)
        pg8::StaticOrder S; S.init(NTOK, 1024, gridDim.x, blockIdx.x);
#pragma unroll 1
        for (int r_ = 0; r_ < NREP(8); ++r_) {
        __syncthreads();
        {
            pg8::Gemm g{U + C_XF, (const bf16_t*)(ws + WS_WPF), NTOK, 1024, 512, LDU, 512};
            Epi2<0> E{U};
            pg8::gemm_phase(lds, g, S, E);
        }
        {
            pg8::Gemm g{U + C_GR, (const bf16_t*)(ws + WS_WPR), NTOK, 1024, 1024, LDU, 1024};
            Epi2<1> E{U};
            pg8::gemm_phase(lds, g, S, E);
        }
        }
    PH_END
    PH_BEGIN(9)
        pg8::StaticOrder S; S.init(NTOK, 1024, gridDim.x, blockIdx.x);
        pg8::Gemm g{U + C_MERGED, (const bf16_t*)(ws + WS_WOUT), NTOK, 1024, 1024, LDU, 1024};
        Epi3 E{a.in[0], a.in[1], (const float*)(ws + WS_MODF), a.out};
#pragma unroll 1
        for (int r_ = 0; r_ < NREP(9); ++r_) { __syncthreads(); pg8::gemm_phase(lds, g, S, E); }
#ifdef SYNC_EXTRA
        for (int r_ = 0; r_ < SYNC_EXTRA; ++r_) cg::this_grid().sync();
#endif
    PH_END
    PH_BEGIN(10) phase_final(a); PH_END
}

extern "C" void kernel_launch(void* const* d_in, const int* in_sizes, int n_in, void* d_out, int out_size, void* d_ws, size_t ws_size, hipStream_t stream) {
    static int grid = 0;
    if (grid == 0) {
        if (n_in != 23 || ws_size < WS_END) { fprintf(stderr, "kernel_launch: unexpected n_in %d / ws_size %zu (need %zu)\n", n_in, ws_size, (size_t)WS_END); grid = -1; return; }
        int dev = 0, cus = 0, per_cu = 0;
        hipGetDevice(&dev);
        hipDeviceGetAttribute(&cus, hipDeviceAttributeMultiprocessorCount, dev);
        if (hipFuncSetAttribute((const void*)mega, hipFuncAttributeMaxDynamicSharedMemorySize, LDS_BYTES) != hipSuccess) { fprintf(stderr, "kernel_launch: hipFuncSetAttribute failed\n"); grid = -1; return; }
        if (hipOccupancyMaxActiveBlocksPerMultiprocessor(&per_cu, (const void*)mega, 512, LDS_BYTES) != hipSuccess || per_cu < 1) { fprintf(stderr, "kernel_launch: occupancy query says %d\n", per_cu); per_cu = 1; }
        (void)hipGetLastError();
        grid = cus;
    }
    if (grid < 0) return;
    Args a{};
    for (int i = 0; i < 23; ++i) a.in[i] = (const float*)d_in[i];
    a.out = (float*)d_out; a.ws = (unsigned char*)d_ws;
    (void)hipMemsetAsync((unsigned char*)d_ws + WS_BAR, 0, 16384, stream);
#if MULTI_LAUNCH
    for (int ph = 0; ph < NPH; ++ph) {
        a.ph_lo = ph; a.ph_hi = ph + 1;
        hipLaunchKernelGGL(mega, dim3(grid), dim3(512), LDS_BYTES, stream, a);
    }
#else
    a.ph_lo = 0; a.ph_hi = NPH;
    void* args[] = {&a};
    hipError_t e = hipLaunchCooperativeKernel((void*)mega, dim3(grid), dim3(512), args, LDS_BYTES, stream);
    if (e != hipSuccess) fprintf(stderr, "cooperative launch failed: %s (grid %d)\n", hipGetErrorString(e), grid);
#endif
}
```

```cpp
#include <hip/hip_runtime.h>
#include <hip/hip_cooperative_groups.h>
#include <cstdio>
namespace cg = cooperative_groups;

#ifndef MULTI_LAUNCH
#define MULTI_LAUNCH 0
#endif

#define LAS __attribute__((address_space(3)))
typedef unsigned short bf16_t;
typedef short bf16x8 __attribute__((ext_vector_type(8)));
typedef float f32x4 __attribute__((ext_vector_type(4)));
typedef unsigned u32x4 __attribute__((ext_vector_type(4)));
typedef unsigned u32x2 __attribute__((ext_vector_type(2)));

constexpr int DM = 1024, NTOK_C = 4096, NTOK_L = 8192, NTOK = 12288;
constexpr int LDU = 7424;
constexpr int C_XF = 0, C_GF = 512, C_SH = 1024, C_GR = 4224, C_MG = 5248;
constexpr int C_MERGED = 1024;
constexpr float RMS_EPS = 1e-6f, GN_EPS = 64e-5f;
constexpr int NPH = 11;
constexpr int LDS_BYTES = 152064;

constexpr size_t WS_WINT = 0;
constexpr size_t WS_WPF  = WS_WINT + (size_t)7424 * 1024 * 2;
constexpr size_t WS_WPR  = WS_WPF + (size_t)1024 * 512 * 2;
constexpr size_t WS_WOUT = WS_WPR + (size_t)1024 * 1024 * 2;
constexpr size_t WS_MODP = WS_WOUT + (size_t)1024 * 1024 * 2;
constexpr size_t WS_MODF = WS_MODP + (size_t)16 * 3 * 3072 * 4;
constexpr size_t WS_TAB  = WS_MODF + (size_t)3 * 3072 * 4;
constexpr size_t WS_WUPT = WS_TAB + 131072;
constexpr size_t WS_AUPT = WS_WUPT + 262144;
constexpr size_t WS_H    = WS_AUPT + 262144;
constexpr size_t WS_U    = WS_H + (size_t)NTOK * 1024 * 2;
constexpr size_t WS_RLAT = WS_U + (size_t)NTOK * LDU * 2;
constexpr size_t WS_BAR  = WS_RLAT + (size_t)1024 * 64 * 128 * 2;
constexpr size_t WS_MIX  = WS_BAR + 16384;
constexpr size_t WS_ZB   = WS_MIX + (size_t)NTOK * 128 * 2;
constexpr size_t WS_SAB  = WS_ZB + (size_t)64 * 2048 * 64 * 2;
constexpr size_t WS_END  = WS_SAB + (size_t)64 * 64 * 64 * 2;
static_assert(WS_END <= (size_t)256 * 1024 * 1024, "workspace map exceeds the guaranteed 256 MiB");
constexpr int LDS_XB = 151552;
constexpr int T_W128 = 0, T_WB64 = 32768, T_WC64 = 49152, T_WB16 = 57344, T_WC16 = 58368, T_END = 58880;
constexpr size_t YF_OFF = 0, BON_OFF = (size_t)NTOK * DM;
constexpr size_t QLAT_ELEMS = (size_t)1024 * 64 * 128;

struct Args { const float* in[23]; float* out; unsigned char* ws; int ph_lo, ph_hi; };

__device__ __forceinline__ unsigned f2bf(float f) { unsigned u = __float_as_uint(f); u += 0x7FFFu + ((u >> 16) & 1u); return u >> 16; }
typedef __bf16 bf16x2_t __attribute__((ext_vector_type(2)));
typedef float f32x2_t __attribute__((ext_vector_type(2)));
__device__ __forceinline__ unsigned pk2(float lo, float hi) { f32x2_t v = {lo, hi}; bf16x2_t b = __builtin_convertvector(v, bf16x2_t); return __builtin_bit_cast(unsigned, b); }
__device__ __forceinline__ float bf2f(unsigned b) { return __uint_as_float(b << 16); }
__device__ __forceinline__ float bflo(unsigned w) { return __uint_as_float(w << 16); }
__device__ __forceinline__ float bfhi(unsigned w) { return __uint_as_float(w & 0xffff0000u); }
__device__ __forceinline__ float wave_sum(float v) {
#pragma unroll
    for (int o = 1; o < 64; o <<= 1) v += __shfl_xor(v, o);
    return v;
}
__device__ __forceinline__ float sigmoidf_(float x) { return __builtin_amdgcn_rcpf(1.0f + __expf(-x)); }
__device__ __forceinline__ float siluf_(float x) { return x * __builtin_amdgcn_rcpf(1.0f + __expf(-x)); }
#define LDS_WAIT() asm volatile("s_waitcnt lgkmcnt(0)" ::: "memory")

namespace pg8 {
constexpr int BM = 256, BK = 64, HALF = 128, HTB = HALF * BK * 2, STAGE_BYTES = 8 * HTB, NXCD = 8, WGM = 8;
__device__ __forceinline__ int lds_byte(int r, int c) { const int st = (r >> 4) * 2 + (c >> 5), rr = r & 15, cc = c & 31, ob = rr * 64 + cc * 2; return st * 1024 + (ob ^ (((ob >> 9) & 1) << 5)); }
__device__ __forceinline__ void stage_rc(int b, int& R, int& C) { const int st = b / 1024, sb = b % 1024, swz = sb ^ (((sb >> 9) & 1) << 5); R = (st >> 1) * 16 + swz / 64; C = (st & 1) * 32 + (swz % 64) / 2; }
__device__ __forceinline__ int perm32(int rho) { const int n = rho >> 4, i = rho & 15; return 8 * (i >> 2) + 4 * n + (i & 3); }
struct Unit { int pm, pn; };
struct Gemm { const bf16_t* A; const bf16_t* Bt; int M, N, K, lda, ldb; };
struct StaticOrder {
    int nM, nN, nwg, G, c;
    __device__ __forceinline__ void init(int M, int N, int G_, int c_) { nM = M / BM; nN = N / BM; nwg = nM * nN; G = G_; c = c_; }
    __device__ __forceinline__ bool next(int i, Unit& u) const {
        const long L = (long)i * G + c; if (L >= nwg) return false;
        int wgid = (int)L; { const int q = nwg / NXCD, r = nwg % NXCD, xcd = wgid % NXCD, off = wgid / NXCD; wgid = (xcd < r ? xcd * (q + 1) : r * (q + 1) + (xcd - r) * q) + off; }
        const int nig = WGM * nN, gid = wgid / nig, fm = gid * WGM, gsz = (nM - fm) < WGM ? (nM - fm) : WGM;
        u.pm = fm + ((wgid % nig) % gsz); u.pn = (wgid % nig) / gsz; return true;
    }
};

template <class Epi>
__device__ __forceinline__ void gemm_phase(LAS unsigned char* lds, const Gemm g, const StaticOrder& S, const Epi& E) {
    int tid_ = threadIdx.x; asm volatile("" : "+v"(tid_));
    const int tid = tid_, wid = __builtin_amdgcn_readfirstlane(tid >> 6), lane = tid & 63, wr = wid >> 2, wc = wid & 3, fr = lane & 15, fq = lane >> 4;
    const int K = g.K, nt = K / BK;
    unsigned voffA[2], voffB[2];
#pragma unroll
    for (int i = 0; i < 2; ++i) { int R, C; stage_rc(tid * 16 + i * 8192, R, C); const int Rb = Epi::PERM ? ((R & ~31) + perm32(R & 31)) : R;
        voffA[i] = (unsigned)(R * g.lda + C) * 2u; voffB[i] = (unsigned)(Rb * g.ldb + C) * 2u; }
    const size_t kstep = (size_t)(BK * 2);
    const size_t hstepA = (size_t)HALF * g.lda * 2, hstepB = (size_t)HALF * g.ldb * 2;
    const size_t tstepA = 2 * hstepA, tstepB = 2 * hstepB;
    const unsigned ldsw = (unsigned)wid * 1024u;
    const int aoff = lds_byte(wr * 64 + fr, fq * 8), boff = lds_byte(wc * 32 + fr, fq * 8);
#define PG8_SA(b, h) (((b) * 2 + (h)) * HTB)
#define PG8_SB(b, h) ((4 + (b) * 2 + (h)) * HTB)
#define PG8_STAGE(bufoff, gbase, voff) do { _Pragma("unroll") for (int _i = 0; _i < 2; ++_i) \
        __builtin_amdgcn_global_load_lds((const unsigned*)((const char*)(gbase) + (voff)[_i]), (LAS unsigned*)(lds + (bufoff) + ldsw + _i * 8192), 16, 0, 0); } while (0)
#define PG8_LDA(dst, b, h) do { _Pragma("unroll") for (int m = 0; m < 4; ++m) _Pragma("unroll") for (int k = 0; k < 2; ++k) dst[m][k] = *(const LAS bf16x8*)(lds + PG8_SA(b, h) + aoff + m * 2048 + k * 1024); } while (0)
#define PG8_LDB(dst, b, h) do { _Pragma("unroll") for (int n = 0; n < 2; ++n) _Pragma("unroll") for (int k = 0; k < 2; ++k) dst[n][k] = *(const LAS bf16x8*)(lds + PG8_SB(b, h) + boff + n * 2048 + k * 1024); } while (0)
#define PG8_MMA(ai, bj, At, Bt) do { __builtin_amdgcn_s_setprio(1); _Pragma("unroll") for (int m = 0; m < 4; ++m) _Pragma("unroll") for (int n = 0; n < 2; ++n) _Pragma("unroll") for (int k = 0; k < 2; ++k) \
        acc[ai][bj][m][n] = __builtin_amdgcn_mfma_f32_16x16x32_bf16(Bt[n][k], At[m][k], acc[ai][bj][m][n], 0, 0, 0); __builtin_amdgcn_s_setprio(0); } while (0)
#define PG8_WAIT_V(n) asm volatile("s_waitcnt vmcnt(" #n ")" ::: "memory")
#define PG8_WAIT_L(n) asm volatile("s_waitcnt lgkmcnt(" #n ")" ::: "memory")
#define PG8_BAR __builtin_amdgcn_s_barrier()
#define PG8_SCHED __builtin_amdgcn_sched_barrier(0)
    Unit cur, nxt; int ui = 0;
    if (!S.next(0, cur)) return;
    f32x4 acc[2][2][4][2];
#pragma unroll
    for (int a = 0; a < 2; ++a)
#pragma unroll
        for (int b = 0; b < 2; ++b)
#pragma unroll
            for (int m = 0; m < 4; ++m)
#pragma unroll
                for (int n = 0; n < 2; ++n) acc[a][b][m][n] = (f32x4){0.f, 0.f, 0.f, 0.f};
    bf16x8 At[4][2], B0[2][2], B1[2][2];
    const char* cA = (const char*)g.A + (size_t)cur.pm * tstepA; const char* cB = (const char*)g.Bt + (size_t)cur.pn * tstepB;
    PG8_STAGE(PG8_SB(0, 0), cB, voffB); PG8_STAGE(PG8_SA(0, 0), cA, voffA); PG8_STAGE(PG8_SB(0, 1), cB + hstepB, voffB); PG8_STAGE(PG8_SA(0, 1), cA + hstepA, voffA);
    if (wr == 1) PG8_BAR;
    PG8_WAIT_V(4); PG8_BAR;
    PG8_STAGE(PG8_SB(1, 0), cB + kstep, voffB); PG8_STAGE(PG8_SA(1, 0), cA + kstep, voffA); PG8_STAGE(PG8_SB(1, 1), cB + hstepB + kstep, voffB);
    PG8_WAIT_V(6); PG8_BAR;
    for (;;) {
        const bool has_next = S.next(ui + 1, nxt);
        const char* nA = has_next ? (const char*)g.A + (size_t)nxt.pm * tstepA : cA; const char* nB = has_next ? (const char*)g.Bt + (size_t)nxt.pn * tstepB : cB;
        for (int t = 0; t < nt; t += 2) {
            const bool last = (t == nt - 2);
            const char* a1 = cA + (size_t)(t + 1) * kstep;
            const char* a2 = last ? nA : cA + (size_t)(t + 2) * kstep; const char* b2 = last ? nB : cB + (size_t)(t + 2) * kstep;
            const char* a3 = a2 + kstep; const char* b3 = b2 + kstep;
            PG8_LDB(B0, 0, 0); PG8_SCHED; PG8_LDA(At, 0, 0); PG8_STAGE(PG8_SA(1, 1), a1 + hstepA, voffA);
            PG8_WAIT_L(8); PG8_BAR; PG8_WAIT_L(0); PG8_MMA(0, 0, At, B0); PG8_BAR; PG8_SCHED;
            PG8_LDB(B1, 0, 1); PG8_STAGE(PG8_SB(0, 0), b2, voffB);
            PG8_BAR; PG8_WAIT_L(0); PG8_MMA(0, 1, At, B1); PG8_BAR;
            PG8_LDA(At, 0, 1); PG8_STAGE(PG8_SA(0, 0), a2, voffA);
            PG8_BAR; PG8_WAIT_L(0); PG8_MMA(1, 0, At, B0); PG8_BAR; PG8_SCHED;
            PG8_STAGE(PG8_SB(0, 1), b2 + hstepB, voffB);
            PG8_WAIT_V(6); PG8_BAR; PG8_MMA(1, 1, At, B1); PG8_BAR;
            PG8_LDB(B0, 1, 0); PG8_SCHED; PG8_LDA(At, 1, 0); PG8_STAGE(PG8_SA(0, 1), a2 + hstepA, voffA);
            PG8_WAIT_L(8); PG8_BAR; PG8_WAIT_L(0); PG8_MMA(0, 0, At, B0); PG8_BAR; PG8_SCHED;
            PG8_LDB(B1, 1, 1); PG8_STAGE(PG8_SB(1, 0), b3, voffB);
            PG8_BAR; PG8_WAIT_L(0); PG8_MMA(0, 1, At, B1); PG8_BAR;
            PG8_LDA(At, 1, 1); PG8_STAGE(PG8_SA(1, 0), a3, voffA);
            PG8_BAR; PG8_WAIT_L(0); PG8_MMA(1, 0, At, B0); PG8_BAR; PG8_SCHED;
            PG8_STAGE(PG8_SB(1, 1), b3 + hstepB, voffB);
            PG8_WAIT_V(6); PG8_BAR; PG8_MMA(1, 1, At, B1); PG8_BAR;
        }
        E(acc, cur, wr, wc, fr, fq);
        if (!has_next) break;
#pragma unroll
        for (int a = 0; a < 2; ++a)
#pragma unroll
            for (int b = 0; b < 2; ++b)
#pragma unroll
                for (int m = 0; m < 4; ++m)
#pragma unroll
                    for (int n = 0; n < 2; ++n) acc[a][b][m][n] = (f32x4){0.f, 0.f, 0.f, 0.f};
        cur = nxt; cA = nA; cB = nB; ++ui;
    }
    PG8_WAIT_V(0);
    if (wr == 0) PG8_BAR;
    PG8_BAR;
#undef PG8_SA
#undef PG8_SB
#undef PG8_STAGE
#undef PG8_LDA
#undef PG8_LDB
#undef PG8_MMA
#undef PG8_WAIT_V
#undef PG8_WAIT_L
#undef PG8_BAR
#undef PG8_SCHED
}
}
using pg8::Unit;

struct Epi1 {
    static constexpr bool PERM = true;
    bf16_t* U;
    __device__ __forceinline__ void operator()(const f32x4 (&acc)[2][2][4][2], const Unit& u, int wr, int wc, int fr, int fq) const {
        const int row0 = u.pm * 256 + wr * 64 + fr, col0 = u.pn * 256 + wc * 32 + 8 * fq;
#pragma unroll
        for (int bj = 0; bj < 2; ++bj) {
            const int c = col0 + bj * 128;
            const int act = (c < C_GF) ? 0 : (c < C_SH) ? 1 : (c < C_GR) ? 0 : (c < C_MG) ? 1 : 2;
#pragma unroll
            for (int ai = 0; ai < 2; ++ai)
#pragma unroll
                for (int m = 0; m < 4; ++m) {
                    f32x4 v0 = acc[ai][bj][m][0], v1 = acc[ai][bj][m][1];
                    if (act == 1) {
#pragma unroll
                        for (int j = 0; j < 4; ++j) { v0[j] = siluf_(v0[j]); v1[j] = siluf_(v1[j]); }
                    } else if (act == 2) {
#pragma unroll
                        for (int j = 0; j < 4; ++j) { v0[j] = sigmoidf_(v0[j]); v1[j] = sigmoidf_(v1[j]); }
                    }
                    u32x4 w; w.x = pk2(v0[0], v0[1]); w.y = pk2(v0[2], v0[3]); w.z = pk2(v1[0], v1[1]); w.w = pk2(v1[2], v1[3]);
                    *(u32x4*)(U + (size_t)(row0 + ai * 128 + m * 16) * LDU + c) = w;
                }
        }
    }
};
template <int second> struct Epi2 {
    static constexpr bool PERM = true;
    bf16_t* U;
    __device__ __forceinline__ void operator()(const f32x4 (&acc)[2][2][4][2], const Unit& u, int wr, int wc, int fr, int fq) const {
        const int row0 = u.pm * 256 + wr * 64 + fr, col0 = u.pn * 256 + wc * 32 + 8 * fq;
#pragma unroll
        for (int bj = 0; bj < 2; ++bj) {
            const int c = col0 + bj * 128;
#pragma unroll
            for (int ai = 0; ai < 2; ++ai)
#pragma unroll
                for (int m = 0; m < 4; ++m) {
                    bf16_t* rowp = U + (size_t)(row0 + ai * 128 + m * 16) * LDU;
                    const u32x4 gw = *(const u32x4*)(rowp + C_MG + (second ? 1024 : 0) + c);
                    const f32x4 v0 = acc[ai][bj][m][0], v1 = acc[ai][bj][m][1];
                    float o[8];
                    o[0] = v0[0] * bflo(gw.x); o[1] = v0[1] * bfhi(gw.x); o[2] = v0[2] * bflo(gw.y); o[3] = v0[3] * bfhi(gw.y);
                    o[4] = v1[0] * bflo(gw.z); o[5] = v1[1] * bfhi(gw.z); o[6] = v1[2] * bflo(gw.w); o[7] = v1[3] * bfhi(gw.w);
                    if (second) {
                        const u32x4 pw = *(const u32x4*)(rowp + C_MERGED + c);
                        o[0] += bflo(pw.x); o[1] += bfhi(pw.x); o[2] += bflo(pw.y); o[3] += bfhi(pw.y);
                        o[4] += bflo(pw.z); o[5] += bfhi(pw.z); o[6] += bflo(pw.w); o[7] += bfhi(pw.w);
                    }
                    u32x4 w; w.x = pk2(o[0], o[1]); w.y = pk2(o[2], o[3]); w.z = pk2(o[4], o[5]); w.w = pk2(o[6], o[7]);
                    *(u32x4*)(rowp + C_MERGED + c) = w;
                    asm volatile("" ::: "memory");
                }
        }
    }
};
struct Epi3 {
    static constexpr bool PERM = false;
    const float* xp; const float* xs; const float* modf; float* out;
    __device__ __forceinline__ void operator()(const f32x4 (&acc)[2][2][4][2], const Unit& u, int wr, int wc, int fr, int fq) const {
        const int row0 = u.pm * 256 + wr * 64 + fr, col0 = u.pn * 256 + wc * 32 + 4 * fq;
#pragma unroll
        for (int ai = 0; ai < 2; ++ai)
#pragma unroll
            for (int m = 0; m < 4; ++m) {
                const int row = row0 + ai * 128 + m * 16;
                const int set = row < NTOK_C ? 0 : 1 + ((row - NTOK_C) >> 12);
                const float* xr = row < NTOK_C ? xp + (size_t)row * DM : xs + (size_t)(row - NTOK_C) * DM;
                const float* gt = modf + set * 3072 + 2048;
#pragma unroll
                for (int bj = 0; bj < 2; ++bj)
#pragma unroll
                    for (int n = 0; n < 2; ++n) {
                        const int c = col0 + bj * 128 + n * 16;
                        const f32x4 xv = *(const f32x4*)(xr + c), gv = *(const f32x4*)(gt + c);
                        *(f32x4*)(out + (size_t)row * DM + c) = xv + gv * acc[ai][bj][m][n];
                    }
            }
    }
};

template <int MT, int NT, int KS, int UNR = 1>
__device__ __forceinline__ void wave_mma(const bf16_t* const (&ap)[MT], const bf16_t* const (&bp)[NT], f32x4 (&acc)[MT][NT], int fq) {
#pragma unroll UNR
    for (int ks = 0; ks < KS; ++ks) {
        bf16x8 av[MT], bv[NT];
#pragma unroll
        for (int mi = 0; mi < MT; ++mi) av[mi] = *(const bf16x8*)(ap[mi] + ks * 32 + fq * 8);
#pragma unroll
        for (int ni = 0; ni < NT; ++ni) bv[ni] = *(const bf16x8*)(bp[ni] + ks * 32 + fq * 8);
#pragma unroll
        for (int mi = 0; mi < MT; ++mi)
#pragma unroll
            for (int ni = 0; ni < NT; ++ni) acc[mi][ni] = __builtin_amdgcn_mfma_f32_16x16x32_bf16(av[mi], bv[ni], acc[mi][ni], 0, 0, 0);
    }
}
template <int MT, int NT, int KS, int LDB, int UNR = 1>
__device__ __forceinline__ void wave_mma_lb(const bf16_t* const (&ap)[MT], const LAS bf16_t* bl, f32x4 (&acc)[MT][NT], int fr, int fq) {
#pragma unroll UNR
    for (int ks = 0; ks < KS; ++ks) {
        bf16x8 av[MT], bv[NT];
#pragma unroll
        for (int mi = 0; mi < MT; ++mi) av[mi] = *(const bf16x8*)(ap[mi] + ks * 32 + fq * 8);
#pragma unroll
        for (int ni = 0; ni < NT; ++ni) bv[ni] = *(const LAS bf16x8*)(bl + (16 * ni + fr) * LDB + ks * 32 + fq * 8);
#pragma unroll
        for (int mi = 0; mi < MT; ++mi)
#pragma unroll
            for (int ni = 0; ni < NT; ++ni) acc[mi][ni] = __builtin_amdgcn_mfma_f32_16x16x32_bf16(av[mi], bv[ni], acc[mi][ni], 0, 0, 0);
    }
}
template <int LDB>
__device__ __forceinline__ void stage_table(LAS bf16_t* dst, const bf16_t* src, int rows, int cols) {
    const int per = cols / 8;
    for (int i = threadIdx.x; i < rows * per; i += 512) { const int r = i / per, c8 = i % per; *(LAS u32x4*)(dst + r * LDB + c8 * 8) = *(const u32x4*)(src + (size_t)r * cols + c8 * 8); }
}
__device__ __forceinline__ void st4bf(bf16_t* p, const f32x4 v) { u32x2 w; w.x = pk2(v[0], v[1]); w.y = pk2(v[2], v[3]); *(u32x2*)p = w; }

struct Ctx {
    const Args& a; LAS unsigned char* lds; int tid, lane, wv, gw, ngw;
};

__device__ __forceinline__ void transpose_item(const float* W, int K, int N, bf16_t* WT, LAS float* scr, int item, int lane) {
    const int nblk = N / 32, kb = item / nblk, nb = item % nblk, k0 = 64 * kb, n0 = 32 * nb;
#pragma unroll 8
    for (int i = 0; i < 32; ++i) { const int kk = 2 * i + (lane >> 5); scr[kk * 33 + (lane & 31)] = W[(size_t)(k0 + kk) * N + n0 + (lane & 31)]; }
    LDS_WAIT();
    const int c = lane & 7;
#pragma unroll
    for (int j = 0; j < 4; ++j) { const int n = (lane >> 3) + 8 * j; const LAS float* s = scr + (8 * c) * 33 + n;
        u32x4 o; o.x = pk2(s[0 * 33], s[1 * 33]); o.y = pk2(s[2 * 33], s[3 * 33]); o.z = pk2(s[4 * 33], s[5 * 33]); o.w = pk2(s[6 * 33], s[7 * 33]);
        *(u32x4*)(WT + (size_t)(n0 + n) * K + k0 + 8 * c) = o; }
    LDS_WAIT();
}
__device__ __forceinline__ void phase0(const Args& a, LAS unsigned char* lds) {
    const int tid = threadIdx.x, lane = tid & 63, wv = tid >> 6, gw = blockIdx.x * 8 + wv, ngw = gridDim.x * 8;
    unsigned char* ws = a.ws;
    for (int cb = blockIdx.x; cb < 256; cb += gridDim.x) {
        LAS float* sv = (LAS float*)(lds + 8 * 8448);
        LAS float* pr = sv + 3072;
        __syncthreads();
        for (int i = tid; i < 3072; i += 512) { const int v = i >> 10, k = i & 1023; sv[i] = siluf_((v == 0) ? a.in[4][k] : a.in[3][(v - 1) * 1024 + k]); }
        __syncthreads();
        const int kk = tid >> 2, cq = tid & 3, col = cb * 12 + 3 * cq;
        float acc[3][3];
#pragma unroll
        for (int v = 0; v < 3; ++v)
#pragma unroll
            for (int j = 0; j < 3; ++j) acc[v][j] = 0.f;
#pragma unroll
        for (int i = 0; i < 8; ++i) {
            const int k = kk + 128 * i;
            const float* w = a.in[6] + (size_t)k * 3072 + col;
            const float w0 = w[0], w1 = w[1], w2 = w[2];
#pragma unroll
            for (int v = 0; v < 3; ++v) { const float sk = sv[v * 1024 + k]; acc[v][0] += sk * w0; acc[v][1] += sk * w1; acc[v][2] += sk * w2; }
        }
#pragma unroll
        for (int v = 0; v < 3; ++v)
#pragma unroll
            for (int j = 0; j < 3; ++j) { float x = acc[v][j]; x += __shfl_xor(x, 4); x += __shfl_xor(x, 8); x += __shfl_xor(x, 16); x += __shfl_xor(x, 32); acc[v][j] = x; }
        if (lane < 4) {
#pragma unroll
            for (int v = 0; v < 3; ++v)
#pragma unroll
                for (int j = 0; j < 3; ++j) pr[(wv * 4 + lane) * 9 + v * 3 + j] = acc[v][j];
        }
        __syncthreads();
        if (tid < 36) {
            const int q = tid / 9, r = tid % 9, v = r / 3, j = r % 3;
            float sum = 0.f;
#pragma unroll
            for (int w8 = 0; w8 < 8; ++w8) sum += pr[(w8 * 4 + q) * 9 + r];
            const int c = cb * 12 + 3 * q + j;
            ((float*)(ws + WS_MODF))[v * 3072 + c] = sum + a.in[7][c];
        }
    }
    __syncthreads();
}
__device__ __forceinline__ void phase0_conv(const Args& a, LAS unsigned char* lds) {
    const int tid = threadIdx.x, lane = tid & 63, wv = tid >> 6, gw = blockIdx.x * 8 + wv, ngw = gridDim.x * 8;
    unsigned char* ws = a.ws;
    LAS float* scr = (LAS float*)(lds + wv * 8448);
    for (int it = gw; it < 16 * 228; it += ngw) transpose_item(a.in[8], 1024, 7296, (bf16_t*)(ws + WS_WINT), scr, it, lane);
    u32x4* padp = (u32x4*)((bf16_t*)(ws + WS_WINT) + (size_t)7296 * 1024);
    for (int i = blockIdx.x * 512 + tid; i < 128 * 1024 / 8; i += gridDim.x * 512) padp[i] = (u32x4){0u, 0u, 0u, 0u};
}
__device__ __forceinline__ void conv_rest(const Args& a, LAS unsigned char* lds, int wb, int nwb) {
    const int tid = threadIdx.x, lane = tid & 63, wv = tid >> 6, gw = wb * 8 + wv, ngw = nwb * 8;
    unsigned char* ws = a.ws;
    {
        LAS float* scr = (LAS float*)(lds + wv * 8448);
        constexpr int I_PF = 8 * 32, I_PR = 16 * 32, I_OUT = 16 * 32;
        for (int it = gw; it < I_PF + I_PR + I_OUT; it += ngw) {
            int r = it;
            if (r < I_PF) { transpose_item(a.in[19], 512, 1024, (bf16_t*)(ws + WS_WPF), scr, r, lane); continue; } r -= I_PF;
            if (r < I_PR) { transpose_item(a.in[20], 1024, 1024, (bf16_t*)(ws + WS_WPR), scr, r, lane); continue; } r -= I_PR;
            transpose_item(a.in[21], 1024, 1024, (bf16_t*)(ws + WS_WOUT), scr, r, lane);
        }
    }
    {
        bf16_t* wt = (bf16_t*)(ws + WS_WUPT); bf16_t* at = (bf16_t*)(ws + WS_AUPT);
        for (int i = wb * 512 + tid; i < 2 * 1024 * 64; i += nwb * 512) {
            const int rk = i & 63, C = (i >> 6) & 1023, d = i >> 16;
            wt[i] = (bf16_t)f2bf(a.in[11][(size_t)(d * 64 + rk) * 1024 + C]);
            at[i] = (bf16_t)f2bf(a.in[13][(size_t)(d * 64 + rk) * 1024 + C]);
        }
    }
    {
        bf16_t* tab = (bf16_t*)(ws + WS_TAB);
        for (int i = wb * 512 + tid; i < T_END; i += nwb * 512) {
            float val;
            if (i < T_WB64) {
                const int n = i >> 7, c = i & 127, part = n >> 7, kc = n & 127, m = (kc * c) & 127;
                const float x = (float)m * (1.0f / 64.0f);
                val = part ? -sinpif(x) : cospif(x);
            } else if (i < T_WC64) {
                const int j = i - T_WB64, n = j >> 7, k = j & 127, pp = n >> 6, k1 = n & 63, p = k >> 6, t1 = k & 63, m = (k1 * t1) & 63;
                const float x = (float)m * (1.0f / 32.0f), cs = cospif(x), sn = sinpif(x);
                val = (pp == p) ? cs : (pp == 0 ? sn : -sn);
            } else if (i < T_WB16) {
                const int j = i - T_WC64, k2 = j >> 7, k = j & 127, p = k >> 6, t2 = k & 63, m = (k2 * t2) & 63;
                const float x = (float)m * (1.0f / 32.0f);
                val = p ? sinpif(x) : cospif(x);
            } else if (i < T_WC16) {
                const int j = i - T_WB16, n = j >> 5, k = j & 31, pp = n >> 4, k1 = n & 15, p = k >> 4, t1 = k & 15, m = (k1 * t1) & 15;
                const float x = (float)m * (1.0f / 8.0f), cs = cospif(x), sn = sinpif(x);
                val = (pp == p) ? cs : (pp == 0 ? sn : -sn);
            } else {
                const int j = i - T_WC16, k2 = j >> 5, k = j & 31, p = k >> 4, t2 = k & 15, m = (k2 * t2) & 15;
                const float x = (float)m * (1.0f / 8.0f);
                val = p ? sinpif(x) : cospif(x);
            }
            tab[i] = (bf16_t)f2bf(val);
        }
    }
}

__device__ __forceinline__ void phase1(const Args& a, LAS unsigned char* lds) {
    const int tid = threadIdx.x, lane = tid & 63, wv = tid >> 6, gw = blockIdx.x * 8 + wv, ngw = gridDim.x * 8;
    unsigned char* ws = a.ws;
    LAS float* ml = (LAS float*)lds;
    const float* mf = (const float*)(ws + WS_MODF);
    for (int i = tid; i < 9216; i += 512) ml[i] = mf[i];
    __syncthreads();
    bf16_t* H = (bf16_t*)(ws + WS_H);
    const float* ng = a.in[5];
    for (int row0 = gw; row0 < NTOK; row0 += 3 * ngw) {
        f32x4 v[3][4];
#pragma unroll
        for (int u = 0; u < 3; ++u) {
            const int row = row0 + u * ngw < NTOK ? row0 + u * ngw : row0;
            const float* xr = row < NTOK_C ? a.in[0] + (size_t)row * DM : a.in[1] + (size_t)(row - NTOK_C) * DM;
#pragma unroll
            for (int j = 0; j < 4; ++j) v[u][j] = *(const f32x4*)(xr + lane * 4 + 256 * j);
        }
#pragma unroll
        for (int u = 0; u < 3; ++u) {
            const int row = row0 + u * ngw;
            if (row < NTOK) {
                const int set = row < NTOK_C ? 0 : 1 + ((row - NTOK_C) >> 12);
                float ss = 0.f;
#pragma unroll
                for (int j = 0; j < 4; ++j) ss += (v[u][j][0] * v[u][j][0] + v[u][j][1] * v[u][j][1]) + (v[u][j][2] * v[u][j][2] + v[u][j][3] * v[u][j][3]);
                const float rstd = rsqrtf(wave_sum(ss) * (1.0f / DM) + RMS_EPS);
#pragma unroll
                for (int j = 0; j < 4; ++j) {
                    const int c = lane * 4 + 256 * j;
                    const f32x4 g4 = *(const f32x4*)(ng + c);
                    float o[4];
#pragma unroll
                    for (int e = 0; e < 4; ++e) o[e] = (v[u][j][e] * rstd * g4[e]) * (1.0f + ml[set * 3072 + 1024 + c + e]) + ml[set * 3072 + c + e];
                    u32x2 w; w.x = pk2(o[0], o[1]); w.y = pk2(o[2], o[3]);
                    *(u32x2*)(H + (size_t)row * DM + c) = w;
                }
            }
        }
    }
}

__device__ __forceinline__ void fourier_l1(const Args& a, LAS unsigned char* lds) {
    const int tid = threadIdx.x, lane = tid & 63, wv = tid >> 6, gw = blockIdx.x * 8 + wv, ngw = gridDim.x * 8, fr = lane & 15, fq = lane >> 4;
    unsigned char* ws = a.ws;
    const bf16_t* U = (const bf16_t*)(ws + WS_U);
    const bf16_t* W128 = (const bf16_t*)(ws + WS_TAB) + T_W128;
    bf16_t* Qlat = (bf16_t*)(ws + WS_H);
    bf16_t* Qctx = Qlat + QLAT_ELEMS;
    LAS bf16_t* Wl = (LAS bf16_t*)lds;
    __syncthreads(); stage_table<136>(Wl, W128, 256, 128); __syncthreads();
    for (int wt = gw; wt < 2048 + 1024; wt += ngw) {
        const bf16_t* ap[4]; f32x4 acc[4][4];
#pragma unroll
        for (int mi = 0; mi < 4; ++mi)
#pragma unroll
            for (int ni = 0; ni < 4; ++ni) acc[mi][ni] = (f32x4){0.f, 0.f, 0.f, 0.f};
        if (wt < 2048) {
            const int nb = wt & 3, t2 = (wt >> 2) & 63, bg = wt >> 8, b = bg >> 2, g = bg & 3;
#pragma unroll
            for (int mi = 0; mi < 4; ++mi) ap[mi] = U + (size_t)(NTOK_C + b * 4096 + 64 * (16 * mi + fr) + t2) * LDU + C_XF + g * 128;
            wave_mma_lb<4, 4, 4, 136, 2>(ap, Wl + (nb * 64) * 136, acc, fr, fq);
#pragma unroll
            for (int mi = 0; mi < 4; ++mi)
#pragma unroll
                for (int ni = 0; ni < 4; ++ni) {
                    const int cn = nb * 64 + 16 * ni + fr, part = cn >> 7, kc = cn & 127;
                    st4bf(Qlat + ((((size_t)(bg * 128 + kc) * 64 + t2) * 2 + part) * 64 + 16 * mi + 4 * fq), acc[mi][ni]);
                }
        } else {
            const int w2 = wt - 2048, nb = w2 & 3, tg = (w2 >> 2) & 3, bg = w2 >> 4, b = bg >> 2, g = bg & 3;
#pragma unroll
            for (int mi = 0; mi < 4; ++mi) ap[mi] = U + (size_t)(b * 256 + 16 * fr + (tg * 4 + mi)) * LDU + C_XF + g * 128;
            wave_mma_lb<4, 4, 4, 136, 2>(ap, Wl + (nb * 64) * 136, acc, fr, fq);
#pragma unroll
            for (int mi = 0; mi < 4; ++mi)
#pragma unroll
                for (int ni = 0; ni < 4; ++ni) {
                    const int cn = nb * 64 + 16 * ni + fr, part = cn >> 7, kc = cn & 127, t2 = tg * 4 + mi;
                    st4bf(Qctx + ((((size_t)(bg * 128 + kc) * 16 + t2) * 2 + part) * 16 + 4 * fq), acc[mi][ni]);
                }
        }
    }
}
__device__ __forceinline__ void fourier_l2(const Args& a, LAS unsigned char* lds) {
    const int tid = threadIdx.x, lane = tid & 63, wv = tid >> 6, gw = blockIdx.x * 8 + wv, ngw = gridDim.x * 8, fr = lane & 15, fq = lane >> 4;
    unsigned char* ws = a.ws;
    const bf16_t* tab = (const bf16_t*)(ws + WS_TAB);
    const bf16_t* Qlat = (const bf16_t*)(ws + WS_H);
    const bf16_t* Qctx = Qlat + QLAT_ELEMS;
    bf16_t* Rlat = (bf16_t*)(ws + WS_RLAT);
    bf16_t* Rctx = (bf16_t*)(ws + WS_WINT);
    LAS bf16_t* Bl64 = (LAS bf16_t*)lds;
    LAS bf16_t* Bl16 = Bl64 + 128 * 136;
    __syncthreads(); stage_table<136>(Bl64, tab + T_WB64, 128, 128); stage_table<40>(Bl16, tab + T_WB16, 32, 32); __syncthreads();
    for (int wt = gw; wt < 2048 + 2048; wt += ngw) {
        if (wt < 2048) {
            const int bgkc = wt >> 1, mh = wt & 1;
            const bf16_t* ap[2]; f32x4 acc[2][8];
#pragma unroll
            for (int mi = 0; mi < 2; ++mi)
#pragma unroll
                for (int ni = 0; ni < 8; ++ni) acc[mi][ni] = (f32x4){0.f, 0.f, 0.f, 0.f};
#pragma unroll
            for (int mi = 0; mi < 2; ++mi) ap[mi] = Qlat + ((size_t)bgkc * 64 + 32 * mh + 16 * mi + fr) * 128;
            wave_mma_lb<2, 8, 4, 136>(ap, Bl64, acc, fr, fq);
#pragma unroll
            for (int mi = 0; mi < 2; ++mi)
#pragma unroll
                for (int ni = 0; ni < 4; ++ni) {
                    const int k1 = 16 * ni + fr;
                    f32x4 orr, oi;
#pragma unroll
                    for (int r = 0; r < 4; ++r) {
                        const int t2 = 32 * mh + 16 * mi + 4 * fq + r, m = (t2 * k1) & 4095;
                        const float x = (float)m * (1.0f / 2048.0f), cs = cospif(x), sn = sinpif(x);
                        const float br = acc[mi][ni][r], bi = acc[mi][ni + 4][r];
                        orr[r] = br * cs + bi * sn; oi[r] = bi * cs - br * sn;
                    }
                    bf16_t* dst = Rlat + ((size_t)bgkc * 64 + k1) * 128 + 32 * mh + 16 * mi + 4 * fq;
                    st4bf(dst, orr); st4bf(dst + 64, oi);
                }
        } else {
            const int bgkc0 = (wt - 2048) * 4;
            const bf16_t* ap[4]; f32x4 acc[4][2];
#pragma unroll
            for (int mi = 0; mi < 4; ++mi)
#pragma unroll
                for (int ni = 0; ni < 2; ++ni) acc[mi][ni] = (f32x4){0.f, 0.f, 0.f, 0.f};
#pragma unroll
            for (int mi = 0; mi < 4; ++mi) ap[mi] = Qctx + ((size_t)(bgkc0 + mi) * 16 + fr) * 32;
            wave_mma_lb<4, 2, 1, 40>(ap, Bl16, acc, fr, fq);
#pragma unroll
            for (int mi = 0; mi < 4; ++mi) {
                const int k1 = fr;
                f32x4 orr, oi;
#pragma unroll
                for (int r = 0; r < 4; ++r) {
                    const int t2 = 4 * fq + r, m = (t2 * k1) & 255;
                    const float x = (float)m * (1.0f / 128.0f), cs = cospif(x), sn = sinpif(x);
                    const float br = acc[mi][0][r], bi = acc[mi][1][r];
                    orr[r] = br * cs + bi * sn; oi[r] = bi * cs - br * sn;
                }
                bf16_t* dst = Rctx + ((size_t)(bgkc0 + mi) * 16 + k1) * 32 + 4 * fq;
                st4bf(dst, orr); st4bf(dst + 16, oi);
            }
        }
    }
}
__device__ __forceinline__ void fourier_l3(const Args& a, LAS unsigned char* lds) {
    const int skipb = (gridDim.x >= 128 && gridDim.x < 256) ? 64 : 0;
    if ((int)blockIdx.x < skipb) return;
    const int tid = threadIdx.x, lane = tid & 63, wv = tid >> 6, gw = ((int)blockIdx.x - skipb) * 8 + wv, ngw = ((int)gridDim.x - skipb) * 8, fr = lane & 15, fq = lane >> 4;
    unsigned char* ws = a.ws;
    const bf16_t* tab = (const bf16_t*)(ws + WS_TAB);
    const bf16_t* Rlat = (const bf16_t*)(ws + WS_RLAT);
    const bf16_t* Rctx = (const bf16_t*)(ws + WS_WINT);
    bf16_t* U = (bf16_t*)(ws + WS_U);
    LAS bf16_t* Cl64 = (LAS bf16_t*)lds;
    LAS bf16_t* Cl16 = Cl64 + 64 * 136;
    stage_table<136>(Cl64, tab + T_WC64, 64, 128); stage_table<40>(Cl16, tab + T_WC16, 16, 32); __syncthreads();
    for (int wt = gw; wt < 1024 + 2048; wt += ngw) {
        if (wt < 1024) {
            const int kb = wt & 1, k1 = (wt >> 1) & 63, bg = wt >> 7, b = bg >> 2, g = bg & 3;
            const bf16_t* ap[4]; f32x4 acc[4][4];
#pragma unroll
            for (int mi = 0; mi < 4; ++mi)
#pragma unroll
                for (int ni = 0; ni < 4; ++ni) acc[mi][ni] = (f32x4){0.f, 0.f, 0.f, 0.f};
#pragma unroll
            for (int mi = 0; mi < 4; ++mi) ap[mi] = Rlat + ((size_t)(bg * 128 + kb * 64 + 16 * mi + fr) * 64 + k1) * 128;
            wave_mma_lb<4, 4, 4, 136, 2>(ap, Cl64, acc, fr, fq);
            const float scale = 0.0013810679320049757f;
#pragma unroll
            for (int mi = 0; mi < 4; ++mi)
#pragma unroll
                for (int ni = 0; ni < 4; ++ni) {
                    const int k2 = 16 * ni + fr, kt = k1 + 64 * k2, row = NTOK_C + b * 4096 + kt, col = g * 128 + kb * 64 + 16 * mi + 4 * fq;
                    bf16_t* rp = U + (size_t)row * LDU;
                    const u32x2 gt = *(const u32x2*)(rp + C_GF + col);
                    f32x4 o; o[0] = acc[mi][ni][0] * scale * bflo(gt.x); o[1] = acc[mi][ni][1] * scale * bfhi(gt.x);
                    o[2] = acc[mi][ni][2] * scale * bflo(gt.y); o[3] = acc[mi][ni][3] * scale * bfhi(gt.y);
                    st4bf(rp + C_XF + col, o);
                }
        } else {
            const int w2 = wt - 1024, kb = w2 & 1, k1 = (w2 >> 1) & 15, bg = w2 >> 5, b = bg >> 2, g = bg & 3;
            const bf16_t* ap[4]; f32x4 acc[4][1];
#pragma unroll
            for (int mi = 0; mi < 4; ++mi) acc[mi][0] = (f32x4){0.f, 0.f, 0.f, 0.f};
#pragma unroll
            for (int mi = 0; mi < 4; ++mi) ap[mi] = Rctx + ((size_t)(bg * 128 + kb * 64 + 16 * mi + fr) * 16 + k1) * 32;
            wave_mma_lb<4, 1, 1, 40>(ap, Cl16, acc, fr, fq);
            const float scale = 0.005524271728019903f;
#pragma unroll
            for (int mi = 0; mi < 4; ++mi) {
                const int k2 = fr, kt = k1 + 16 * k2, row = b * 256 + kt, col = g * 128 + kb * 64 + 16 * mi + 4 * fq;
                bf16_t* rp = U + (size_t)row * LDU;
                const u32x2 gt = *(const u32x2*)(rp + C_GF + col);
                f32x4 o; o[0] = acc[mi][0][0] * scale * bflo(gt.x); o[1] = acc[mi][0][1] * scale * bfhi(gt.x);
                o[2] = acc[mi][0][2] * scale * bflo(gt.y); o[3] = acc[mi][0][3] * scale * bfhi(gt.y);
                st4bf(rp + C_XF + col, o);
            }
        }
    }
}

__device__ __forceinline__ float sh_mixed(const bf16_t* U, const float* mu, int row, int cs, int lat, int t) {
    int nb; bool valid;
    if (lat) {
        const int d = cs & 3, cg_ = t & 63, rg = t >> 6;
        if (d == 0) { valid = cg_ > 0; nb = row - 1; } else if (d == 1) { valid = cg_ < 63; nb = row + 1; }
        else if (d == 2) { valid = rg > 0; nb = row - 64; } else { valid = rg < 63; nb = row + 64; }
    } else {
        if (cs & 1) { valid = t < 255; nb = row + 1; } else { valid = t > 0; nb = row - 1; }
    }
    const float x = bf2f(U[(size_t)row * LDU + C_SH + cs]);
    const float s = valid ? bf2f(U[(size_t)nb * LDU + C_SH + cs]) : 0.0f;
    return x + mu[cs] * (s - x);
}

constexpr int LDP = 72;
constexpr int GS = 68;
constexpr int SC_X = 0, SC_AGF = 17408, SC_AAK = 17408, SC_ARK = 26624, SC_ARB = 35840, SC_TM = 45056, SC_TW = 54272, SC_AD = 63488,
              SC_AT = 72704, SC_RT = 81920, SC_BT = 91136, SC_KT = 100352, SC_BH = 109568, SC_KH = 118912, SC_VT = 128256, SC_SB = 137600, SC_EGL = 146816, SC_ABA = 147072, SC_PAR = 149632;
constexpr int LDQ = 40;
__device__ __forceinline__ bf16x8 ldfrag(const LAS bf16_t* arr, int row, int ks, int fq) { return *(const LAS bf16x8*)(arr + row * LDP + ks * 32 + fq * 8); }
__device__ __forceinline__ int tskew(int row) { return row * LDP + 8 * (row >> 3); }
__device__ __forceinline__ bf16x8 ldfragT(const LAS bf16_t* arr, int row, int ks, int fq) { return *(const LAS bf16x8*)(arr + tskew(row) + ks * 32 + fq * 8); }
__device__ __forceinline__ void st4lds(LAS bf16_t* p, const f32x4 v) { u32x2 w; w.x = pk2(v[0], v[1]); w.y = pk2(v[2], v[3]); *(LAS u32x2*)p = w; }
#define SBAR() do { asm volatile("s_waitcnt lgkmcnt(0)" ::: "memory"); __builtin_amdgcn_s_barrier(); asm volatile("" ::: "memory"); } while (0)
#define MMA16(a_, b_, c_) (c_) = __builtin_amdgcn_mfma_f32_16x16x32_bf16((a_), (b_), (c_), 0, 0, 0)

__device__ __forceinline__ float bfel(const u32x4 w, int e) { const unsigned x = w[e >> 1]; return (e & 1) ? bfhi(x) : bflo(x); }
__device__ __forceinline__ void mix8(const u32x4 self, const u32x4 (&nb)[4], const bool (&vl)[4], int lat, const f32x4 mu0, const f32x4 mu1, float (&out)[8]) {
#pragma unroll
    for (int e = 0; e < 8; ++e) {
        const float x = bfel(self, e);
        float s;
        if (lat) { const int d = e & 3; s = vl[d] ? bfel(nb[d], e) : 0.f; }
        else { const int d = e & 1; s = vl[d] ? bfel(nb[d], e) : 0.f; }
        const float m = (e < 4) ? mu0[e] : mu1[e - 4];
        out[e] = x + m * (s - x);
    }
}
__device__ __forceinline__ u32x4 pack8(const float (&v)[8]) { u32x4 w; w.x = pk2(v[0], v[1]); w.y = pk2(v[2], v[3]); w.z = pk2(v[4], v[5]); w.w = pk2(v[6], v[7]); return w; }
__device__ __forceinline__ float tanh_fast(float x) { const float e = __expf(2.0f * x); return 1.0f - 2.0f * __builtin_amdgcn_rcpf(e + 1.0f); }

__device__ __forceinline__ void phase_premix(const Args& a) {
    const bf16_t* U = (const bf16_t*)(a.ws + WS_U);
    bf16_t* MIX = (bf16_t*)(a.ws + WS_MIX);
    const float* mu = a.in[9];
    for (int idx = blockIdx.x * 512 + threadIdx.x; idx < NTOK * 16; idx += gridDim.x * 512) {
        const int row = idx >> 4, c0 = (idx & 15) * 8;
        const int lat = row >= NTOK_C, t = lat ? ((row - NTOK_C) & 4095) : (row & 255);
        bool nv[4]; int nrow[4];
        if (lat) { const int cx = t & 63, rg = t >> 6; nv[0] = cx > 0; nv[1] = cx < 63; nv[2] = rg > 0; nv[3] = rg < 63;
            nrow[0] = nv[0] ? row - 1 : row; nrow[1] = nv[1] ? row + 1 : row; nrow[2] = nv[2] ? row - 64 : row; nrow[3] = nv[3] ? row + 64 : row; }
        else { nv[0] = t > 0; nv[1] = t < 255; nv[2] = false; nv[3] = false; nrow[0] = nv[0] ? row - 1 : row; nrow[1] = nv[1] ? row + 1 : row; nrow[2] = row; nrow[3] = row; }
        const u32x4 Ws = *(const u32x4*)(U + (size_t)row * LDU + C_SH + 3072 + c0);
        u32x4 Wn[4];
#pragma unroll
        for (int d = 0; d < 4; ++d) { if (d < 2 || lat) Wn[d] = *(const u32x4*)(U + (size_t)nrow[d] * LDU + C_SH + 3072 + c0); else Wn[d] = Ws; }
        float o[8];
        mix8(Ws, Wn, nv, lat, *(const f32x4*)(mu + 3072 + c0), *(const f32x4*)(mu + 3072 + c0 + 4), o);
        if (c0 < 64) {
#pragma unroll
            for (int e = 0; e < 8; ++e) o[e] = tanh_fast(o[e]);
        }
        *(u32x4*)(MIX + (size_t)row * 128 + c0) = pack8(o);
    }
}

__device__ __forceinline__ void scan_chain(const Args& a, LAS unsigned char* lds, int lat, int b, int h, int dir, float ysc, int cbeg, int cend, int mode) {
    const int tid = threadIdx.x, lane = tid & 63, wv = __builtin_amdgcn_readfirstlane(tid >> 6), fr = lane & 15, fq = lane >> 4;
    const int T = lat ? 4096 : 256, row_base = lat ? NTOK_C + b * 4096 : b * 256;
    const bf16_t* U = (const bf16_t*)(a.ws + WS_U);
    const float* mu = a.in[9];
    LAS float* Gf = (LAS float*)(lds + SC_X); LAS float* AGf = (LAS float*)(lds + SC_AGF); LAS float* Aab = (LAS float*)(lds + SC_X);
    LAS bf16_t* Aak = (LAS bf16_t*)(lds + SC_AAK); LAS bf16_t* Ark = (LAS bf16_t*)(lds + SC_ARK); LAS bf16_t* Arb = (LAS bf16_t*)(lds + SC_ARB);
    LAS bf16_t* Tm = (LAS bf16_t*)(lds + SC_TM); LAS bf16_t* TW = (LAS bf16_t*)(lds + SC_TW); LAS bf16_t* AD = (LAS bf16_t*)(lds + SC_AD);
    LAS bf16_t* PT = TW; LAS bf16_t* UT = AD;
    LAS bf16_t* At = (LAS bf16_t*)(lds + SC_AT); LAS bf16_t* Rt = (LAS bf16_t*)(lds + SC_RT); LAS bf16_t* Bt = (LAS bf16_t*)(lds + SC_BT);
    LAS bf16_t* Kt = (LAS bf16_t*)(lds + SC_KT); LAS bf16_t* BhT = (LAS bf16_t*)(lds + SC_BH); LAS bf16_t* KhT = (LAS bf16_t*)(lds + SC_KH);
    LAS bf16_t* VT = (LAS bf16_t*)(lds + SC_VT); LAS bf16_t* Sb = (LAS bf16_t*)(lds + SC_SB); LAS float* EGL = (LAS float*)(lds + SC_EGL);
    const int nio = wv & 3, mo0 = 2 * (wv >> 2);
    f32x4 Sacc[2];
    {
        const int i = 16 * nio + fr;
#pragma unroll
        for (int mm = 0; mm < 2; ++mm) {
            const int j0 = 16 * (mo0 + mm) + 4 * fq;
            if (mode == 2) { Sacc[mm] = (f32x4){0.f, 0.f, 0.f, 0.f};
#pragma unroll
                for (int r = 0; r < 4; ++r) if (j0 + r == i) Sacc[mm][r] = 1.0f; }
            else if (lat && mode == 0) Sacc[mm] = *(const f32x4*)(a.in[2] + ((((size_t)b * 2 + dir) * 16 + h) * 64 + i) * 64 + j0);
            else Sacc[mm] = (f32x4){0.f, 0.f, 0.f, 0.f};
            st4lds(Sb + i * LDP + j0, Sacc[mm]);
        }
    }
    const int lr_strip = wv & 3;
    const bool lr_lo = wv < 4;
    const int lr_c = h * 64 + 16 * lr_strip + fr;
    const float lr_w0 = a.in[10][dir * 1024 + lr_c], lr_a0 = a.in[12][dir * 1024 + lr_c];
    const bf16_t* lr_bw = (const bf16_t*)(a.ws + WS_WUPT) + ((size_t)dir * 1024 + lr_c) * 64;
    const bf16_t* lr_ba = (const bf16_t*)(a.ws + WS_AUPT) + ((size_t)dir * 1024 + lr_c) * 64;
    u32x4 Rs, Ks, Vs, Rn[4], Kn[4], Vn[4]; bf16x8 Wf[2][4]; int nvm = 0;
    const bf16_t* MIXp = (const bf16_t*)(a.ws + WS_MIX);
    const int nch = cend;
#define SCAN_ISSUE(cidx) do { \
        const int l2_ = threadIdx.x & 63, p2_ = (l2_ >> 3) + 8 * wv, g2_ = l2_ & 7; \
        const int pos_ = (cidx) * 64 + p2_, t_ = dir ? T - 1 - pos_ : pos_, row_ = row_base + t_; \
        int n0_, n1_, n2_, n3_, m_ = 0; \
        if (lat) { const int cx = t_ & 63, rg = t_ >> 6; m_ = (cx > 0 ? 1 : 0) | (cx < 63 ? 2 : 0) | (rg > 0 ? 4 : 0) | (rg < 63 ? 8 : 0); \
            n0_ = (m_ & 1) ? row_ - 1 : row_; n1_ = (m_ & 2) ? row_ + 1 : row_; n2_ = (m_ & 4) ? row_ - 64 : row_; n3_ = (m_ & 8) ? row_ + 64 : row_; } \
        else { m_ = (t_ > 0 ? 1 : 0) | (t_ < 255 ? 2 : 0); n0_ = (m_ & 1) ? row_ - 1 : row_; n1_ = (m_ & 2) ? row_ + 1 : row_; n2_ = row_; n3_ = row_; } \
        nvm = m_; \
        const int colr_ = h * 64 + 8 * g2_; \
        const bf16_t* sp_ = U + (size_t)row_ * LDU + C_SH + colr_; \
        Rs = *(const u32x4*)(sp_); Ks = *(const u32x4*)(sp_ + 1024); Vs = *(const u32x4*)(sp_ + 2048); \
        { const bf16_t* q_ = U + (size_t)n0_ * LDU + C_SH + colr_; Rn[0] = *(const u32x4*)(q_); Kn[0] = *(const u32x4*)(q_ + 1024); Vn[0] = *(const u32x4*)(q_ + 2048); } \
        { const bf16_t* q_ = U + (size_t)n1_ * LDU + C_SH + colr_; Rn[1] = *(const u32x4*)(q_); Kn[1] = *(const u32x4*)(q_ + 1024); Vn[1] = *(const u32x4*)(q_ + 2048); } \
        if (lat) { \
            { const bf16_t* q_ = U + (size_t)n2_ * LDU + C_SH + colr_; Rn[2] = *(const u32x4*)(q_); Kn[2] = *(const u32x4*)(q_ + 1024); Vn[2] = *(const u32x4*)(q_ + 2048); } \
            { const bf16_t* q_ = U + (size_t)n3_ * LDU + C_SH + colr_; Rn[3] = *(const u32x4*)(q_); Kn[3] = *(const u32x4*)(q_ + 1024); Vn[3] = *(const u32x4*)(q_ + 2048); } \
        } else { Rn[2] = Rs; Kn[2] = Ks; Vn[2] = Vs; Rn[3] = Rs; Kn[3] = Ks; Vn[3] = Vs; } \
        _Pragma("unroll") for (int mi_ = 0; mi_ < 4; ++mi_) { \
            const int pw_ = (cidx) * 64 + 16 * mi_ + (l2_ & 15), tw_ = dir ? T - 1 - pw_ : pw_; \
            const bf16_t* wp_ = MIXp + (size_t)(row_base + tw_) * 128 + (((mi_ < 2) == lr_lo) ? 0 : 64) + (l2_ >> 4) * 8; \
            Wf[0][mi_] = *(const bf16x8*)(wp_); Wf[1][mi_] = *(const bf16x8*)(wp_ + 32); } \
    } while (0)
    {
        LAS float* PAR = (LAS float*)(lds + SC_PAR);
        const int tt = threadIdx.x;
        if (tt < 384) { const int w_ = tt >> 6, cc_ = h * 64 + (tt & 63);
            PAR[tt] = (w_ == 0) ? mu[cc_] : (w_ == 1) ? mu[1024 + cc_] : (w_ == 2) ? mu[2048 + cc_] : (w_ == 3) ? a.in[14][cc_] : (w_ == 4) ? a.in[15][cc_] : a.in[16][cc_]; }
    }
    for (int i_ = threadIdx.x; i_ < 32 * 32; i_ += 512) Tm[(i_ >> 5) * LDP + 32 + (i_ & 31)] = (bf16_t)0;
    SCAN_ISSUE(cbeg);
    for (int chunk = cbeg; chunk < nch; ++chunk) {
        int lv_ = threadIdx.x & 63; asm volatile("" : "+v"(lv_));
        const int lane = lv_, fr = lv_ & 15, fq = lv_ >> 4;
        const int tk_p = (lv_ >> 3) + 8 * wv, tk_cg = lv_ & 7;
        const int colr = h * 64 + 8 * tk_cg;
        {
            const int dmi = lr_lo ? 0 : 2, ami = lr_lo ? 2 : 0;
            f32x4 accd[2], acca[2];
#pragma unroll
            for (int mm = 0; mm < 2; ++mm) { accd[mm] = (f32x4){lr_w0, lr_w0, lr_w0, lr_w0}; acca[mm] = (f32x4){lr_a0, lr_a0, lr_a0, lr_a0}; }
#pragma unroll
            for (int ks = 0; ks < 2; ++ks) {
                const bf16x8 bw = *(const bf16x8*)(lr_bw + ks * 32 + fq * 8), ba = *(const bf16x8*)(lr_ba + ks * 32 + fq * 8);
                if (lr_lo) { MMA16(Wf[ks][0], bw, accd[0]); MMA16(Wf[ks][1], bw, accd[1]); MMA16(Wf[ks][2], ba, acca[0]); MMA16(Wf[ks][3], ba, acca[1]); }
                else       { MMA16(Wf[ks][2], bw, accd[0]); MMA16(Wf[ks][3], bw, accd[1]); MMA16(Wf[ks][0], ba, acca[0]); MMA16(Wf[ks][1], ba, acca[1]); }
            }
            const int ch = 16 * lr_strip + fr;
            float carry = 0.f;
#pragma unroll
            for (int mm = 0; mm < 2; ++mm) {
                float c[4];
#pragma unroll
                for (int r = 0; r < 4; ++r) {
                    const float lw = -0.87503878f * sigmoidf_(accd[mm][r]);
                    c[r] = (r ? c[r - 1] : 0.f) + lw;
                }
                const float t0 = __shfl(c[3], fr), t1 = __shfl(c[3], fr + 16), t2 = __shfl(c[3], fr + 32), t3 = __shfl(c[3], fr + 48);
                const float off = carry + (fq > 0 ? t0 : 0.f) + (fq > 1 ? t1 : 0.f) + (fq > 2 ? t2 : 0.f);
#pragma unroll
                for (int r = 0; r < 4; ++r) Gf[(16 * (dmi + mm) + 4 * fq + r) * GS + ch] = off + c[r];
                carry += (t0 + t1) + (t2 + t3);
            }
#pragma unroll
            for (int mm = 0; mm < 2; ++mm)
#pragma unroll
                for (int r = 0; r < 4; ++r) AGf[(16 * (ami + mm) + 4 * fq + r) * GS + ch] = sigmoidf_(acca[mm][r]);
        }
        SBAR();
        {
            const int c0 = 8 * tk_cg, p = tk_p;
            float rr[8], kx[8], vv[8];
            const bool nv[4] = {(nvm & 1) != 0, (nvm & 2) != 0, (nvm & 4) != 0, (nvm & 8) != 0};
            {
                const LAS float* PAR = (const LAS float*)(lds + SC_PAR) + c0;
                const f32x4 a0 = *(const LAS f32x4*)(PAR), a1 = *(const LAS f32x4*)(PAR + 4);
                mix8(Rs, Rn, nv, lat, a0, a1, rr);
                const f32x4 b0 = *(const LAS f32x4*)(PAR + 64), b1 = *(const LAS f32x4*)(PAR + 68);
                mix8(Ks, Kn, nv, lat, b0, b1, kx);
                const f32x4 d0 = *(const LAS f32x4*)(PAR + 128), d1 = *(const LAS f32x4*)(PAR + 132);
                mix8(Vs, Vn, nv, lat, d0, d1, vv);
                if (mode == 2) {
#pragma unroll
                    for (int e = 0; e < 8; ++e) vv[e] = 0.f; }
            }
            f32x4 g0 = *(const LAS f32x4*)(Gf + p * GS + c0), g1 = *(const LAS f32x4*)(Gf + p * GS + c0 + 4);
            const int pm = p > 0 ? p - 1 : 0;
            f32x4 q0 = *(const LAS f32x4*)(Gf + pm * GS + c0), q1 = *(const LAS f32x4*)(Gf + pm * GS + c0 + 4);
            const f32x4 h0 = *(const LAS f32x4*)(Gf + 31 * GS + c0), h1 = *(const LAS f32x4*)(Gf + 31 * GS + c0 + 4);
            if (p == 0) { q0 = (f32x4){0.f, 0.f, 0.f, 0.f}; q1 = q0; }
            if (p >= 32) { g0 += h0; g1 += h1; }
            if (p >= 33) { q0 += h0; q1 += h1; }
            const f32x4 ag0 = *(const LAS f32x4*)(AGf + p * GS + c0), ag1 = *(const LAS f32x4*)(AGf + p * GS + c0 + 4);
            const f32x4 l0 = *(const LAS f32x4*)(Gf + 63 * GS + c0) + h0, l1 = *(const LAS f32x4*)(Gf + 63 * GS + c0 + 4) + h1;
            const f32x4 kk0 = *(const LAS f32x4*)((const LAS float*)(lds + SC_PAR) + 192 + c0), kk1 = *(const LAS f32x4*)((const LAS float*)(lds + SC_PAR) + 196 + c0);
            const f32x4 ka0 = *(const LAS f32x4*)((const LAS float*)(lds + SC_PAR) + 256 + c0), ka1 = *(const LAS f32x4*)((const LAS float*)(lds + SC_PAR) + 260 + c0);
            float kkv[8], n2 = 0.f;
#pragma unroll
            for (int e = 0; e < 8; ++e) { kkv[e] = kx[e] * (e < 4 ? kk0[e] : kk1[e - 4]); n2 += kkv[e] * kkv[e]; }
            n2 += __shfl_xor(n2, 1); n2 += __shfl_xor(n2, 2); n2 += __shfl_xor(n2, 4);
            if (dir == 0 && mode != 2) {
                const f32x4 rk0 = *(const LAS f32x4*)((const LAS float*)(lds + SC_PAR) + 320 + c0), rk1 = *(const LAS f32x4*)((const LAS float*)(lds + SC_PAR) + 324 + c0);
                float bs = 0.f;
#pragma unroll
                for (int e = 0; e < 8; ++e) bs += rr[e] * kx[e] * (e < 4 ? rk0[e] : rk1[e - 4]);
                bs += __shfl_xor(bs, 1); bs += __shfl_xor(bs, 2); bs += __shfl_xor(bs, 4);
                float bo[8];
#pragma unroll
                for (int e = 0; e < 8; ++e) bo[e] = bs * vv[e];
                const int bpos = chunk * 64 + p, bt = bpos;
                *(u32x4*)((bf16_t*)a.out + BON_OFF + (size_t)(row_base + bt) * DM + h * 64 + c0) = pack8(bo);
            }
            const float inv = __builtin_amdgcn_rcpf(fmaxf(__builtin_amdgcn_sqrtf(n2), 1e-12f));
            float oa[8], orr[8], ob[8], ok[8];
#pragma unroll
            for (int e = 0; e < 8; ++e) {
                const float g = e < 4 ? g0[e] : g1[e - 4], gp = e < 4 ? q0[e] : q1[e - 4], ag = e < 4 ? ag0[e] : ag1[e - 4], gl = e < 4 ? l0[e] : l1[e - 4];
                const float kac = e < 4 ? ka0[e] : ka1[e - 4];
                const float kkn = kkv[e] * inv, kd = kx[e] * (1.0f + (ag - 1.0f) * kac), bb = kkn * ag;
                const float emg = __builtin_amdgcn_exp2f(-g), eh = __builtin_amdgcn_exp2f(gl - g);
                oa[e] = -kkn * __builtin_amdgcn_exp2f(gp); orr[e] = rr[e] * __builtin_amdgcn_exp2f(g); ob[e] = bb * emg; ok[e] = kd * emg;
                BhT[tskew(c0 + e) + p] = (bf16_t)f2bf(bb * eh);
                KhT[tskew(c0 + e) + p] = (bf16_t)f2bf(kd * eh);
                VT[tskew(c0 + e) + p] = (bf16_t)f2bf(vv[e]);
                if (p == 0) EGL[c0 + e] = __builtin_amdgcn_exp2f(gl);
            }
            *(LAS u32x4*)(At + p * LDP + c0) = pack8(oa); *(LAS u32x4*)(Rt + p * LDP + c0) = pack8(orr);
            *(LAS u32x4*)(Bt + p * LDP + c0) = pack8(ob); *(LAS u32x4*)(Kt + p * LDP + c0) = pack8(ok);
        }
        SBAR();
        {
#pragma unroll
            for (int rep = 0; rep < 2; ++rep) {
                const int tix = wv + 8 * rep;
                if (tix < 10) {
                    const int mi = tix < 4 ? 0 : tix < 7 ? 1 : tix < 9 ? 2 : 3, ni = tix < 4 ? tix : tix < 7 ? tix - 3 : tix < 9 ? tix - 5 : 3;
                    const bf16x8 x0 = ldfrag(Bt, 16 * mi + fr, 0, fq), x1 = ldfrag(Bt, 16 * mi + fr, 1, fq), y0 = ldfrag(At, 16 * ni + fr, 0, fq), y1 = ldfrag(At, 16 * ni + fr, 1, fq);
                    f32x4 c = (f32x4){0.f, 0.f, 0.f, 0.f};
                    MMA16(x0, y0, c); MMA16(x1, y1, c);
                    const int t = 16 * ni + fr, tau0 = 16 * mi + 4 * fq;
#pragma unroll
                    for (int r = 0; r < 4; ++r) if (tau0 + r >= t) c[r] = 0.f;
                    *(LAS f32x4*)(Aab + t * GS + tau0) = c;
                    if (mi < 2 && ni >= 2) st4lds((LAS bf16_t*)(lds + SC_ABA) + (t - 32) * LDQ + tau0, c);
                }
            }
        }
        SBAR();
        if (wv != 0) {
#pragma unroll 1
            for (int idx = wv - 1; idx < 48; idx += 7) {
                const int mat = 1 + (idx >> 4), mi = (idx >> 2) & 3, ni = idx & 3;
                const LAS bf16_t* X = (mat == 2) ? Bt : Kt;
                const LAS bf16_t* Y = (mat == 1) ? At : Rt;
                LAS bf16_t* dst = (mat == 1) ? Aak : (mat == 2) ? Arb : Ark;
                f32x4 c = (f32x4){0.f, 0.f, 0.f, 0.f};
                if (mi <= ni) {
                    const bf16x8 x0 = ldfrag(X, 16 * mi + fr, 0, fq), x1 = ldfrag(X, 16 * mi + fr, 1, fq), y0 = ldfrag(Y, 16 * ni + fr, 0, fq), y1 = ldfrag(Y, 16 * ni + fr, 1, fq);
                    MMA16(x0, y0, c); MMA16(x1, y1, c);
                }
                const int t = 16 * ni + fr, tau0 = 16 * mi + 4 * fq;
#pragma unroll
                for (int r = 0; r < 4; ++r) { const int tau = tau0 + r; if ((mat != 1) ? (tau > t) : (tau >= t)) c[r] = 0.f; }
                st4lds(dst + t * LDP + tau0, c);
            }
        }
        if (wv == 0) {
            LAS bf16_t* AbBA = (LAS bf16_t*)(lds + SC_ABA); LAS bf16_t* TT = UT; LAS bf16_t* WsT = UT + 32 * LDQ;
            const int hb = lane >> 5, c = lane & 31;
            const float cf = (float)c;
            float Tr[32];
#pragma unroll
            for (int t = 0; t < 32; ++t) Tr[t] = 0.f;
            {
                const int abase_i = (32 * hb) * GS + 32 * hb;
                f32x2_t TP[16];
#pragma unroll
                for (int q = 0; q < 16; ++q) TP[q] = (f32x2_t){0.f, 0.f};
                Tr[0] = 1.0f - fminf(cf, 1.0f); TP[0][0] = Tr[0];
                const f32x4 r1_0 = *(const LAS f32x4*)(Aab + abase_i + 68);
                const f32x4 r2_0 = *(const LAS f32x4*)(Aab + abase_i + 136);
                int o3 = abase_i + 204; asm volatile("" : "+v"(o3) : "v"(Tr[0]));
                const f32x4 r3_0 = *(const LAS f32x4*)(Aab + o3 + 0);
                __builtin_amdgcn_sched_barrier(0);
                { const f32x2_t pa = (f32x2_t){r1_0[0], r1_0[1]} * TP[0]; const f32x2_t pb = (f32x2_t){0.f, 0.f}; const f32x2_t ps = pa + pb;
                  Tr[1] = (ps[0] + ps[1]) + (1.0f - fminf(fabsf(cf - 1.0f), 1.0f)); TP[0][1] = Tr[1]; }
                __builtin_amdgcn_sched_barrier(0);
                int o4 = abase_i + 272; asm volatile("" : "+v"(o4) : "v"(Tr[1]));
                const f32x4 r4_0 = *(const LAS f32x4*)(Aab + o4 + 0);
                __builtin_amdgcn_sched_barrier(0);
                { const f32x2_t pa = (f32x2_t){r2_0[0], r2_0[1]} * TP[0]; const f32x2_t pb = (f32x2_t){0.f, 0.f}; const f32x2_t ps = pa + pb;
                  Tr[2] = (ps[0] + ps[1]) + (1.0f - fminf(fabsf(cf - 2.0f), 1.0f)); TP[1][0] = Tr[2]; }
                __builtin_amdgcn_sched_barrier(0);
                int o5 = abase_i + 340; asm volatile("" : "+v"(o5) : "v"(Tr[2]));
                const f32x4 r5_0 = *(const LAS f32x4*)(Aab + o5 + 0); const f32x4 r5_1 = *(const LAS f32x4*)(Aab + o5 + 4);
                __builtin_amdgcn_sched_barrier(0);
                { const f32x2_t pa = (f32x2_t){r3_0[0], r3_0[1]} * TP[0]; const f32x2_t pb = (f32x2_t){r3_0[2], r3_0[3]} * TP[1]; const f32x2_t ps = pa + pb;
                  Tr[3] = (ps[0] + ps[1]) + (1.0f - fminf(fabsf(cf - 3.0f), 1.0f)); TP[1][1] = Tr[3]; }
                __builtin_amdgcn_sched_barrier(0);
                int o6 = abase_i + 408; asm volatile("" : "+v"(o6) : "v"(Tr[3]));
                const f32x4 r6_0 = *(const LAS f32x4*)(Aab + o6 + 0); const f32x4 r6_1 = *(const LAS f32x4*)(Aab + o6 + 4);
                __builtin_amdgcn_sched_barrier(0);
                { const f32x2_t pa = (f32x2_t){r4_0[0], r4_0[1]} * TP[0]; const f32x2_t pb = (f32x2_t){r4_0[2], r4_0[3]} * TP[1]; const f32x2_t ps = pa + pb;
                  Tr[4] = (ps[0] + ps[1]) + (1.0f - fminf(fabsf(cf - 4.0f), 1.0f)); TP[2][0] = Tr[4]; }
                __builtin_amdgcn_sched_barrier(0);
                int o7 = abase_i + 476; asm volatile("" : "+v"(o7) : "v"(Tr[4]));
                const f32x4 r7_0 = *(const LAS f32x4*)(Aab + o7 + 0); const f32x4 r7_1 = *(const LAS f32x4*)(Aab + o7 + 4);
                __builtin_amdgcn_sched_barrier(0);
                { const f32x2_t pa = (f32x2_t){r5_0[0], r5_0[1]} * TP[0] + (f32x2_t){r5_1[0], r5_1[1]} * TP[2]; const f32x2_t pb = (f32x2_t){r5_0[2], r5_0[3]} * TP[1]; const f32x2_t ps = pa + pb;
                  Tr[5] = (ps[0] + ps[1]) + (1.0f - fminf(fabsf(cf - 5.0f), 1.0f)); TP[2][1] = Tr[5]; }
                __builtin_amdgcn_sched_barrier(0);
                int o8 = abase_i + 544; asm volatile("" : "+v"(o8) : "v"(Tr[5]));
                const f32x4 r8_0 = *(const LAS f32x4*)(Aab + o8 + 0); const f32x4 r8_1 = *(const LAS f32x4*)(Aab + o8 + 4);
                __builtin_amdgcn_sched_barrier(0);
                { const f32x2_t pa = (f32x2_t){r6_0[0], r6_0[1]} * TP[0] + (f32x2_t){r6_1[0], r6_1[1]} * TP[2]; const f32x2_t pb = (f32x2_t){r6_0[2], r6_0[3]} * TP[1]; const f32x2_t ps = pa + pb;
                  Tr[6] = (ps[0] + ps[1]) + (1.0f - fminf(fabsf(cf - 6.0f), 1.0f)); TP[3][0] = Tr[6]; }
                __builtin_amdgcn_sched_barrier(0);
                int o9 = abase_i + 612; asm volatile("" : "+v"(o9) : "v"(Tr[6]));
                const f32x4 r9_0 = *(const LAS f32x4*)(Aab + o9 + 0); const f32x4 r9_1 = *(const LAS f32x4*)(Aab + o9 + 4); const f32x4 r9_2 = *(const LAS f32x4*)(Aab + o9 + 8);
                __builtin_amdgcn_sched_barrier(0);
                { const f32x2_t pa = (f32x2_t){r7_0[0], r7_0[1]} * TP[0] + (f32x2_t){r7_1[0], r7_1[1]} * TP[2]; const f32x2_t pb = (f32x2_t){r7_0[2], r7_0[3]} * TP[1] + (f32x2_t){r7_1[2], r7_1[3]} * TP[3]; const f32x2_t ps = pa + pb;
                  Tr[7] = (ps[0] + ps[1]) + (1.0f - fminf(fabsf(cf - 7.0f), 1.0f)); TP[3][1] = Tr[7]; }
                __builtin_amdgcn_sched_barrier(0);
                int o10 = abase_i + 680; asm volatile("" : "+v"(o10) : "v"(Tr[7]));
                const f32x4 r10_0 = *(const LAS f32x4*)(Aab + o10 + 0); const f32x4 r10_1 = *(const LAS f32x4*)(Aab + o10 + 4); const f32x4 r10_2 = *(const LAS f32x4*)(Aab + o10 + 8);
                __builtin_amdgcn_sched_barrier(0);
                { const f32x2_t pa = (f32x2_t){r8_0[0], r8_0[1]} * TP[0] + (f32x2_t){r8_1[0], r8_1[1]} * TP[2]; const f32x2_t pb = (f32x2_t){r8_0[2], r8_0[3]} * TP[1] + (f32x2_t){r8_1[2], r8_1[3]} * TP[3]; const f32x2_t ps = pa + pb;
                  Tr[8] = (ps[0] + ps[1]) + (1.0f - fminf(fabsf(cf - 8.0f), 1.0f)); TP[4][0] = Tr[8]; }
                __builtin_amdgcn_sched_barrier(0);
                int o11 = abase_i + 748; asm volatile("" : "+v"(o11) : "v"(Tr[8]));
                const f32x4 r11_0 = *(const LAS f32x4*)(Aab + o11 + 0); const f32x4 r11_1 = *(const LAS f32x4*)(Aab + o11 + 4); const f32x4 r11_2 = *(const LAS f32x4*)(Aab + o11 + 8);
                __builtin_amdgcn_sched_barrier(0);
                { const f32x2_t pa = (f32x2_t){r9_0[0], r9_0[1]} * TP[0] + (f32x2_t){r9_1[0], r9_1[1]} * TP[2] + (f32x2_t){r9_2[0], r9_2[1]} * TP[4]; const f32x2_t pb = (f32x2_t){r9_0[2], r9_0[3]} * TP[1] + (f32x2_t){r9_1[2], r9_1[3]} * TP[3]; const f32x2_t ps = pa + pb;
                  Tr[9] = (ps[0] + ps[1]) + (1.0f - fminf(fabsf(cf - 9.0f), 1.0f)); TP[4][1] = Tr[9]; }
                __builtin_amdgcn_sched_barrier(0);
                int o12 = abase_i + 816; asm volatile("" : "+v"(o12) : "v"(Tr[9]));
                const f32x4 r12_0 = *(const LAS f32x4*)(Aab + o12 + 0); const f32x4 r12_1 = *(const LAS f32x4*)(Aab + o12 + 4); const f32x4 r12_2 = *(const LAS f32x4*)(Aab + o12 + 8);
                __builtin_amdgcn_sched_barrier(0);
                { const f32x2_t pa = (f32x2_t){r10_0[0], r10_0[1]} * TP[0] + (f32x2_t){r10_1[0], r10_1[1]} * TP[2] + (f32x2_t){r10_2[0], r10_2[1]} * TP[4]; const f32x2_t pb = (f32x2_t){r10_0[2], r10_0[3]} * TP[1] + (f32x2_t){r10_1[2], r10_1[3]} * TP[3]; const f32x2_t ps = pa + pb;
                  Tr[10] = (ps[0] + ps[1]) + (1.0f - fminf(fabsf(cf - 10.0f), 1.0f)); TP[5][0] = Tr[10]; }
                __builtin_amdgcn_sched_barrier(0);
                int o13 = abase_i + 884; asm volatile("" : "+v"(o13) : "v"(Tr[10]));
                const f32x4 r13_0 = *(const LAS f32x4*)(Aab + o13 + 0); const f32x4 r13_1 = *(const LAS f32x4*)(Aab + o13 + 4); const f32x4 r13_2 = *(const LAS f32x4*)(Aab + o13 + 8); const f32x4 r13_3 = *(const LAS f32x4*)(Aab + o13 + 12);
                __builtin_amdgcn_sched_barrier(0);
                { const f32x2_t pa = (f32x2_t){r11_0[0], r11_0[1]} * TP[0] + (f32x2_t){r11_1[0], r11_1[1]} * TP[2] + (f32x2_t){r11_2[0], r11_2[1]} * TP[4]; const f32x2_t pb = (f32x2_t){r11_0[2], r11_0[3]} * TP[1] + (f32x2_t){r11_1[2], r11_1[3]} * TP[3] + (f32x2_t){r11_2[2], r11_2[3]} * TP[5]; const f32x2_t ps = pa + pb;
                  Tr[11] = (ps[0] + ps[1]) + (1.0f - fminf(fabsf(cf - 11.0f), 1.0f)); TP[5][1] = Tr[11]; }
                __builtin_amdgcn_sched_barrier(0);
                int o14 = abase_i + 952; asm volatile("" : "+v"(o14) : "v"(Tr[11]));
                const f32x4 r14_0 = *(const LAS f32x4*)(Aab + o14 + 0); const f32x4 r14_1 = *(const LAS f32x4*)(Aab + o14 + 4); const f32x4 r14_2 = *(const LAS f32x4*)(Aab + o14 + 8); const f32x4 r14_3 = *(const LAS f32x4*)(Aab + o14 + 12);
                __builtin_amdgcn_sched_barrier(0);
                { const f32x2_t pa = (f32x2_t){r12_0[0], r12_0[1]} * TP[0] + (f32x2_t){r12_1[0], r12_1[1]} * TP[2] + (f32x2_t){r12_2[0], r12_2[1]} * TP[4]; const f32x2_t pb = (f32x2_t){r12_0[2], r12_0[3]} * TP[1] + (f32x2_t){r12_1[2], r12_1[3]} * TP[3] + (f32x2_t){r12_2[2], r12_2[3]} * TP[5]; const f32x2_t ps = pa + pb;
                  Tr[12] = (ps[0] + ps[1]) + (1.0f - fminf(fabsf(cf - 12.0f), 1.0f)); TP[6][0] = Tr[12]; }
                __builtin_amdgcn_sched_barrier(0);
                int o15 = abase_i + 1020; asm volatile("" : "+v"(o15) : "v"(Tr[12]));
                const f32x4 r15_0 = *(const LAS f32x4*)(Aab + o15 + 0); const f32x4 r15_1 = *(const LAS f32x4*)(Aab + o15 + 4); const f32x4 r15_2 = *(const LAS f32x4*)(Aab + o15 + 8); const f32x4 r15_3 = *(const LAS f32x4*)(Aab + o15 + 12);
                __builtin_amdgcn_sched_barrier(0);
                { const f32x2_t pa = (f32x2_t){r13_0[0], r13_0[1]} * TP[0] + (f32x2_t){r13_1[0], r13_1[1]} * TP[2] + (f32x2_t){r13_2[0], r13_2[1]} * TP[4] + (f32x2_t){r13_3[0], r13_3[1]} * TP[6]; const f32x2_t pb = (f32x2_t){r13_0[2], r13_0[3]} * TP[1] + (f32x2_t){r13_1[2], r13_1[3]} * TP[3] + (f32x2_t){r13_2[2], r13_2[3]} * TP[5]; const f32x2_t ps = pa + pb;
                  Tr[13] = (ps[0] + ps[1]) + (1.0f - fminf(fabsf(cf - 13.0f), 1.0f)); TP[6][1] = Tr[13]; }
                __builtin_amdgcn_sched_barrier(0);
                int o16 = abase_i + 1088; asm volatile("" : "+v"(o16) : "v"(Tr[13]));
                const f32x4 r16_0 = *(const LAS f32x4*)(Aab + o16 + 0); const f32x4 r16_1 = *(const LAS f32x4*)(Aab + o16 + 4); const f32x4 r16_2 = *(const LAS f32x4*)(Aab + o16 + 8); const f32x4 r16_3 = *(const LAS f32x4*)(Aab + o16 + 12);
                __builtin_amdgcn_sched_barrier(0);
                { const f32x2_t pa = (f32x2_t){r14_0[0], r14_0[1]} * TP[0] + (f32x2_t){r14_1[0], r14_1[1]} * TP[2] + (f32x2_t){r14_2[0], r14_2[1]} * TP[4] + (f32x2_t){r14_3[0], r14_3[1]} * TP[6]; const f32x2_t pb = (f32x2_t){r14_0[2], r14_0[3]} * TP[1] + (f32x2_t){r14_1[2], r14_1[3]} * TP[3] + (f32x2_t){r14_2[2], r14_2[3]} * TP[5]; const f32x2_t ps = pa + pb;
                  Tr[14] = (ps[0] + ps[1]) + (1.0f - fminf(fabsf(cf - 14.0f), 1.0f)); TP[7][0] = Tr[14]; }
                __builtin_amdgcn_sched_barrier(0);
                int o17 = abase_i + 1156; asm volatile("" : "+v"(o17) : "v"(Tr[14]));
                const f32x4 r17_0 = *(const LAS f32x4*)(Aab + o17 + 0); const f32x4 r17_1 = *(const LAS f32x4*)(Aab + o17 + 4); const f32x4 r17_2 = *(const LAS f32x4*)(Aab + o17 + 8); const f32x4 r17_3 = *(const LAS f32x4*)(Aab + o17 + 12); const f32x4 r17_4 = *(const LAS f32x4*)(Aab + o17 + 16);
                __builtin_amdgcn_sched_barrier(0);
                { const f32x2_t pa = (f32x2_t){r15_0[0], r15_0[1]} * TP[0] + (f32x2_t){r15_1[0], r15_1[1]} * TP[2] + (f32x2_t){r15_2[0], r15_2[1]} * TP[4] + (f32x2_t){r15_3[0], r15_3[1]} * TP[6]; const f32x2_t pb = (f32x2_t){r15_0[2], r15_0[3]} * TP[1] + (f32x2_t){r15_1[2], r15_1[3]} * TP[3] + (f32x2_t){r15_2[2], r15_2[3]} * TP[5] + (f32x2_t){r15_3[2], r15_3[3]} * TP[7]; const f32x2_t ps = pa + pb;
                  Tr[15] = (ps[0] + ps[1]) + (1.0f - fminf(fabsf(cf - 15.0f), 1.0f)); TP[7][1] = Tr[15]; }
                __builtin_amdgcn_sched_barrier(0);
                int o18 = abase_i + 1224; asm volatile("" : "+v"(o18) : "v"(Tr[15]));
                const f32x4 r18_0 = *(const LAS f32x4*)(Aab + o18 + 0); const f32x4 r18_1 = *(const LAS f32x4*)(Aab + o18 + 4); const f32x4 r18_2 = *(const LAS f32x4*)(Aab + o18 + 8); const f32x4 r18_3 = *(const LAS f32x4*)(Aab + o18 + 12); const f32x4 r18_4 = *(const LAS f32x4*)(Aab + o18 + 16);
                __builtin_amdgcn_sched_barrier(0);
                { const f32x2_t pa = (f32x2_t){r16_0[0], r16_0[1]} * TP[0] + (f32x2_t){r16_1[0], r16_1[1]} * TP[2] + (f32x2_t){r16_2[0], r16_2[1]} * TP[4] + (f32x2_t){r16_3[0], r16_3[1]} * TP[6]; const f32x2_t pb = (f32x2_t){r16_0[2], r16_0[3]} * TP[1] + (f32x2_t){r16_1[2], r16_1[3]} * TP[3] + (f32x2_t){r16_2[2], r16_2[3]} * TP[5] + (f32x2_t){r16_3[2], r16_3[3]} * TP[7]; const f32x2_t ps = pa + pb;
                  Tr[16] = (ps[0] + ps[1]) + (1.0f - fminf(fabsf(cf - 16.0f), 1.0f)); TP[8][0] = Tr[16]; }
                __builtin_amdgcn_sched_barrier(0);
                int o19 = abase_i + 1292; asm volatile("" : "+v"(o19) : "v"(Tr[16]));
                const f32x4 r19_0 = *(const LAS f32x4*)(Aab + o19 + 0); const f32x4 r19_1 = *(const LAS f32x4*)(Aab + o19 + 4); const f32x4 r19_2 = *(const LAS f32x4*)(Aab + o19 + 8); const f32x4 r19_3 = *(const LAS f32x4*)(Aab + o19 + 12); const f32x4 r19_4 = *(const LAS f32x4*)(Aab + o19 + 16);
                __builtin_amdgcn_sched_barrier(0);
                { const f32x2_t pa = (f32x2_t){r17_0[0], r17_0[1]} * TP[0] + (f32x2_t){r17_1[0], r17_1[1]} * TP[2] + (f32x2_t){r17_2[0], r17_2[1]} * TP[4] + (f32x2_t){r17_3[0], r17_3[1]} * TP[6] + (f32x2_t){r17_4[0], r17_4[1]} * TP[8]; const f32x2_t pb = (f32x2_t){r17_0[2], r17_0[3]} * TP[1] + (f32x2_t){r17_1[2], r17_1[3]} * TP[3] + (f32x2_t){r17_2[2], r17_2[3]} * TP[5] + (f32x2_t){r17_3[2], r17_3[3]} * TP[7]; const f32x2_t ps = pa + pb;
                  Tr[17] = (ps[0] + ps[1]) + (1.0f - fminf(fabsf(cf - 17.0f), 1.0f)); TP[8][1] = Tr[17]; }
                __builtin_amdgcn_sched_barrier(0);
                int o20 = abase_i + 1360; asm volatile("" : "+v"(o20) : "v"(Tr[17]));
                const f32x4 r20_0 = *(const LAS f32x4*)(Aab + o20 + 0); const f32x4 r20_1 = *(const LAS f32x4*)(Aab + o20 + 4); const f32x4 r20_2 = *(const LAS f32x4*)(Aab + o20 + 8); const f32x4 r20_3 = *(const LAS f32x4*)(Aab + o20 + 12); const f32x4 r20_4 = *(const LAS f32x4*)(Aab + o20 + 16);
                __builtin_amdgcn_sched_barrier(0);
                { const f32x2_t pa = (f32x2_t){r18_0[0], r18_0[1]} * TP[0] + (f32x2_t){r18_1[0], r18_1[1]} * TP[2] + (f32x2_t){r18_2[0], r18_2[1]} * TP[4] + (f32x2_t){r18_3[0], r18_3[1]} * TP[6] + (f32x2_t){r18_4[0], r18_4[1]} * TP[8]; const f32x2_t pb = (f32x2_t){r18_0[2], r18_0[3]} * TP[1] + (f32x2_t){r18_1[2], r18_1[3]} * TP[3] + (f32x2_t){r18_2[2], r18_2[3]} * TP[5] + (f32x2_t){r18_3[2], r18_3[3]} * TP[7]; const f32x2_t ps = pa + pb;
                  Tr[18] = (ps[0] + ps[1]) + (1.0f - fminf(fabsf(cf - 18.0f), 1.0f)); TP[9][0] = Tr[18]; }
                __builtin_amdgcn_sched_barrier(0);
                int o21 = abase_i + 1428; asm volatile("" : "+v"(o21) : "v"(Tr[18]));
                const f32x4 r21_0 = *(const LAS f32x4*)(Aab + o21 + 0); const f32x4 r21_1 = *(const LAS f32x4*)(Aab + o21 + 4); const f32x4 r21_2 = *(const LAS f32x4*)(Aab + o21 + 8); const f32x4 r21_3 = *(const LAS f32x4*)(Aab + o21 + 12); const f32x4 r21_4 = *(const LAS f32x4*)(Aab + o21 + 16); const f32x4 r21_5 = *(const LAS f32x4*)(Aab + o21 + 20);
                __builtin_amdgcn_sched_barrier(0);
                { const f32x2_t pa = (f32x2_t){r19_0[0], r19_0[1]} * TP[0] + (f32x2_t){r19_1[0], r19_1[1]} * TP[2] + (f32x2_t){r19_2[0], r19_2[1]} * TP[4] + (f32x2_t){r19_3[0], r19_3[1]} * TP[6] + (f32x2_t){r19_4[0], r19_4[1]} * TP[8]; const f32x2_t pb = (f32x2_t){r19_0[2], r19_0[3]} * TP[1] + (f32x2_t){r19_1[2], r19_1[3]} * TP[3] + (f32x2_t){r19_2[2], r19_2[3]} * TP[5] + (f32x2_t){r19_3[2], r19_3[3]} * TP[7] + (f32x2_t){r19_4[2], r19_4[3]} * TP[9]; const f32x2_t ps = pa + pb;
                  Tr[19] = (ps[0] + ps[1]) + (1.0f - fminf(fabsf(cf - 19.0f), 1.0f)); TP[9][1] = Tr[19]; }
                __builtin_amdgcn_sched_barrier(0);
                int o22 = abase_i + 1496; asm volatile("" : "+v"(o22) : "v"(Tr[19]));
                const f32x4 r22_0 = *(const LAS f32x4*)(Aab + o22 + 0); const f32x4 r22_1 = *(const LAS f32x4*)(Aab + o22 + 4); const f32x4 r22_2 = *(const LAS f32x4*)(Aab + o22 + 8); const f32x4 r22_3 = *(const LAS f32x4*)(Aab + o22 + 12); const f32x4 r22_4 = *(const LAS f32x4*)(Aab + o22 + 16); const f32x4 r22_5 = *(const LAS f32x4*)(Aab + o22 + 20);
                __builtin_amdgcn_sched_barrier(0);
                { const f32x2_t pa = (f32x2_t){r20_0[0], r20_0[1]} * TP[0] + (f32x2_t){r20_1[0], r20_1[1]} * TP[2] + (f32x2_t){r20_2[0], r20_2[1]} * TP[4] + (f32x2_t){r20_3[0], r20_3[1]} * TP[6] + (f32x2_t){r20_4[0], r20_4[1]} * TP[8]; const f32x2_t pb = (f32x2_t){r20_0[2], r20_0[3]} * TP[1] + (f32x2_t){r20_1[2], r20_1[3]} * TP[3] + (f32x2_t){r20_2[2], r20_2[3]} * TP[5] + (f32x2_t){r20_3[2], r20_3[3]} * TP[7] + (f32x2_t){r20_4[2], r20_4[3]} * TP[9]; const f32x2_t ps = pa + pb;
                  Tr[20] = (ps[0] + ps[1]) + (1.0f - fminf(fabsf(cf - 20.0f), 1.0f)); TP[10][0] = Tr[20]; }
                __builtin_amdgcn_sched_barrier(0);
                int o23 = abase_i + 1564; asm volatile("" : "+v"(o23) : "v"(Tr[20]));
                const f32x4 r23_0 = *(const LAS f32x4*)(Aab + o23 + 0); const f32x4 r23_1 = *(const LAS f32x4*)(Aab + o23 + 4); const f32x4 r23_2 = *(const LAS f32x4*)(Aab + o23 + 8); const f32x4 r23_3 = *(const LAS f32x4*)(Aab + o23 + 12); const f32x4 r23_4 = *(const LAS f32x4*)(Aab + o23 + 16); const f32x4 r23_5 = *(const LAS f32x4*)(Aab + o23 + 20);
                __builtin_amdgcn_sched_barrier(0);
                { const f32x2_t pa = (f32x2_t){r21_0[0], r21_0[1]} * TP[0] + (f32x2_t){r21_1[0], r21_1[1]} * TP[2] + (f32x2_t){r21_2[0], r21_2[1]} * TP[4] + (f32x2_t){r21_3[0], r21_3[1]} * TP[6] + (f32x2_t){r21_4[0], r21_4[1]} * TP[8] + (f32x2_t){r21_5[0], r21_5[1]} * TP[10]; const f32x2_t pb = (f32x2_t){r21_0[2], r21_0[3]} * TP[1] + (f32x2_t){r21_1[2], r21_1[3]} * TP[3] + (f32x2_t){r21_2[2], r21_2[3]} * TP[5] + (f32x2_t){r21_3[2], r21_3[3]} * TP[7] + (f32x2_t){r21_4[2], r21_4[3]} * TP[9]; const f32x2_t ps = pa + pb;
                  Tr[21] = (ps[0] + ps[1]) + (1.0f - fminf(fabsf(cf - 21.0f), 1.0f)); TP[10][1] = Tr[21]; }
                __builtin_amdgcn_sched_barrier(0);
                int o24 = abase_i + 1632; asm volatile("" : "+v"(o24) : "v"(Tr[21]));
                const f32x4 r24_0 = *(const LAS f32x4*)(Aab + o24 + 0); const f32x4 r24_1 = *(const LAS f32x4*)(Aab + o24 + 4); const f32x4 r24_2 = *(const LAS f32x4*)(Aab + o24 + 8); const f32x4 r24_3 = *(const LAS f32x4*)(Aab + o24 + 12); const f32x4 r24_4 = *(const LAS f32x4*)(Aab + o24 + 16); const f32x4 r24_5 = *(const LAS f32x4*)(Aab + o24 + 20);
                __builtin_amdgcn_sched_barrier(0);
                { const f32x2_t pa = (f32x2_t){r22_0[0], r22_0[1]} * TP[0] + (f32x2_t){r22_1[0], r22_1[1]} * TP[2] + (f32x2_t){r22_2[0], r22_2[1]} * TP[4] + (f32x2_t){r22_3[0], r22_3[1]} * TP[6] + (f32x2_t){r22_4[0], r22_4[1]} * TP[8] + (f32x2_t){r22_5[0], r22_5[1]} * TP[10]; const f32x2_t pb = (f32x2_t){r22_0[2], r22_0[3]} * TP[1] + (f32x2_t){r22_1[2], r22_1[3]} * TP[3] + (f32x2_t){r22_2[2], r22_2[3]} * TP[5] + (f32x2_t){r22_3[2], r22_3[3]} * TP[7] + (f32x2_t){r22_4[2], r22_4[3]} * TP[9]; const f32x2_t ps = pa + pb;
                  Tr[22] = (ps[0] + ps[1]) + (1.0f - fminf(fabsf(cf - 22.0f), 1.0f)); TP[11][0] = Tr[22]; }
                __builtin_amdgcn_sched_barrier(0);
                int o25 = abase_i + 1700; asm volatile("" : "+v"(o25) : "v"(Tr[22]));
                const f32x4 r25_0 = *(const LAS f32x4*)(Aab + o25 + 0); const f32x4 r25_1 = *(const LAS f32x4*)(Aab + o25 + 4); const f32x4 r25_2 = *(const LAS f32x4*)(Aab + o25 + 8); const f32x4 r25_3 = *(const LAS f32x4*)(Aab + o25 + 12); const f32x4 r25_4 = *(const LAS f32x4*)(Aab + o25 + 16); const f32x4 r25_5 = *(const LAS f32x4*)(Aab + o25 + 20); const f32x4 r25_6 = *(const LAS f32x4*)(Aab + o25 + 24);
                __builtin_amdgcn_sched_barrier(0);
                { const f32x2_t pa = (f32x2_t){r23_0[0], r23_0[1]} * TP[0] + (f32x2_t){r23_1[0], r23_1[1]} * TP[2] + (f32x2_t){r23_2[0], r23_2[1]} * TP[4] + (f32x2_t){r23_3[0], r23_3[1]} * TP[6] + (f32x2_t){r23_4[0], r23_4[1]} * TP[8] + (f32x2_t){r23_5[0], r23_5[1]} * TP[10]; const f32x2_t pb = (f32x2_t){r23_0[2], r23_0[3]} * TP[1] + (f32x2_t){r23_1[2], r23_1[3]} * TP[3] + (f32x2_t){r23_2[2], r23_2[3]} * TP[5] + (f32x2_t){r23_3[2], r23_3[3]} * TP[7] + (f32x2_t){r23_4[2], r23_4[3]} * TP[9] + (f32x2_t){r23_5[2], r23_5[3]} * TP[11]; const f32x2_t ps = pa + pb;
                  Tr[23] = (ps[0] + ps[1]) + (1.0f - fminf(fabsf(cf - 23.0f), 1.0f)); TP[11][1] = Tr[23]; }
                __builtin_amdgcn_sched_barrier(0);
                int o26 = abase_i + 1768; asm volatile("" : "+v"(o26) : "v"(Tr[23]));
                const f32x4 r26_0 = *(const LAS f32x4*)(Aab + o26 + 0); const f32x4 r26_1 = *(const LAS f32x4*)(Aab + o26 + 4); const f32x4 r26_2 = *(const LAS f32x4*)(Aab + o26 + 8); const f32x4 r26_3 = *(const LAS f32x4*)(Aab + o26 + 12); const f32x4 r26_4 = *(const LAS f32x4*)(Aab + o26 + 16); const f32x4 r26_5 = *(const LAS f32x4*)(Aab + o26 + 20); const f32x4 r26_6 = *(const LAS f32x4*)(Aab + o26 + 24);
                __builtin_amdgcn_sched_barrier(0);
                { const f32x2_t pa = (f32x2_t){r24_0[0], r24_0[1]} * TP[0] + (f32x2_t){r24_1[0], r24_1[1]} * TP[2] + (f32x2_t){r24_2[0], r24_2[1]} * TP[4] + (f32x2_t){r24_3[0], r24_3[1]} * TP[6] + (f32x2_t){r24_4[0], r24_4[1]} * TP[8] + (f32x2_t){r24_5[0], r24_5[1]} * TP[10]; const f32x2_t pb = (f32x2_t){r24_0[2], r24_0[3]} * TP[1] + (f32x2_t){r24_1[2], r24_1[3]} * TP[3] + (f32x2_t){r24_2[2], r24_2[3]} * TP[5] + (f32x2_t){r24_3[2], r24_3[3]} * TP[7] + (f32x2_t){r24_4[2], r24_4[3]} * TP[9] + (f32x2_t){r24_5[2], r24_5[3]} * TP[11]; const f32x2_t ps = pa + pb;
                  Tr[24] = (ps[0] + ps[1]) + (1.0f - fminf(fabsf(cf - 24.0f), 1.0f)); TP[12][0] = Tr[24]; }
                __builtin_amdgcn_sched_barrier(0);
                int o27 = abase_i + 1836; asm volatile("" : "+v"(o27) : "v"(Tr[24]));
                const f32x4 r27_0 = *(const LAS f32x4*)(Aab + o27 + 0); const f32x4 r27_1 = *(const LAS f32x4*)(Aab + o27 + 4); const f32x4 r27_2 = *(const LAS f32x4*)(Aab + o27 + 8); const f32x4 r27_3 = *(const LAS f32x4*)(Aab + o27 + 12); const f32x4 r27_4 = *(const LAS f32x4*)(Aab + o27 + 16); const f32x4 r27_5 = *(const LAS f32x4*)(Aab + o27 + 20); const f32x4 r27_6 = *(const LAS f32x4*)(Aab + o27 + 24);
                __builtin_amdgcn_sched_barrier(0);
                { const f32x2_t pa = (f32x2_t){r25_0[0], r25_0[1]} * TP[0] + (f32x2_t){r25_1[0], r25_1[1]} * TP[2] + (f32x2_t){r25_2[0], r25_2[1]} * TP[4] + (f32x2_t){r25_3[0], r25_3[1]} * TP[6] + (f32x2_t){r25_4[0], r25_4[1]} * TP[8] + (f32x2_t){r25_5[0], r25_5[1]} * TP[10] + (f32x2_t){r25_6[0], r25_6[1]} * TP[12]; const f32x2_t pb = (f32x2_t){r25_0[2], r25_0[3]} * TP[1] + (f32x2_t){r25_1[2], r25_1[3]} * TP[3] + (f32x2_t){r25_2[2], r25_2[3]} * TP[5] + (f32x2_t){r25_3[2], r25_3[3]} * TP[7] + (f32x2_t){r25_4[2], r25_4[3]} * TP[9] + (f32x2_t){r25_5[2], r25_5[3]} * TP[11]; const f32x2_t ps = pa + pb;
                  Tr[25] = (ps[0] + ps[1]) + (1.0f - fminf(fabsf(cf - 25.0f), 1.0f)); TP[12][1] = Tr[25]; }
                __builtin_amdgcn_sched_barrier(0);
                int o28 = abase_i + 1904; asm volatile("" : "+v"(o28) : "v"(Tr[25]));
                const f32x4 r28_0 = *(const LAS f32x4*)(Aab + o28 + 0); const f32x4 r28_1 = *(const LAS f32x4*)(Aab + o28 + 4); const f32x4 r28_2 = *(const LAS f32x4*)(Aab + o28 + 8); const f32x4 r28_3 = *(const LAS f32x4*)(Aab + o28 + 12); const f32x4 r28_4 = *(const LAS f32x4*)(Aab + o28 + 16); const f32x4 r28_5 = *(const LAS f32x4*)(Aab + o28 + 20); const f32x4 r28_6 = *(const LAS f32x4*)(Aab + o28 + 24);
                __builtin_amdgcn_sched_barrier(0);
                { const f32x2_t pa = (f32x2_t){r26_0[0], r26_0[1]} * TP[0] + (f32x2_t){r26_1[0], r26_1[1]} * TP[2] + (f32x2_t){r26_2[0], r26_2[1]} * TP[4] + (f32x2_t){r26_3[0], r26_3[1]} * TP[6] + (f32x2_t){r26_4[0], r26_4[1]} * TP[8] + (f32x2_t){r26_5[0], r26_5[1]} * TP[10] + (f32x2_t){r26_6[0], r26_6[1]} * TP[12]; const f32x2_t pb = (f32x2_t){r26_0[2], r26_0[3]} * TP[1] + (f32x2_t){r26_1[2], r26_1[3]} * TP[3] + (f32x2_t){r26_2[2], r26_2[3]} * TP[5] + (f32x2_t){r26_3[2], r26_3[3]} * TP[7] + (f32x2_t){r26_4[2], r26_4[3]} * TP[9] + (f32x2_t){r26_5[2], r26_5[3]} * TP[11]; const f32x2_t ps = pa + pb;
                  Tr[26] = (ps[0] + ps[1]) + (1.0f - fminf(fabsf(cf - 26.0f), 1.0f)); TP[13][0] = Tr[26]; }
                __builtin_amdgcn_sched_barrier(0);
                int o29 = abase_i + 1972; asm volatile("" : "+v"(o29) : "v"(Tr[26]));
                const f32x4 r29_0 = *(const LAS f32x4*)(Aab + o29 + 0); const f32x4 r29_1 = *(const LAS f32x4*)(Aab + o29 + 4); const f32x4 r29_2 = *(const LAS f32x4*)(Aab + o29 + 8); const f32x4 r29_3 = *(const LAS f32x4*)(Aab + o29 + 12); const f32x4 r29_4 = *(const LAS f32x4*)(Aab + o29 + 16); const f32x4 r29_5 = *(const LAS f32x4*)(Aab + o29 + 20); const f32x4 r29_6 = *(const LAS f32x4*)(Aab + o29 + 24); const f32x4 r29_7 = *(const LAS f32x4*)(Aab + o29 + 28);
                __builtin_amdgcn_sched_barrier(0);
                { const f32x2_t pa = (f32x2_t){r27_0[0], r27_0[1]} * TP[0] + (f32x2_t){r27_1[0], r27_1[1]} * TP[2] + (f32x2_t){r27_2[0], r27_2[1]} * TP[4] + (f32x2_t){r27_3[0], r27_3[1]} * TP[6] + (f32x2_t){r27_4[0], r27_4[1]} * TP[8] + (f32x2_t){r27_5[0], r27_5[1]} * TP[10] + (f32x2_t){r27_6[0], r27_6[1]} * TP[12]; const f32x2_t pb = (f32x2_t){r27_0[2], r27_0[3]} * TP[1] + (f32x2_t){r27_1[2], r27_1[3]} * TP[3] + (f32x2_t){r27_2[2], r27_2[3]} * TP[5] + (f32x2_t){r27_3[2], r27_3[3]} * TP[7] + (f32x2_t){r27_4[2], r27_4[3]} * TP[9] + (f32x2_t){r27_5[2], r27_5[3]} * TP[11] + (f32x2_t){r27_6[2], r27_6[3]} * TP[13]; const f32x2_t ps = pa + pb;
                  Tr[27] = (ps[0] + ps[1]) + (1.0f - fminf(fabsf(cf - 27.0f), 1.0f)); TP[13][1] = Tr[27]; }
                __builtin_amdgcn_sched_barrier(0);
                int o30 = abase_i + 2040; asm volatile("" : "+v"(o30) : "v"(Tr[27]));
                const f32x4 r30_0 = *(const LAS f32x4*)(Aab + o30 + 0); const f32x4 r30_1 = *(const LAS f32x4*)(Aab + o30 + 4); const f32x4 r30_2 = *(const LAS f32x4*)(Aab + o30 + 8); const f32x4 r30_3 = *(const LAS f32x4*)(Aab + o30 + 12); const f32x4 r30_4 = *(const LAS f32x4*)(Aab + o30 + 16); const f32x4 r30_5 = *(const LAS f32x4*)(Aab + o30 + 20); const f32x4 r30_6 = *(const LAS f32x4*)(Aab + o30 + 24); const f32x4 r30_7 = *(const LAS f32x4*)(Aab + o30 + 28);
                __builtin_amdgcn_sched_barrier(0);
                { const f32x2_t pa = (f32x2_t){r28_0[0], r28_0[1]} * TP[0] + (f32x2_t){r28_1[0], r28_1[1]} * TP[2] + (f32x2_t){r28_2[0], r28_2[1]} * TP[4] + (f32x2_t){r28_3[0], r28_3[1]} * TP[6] + (f32x2_t){r28_4[0], r28_4[1]} * TP[8] + (f32x2_t){r28_5[0], r28_5[1]} * TP[10] + (f32x2_t){r28_6[0], r28_6[1]} * TP[12]; const f32x2_t pb = (f32x2_t){r28_0[2], r28_0[3]} * TP[1] + (f32x2_t){r28_1[2], r28_1[3]} * TP[3] + (f32x2_t){r28_2[2], r28_2[3]} * TP[5] + (f32x2_t){r28_3[2], r28_3[3]} * TP[7] + (f32x2_t){r28_4[2], r28_4[3]} * TP[9] + (f32x2_t){r28_5[2], r28_5[3]} * TP[11] + (f32x2_t){r28_6[2], r28_6[3]} * TP[13]; const f32x2_t ps = pa + pb;
                  Tr[28] = (ps[0] + ps[1]) + (1.0f - fminf(fabsf(cf - 28.0f), 1.0f)); TP[14][0] = Tr[28]; }
                __builtin_amdgcn_sched_barrier(0);
                int o31 = abase_i + 2108; asm volatile("" : "+v"(o31) : "v"(Tr[28]));
                const f32x4 r31_0 = *(const LAS f32x4*)(Aab + o31 + 0); const f32x4 r31_1 = *(const LAS f32x4*)(Aab + o31 + 4); const f32x4 r31_2 = *(const LAS f32x4*)(Aab + o31 + 8); const f32x4 r31_3 = *(const LAS f32x4*)(Aab + o31 + 12); const f32x4 r31_4 = *(const LAS f32x4*)(Aab + o31 + 16); const f32x4 r31_5 = *(const LAS f32x4*)(Aab + o31 + 20); const f32x4 r31_6 = *(const LAS f32x4*)(Aab + o31 + 24); const f32x4 r31_7 = *(const LAS f32x4*)(Aab + o31 + 28);
                __builtin_amdgcn_sched_barrier(0);
                { const f32x2_t pa = (f32x2_t){r29_0[0], r29_0[1]} * TP[0] + (f32x2_t){r29_1[0], r29_1[1]} * TP[2] + (f32x2_t){r29_2[0], r29_2[1]} * TP[4] + (f32x2_t){r29_3[0], r29_3[1]} * TP[6] + (f32x2_t){r29_4[0], r29_4[1]} * TP[8] + (f32x2_t){r29_5[0], r29_5[1]} * TP[10] + (f32x2_t){r29_6[0], r29_6[1]} * TP[12] + (f32x2_t){r29_7[0], r29_7[1]} * TP[14]; const f32x2_t pb = (f32x2_t){r29_0[2], r29_0[3]} * TP[1] + (f32x2_t){r29_1[2], r29_1[3]} * TP[3] + (f32x2_t){r29_2[2], r29_2[3]} * TP[5] + (f32x2_t){r29_3[2], r29_3[3]} * TP[7] + (f32x2_t){r29_4[2], r29_4[3]} * TP[9] + (f32x2_t){r29_5[2], r29_5[3]} * TP[11] + (f32x2_t){r29_6[2], r29_6[3]} * TP[13]; const f32x2_t ps = pa + pb;
                  Tr[29] = (ps[0] + ps[1]) + (1.0f - fminf(fabsf(cf - 29.0f), 1.0f)); TP[14][1] = Tr[29]; }
                __builtin_amdgcn_sched_barrier(0);
                __builtin_amdgcn_sched_barrier(0);
                { const f32x2_t pa = (f32x2_t){r30_0[0], r30_0[1]} * TP[0] + (f32x2_t){r30_1[0], r30_1[1]} * TP[2] + (f32x2_t){r30_2[0], r30_2[1]} * TP[4] + (f32x2_t){r30_3[0], r30_3[1]} * TP[6] + (f32x2_t){r30_4[0], r30_4[1]} * TP[8] + (f32x2_t){r30_5[0], r30_5[1]} * TP[10] + (f32x2_t){r30_6[0], r30_6[1]} * TP[12] + (f32x2_t){r30_7[0], r30_7[1]} * TP[14]; const f32x2_t pb = (f32x2_t){r30_0[2], r30_0[3]} * TP[1] + (f32x2_t){r30_1[2], r30_1[3]} * TP[3] + (f32x2_t){r30_2[2], r30_2[3]} * TP[5] + (f32x2_t){r30_3[2], r30_3[3]} * TP[7] + (f32x2_t){r30_4[2], r30_4[3]} * TP[9] + (f32x2_t){r30_5[2], r30_5[3]} * TP[11] + (f32x2_t){r30_6[2], r30_6[3]} * TP[13]; const f32x2_t ps = pa + pb;
                  Tr[30] = (ps[0] + ps[1]) + (1.0f - fminf(fabsf(cf - 30.0f), 1.0f)); TP[15][0] = Tr[30]; }
                __builtin_amdgcn_sched_barrier(0);
                __builtin_amdgcn_sched_barrier(0);
                { const f32x2_t pa = (f32x2_t){r31_0[0], r31_0[1]} * TP[0] + (f32x2_t){r31_1[0], r31_1[1]} * TP[2] + (f32x2_t){r31_2[0], r31_2[1]} * TP[4] + (f32x2_t){r31_3[0], r31_3[1]} * TP[6] + (f32x2_t){r31_4[0], r31_4[1]} * TP[8] + (f32x2_t){r31_5[0], r31_5[1]} * TP[10] + (f32x2_t){r31_6[0], r31_6[1]} * TP[12] + (f32x2_t){r31_7[0], r31_7[1]} * TP[14]; const f32x2_t pb = (f32x2_t){r31_0[2], r31_0[3]} * TP[1] + (f32x2_t){r31_1[2], r31_1[3]} * TP[3] + (f32x2_t){r31_2[2], r31_2[3]} * TP[5] + (f32x2_t){r31_3[2], r31_3[3]} * TP[7] + (f32x2_t){r31_4[2], r31_4[3]} * TP[9] + (f32x2_t){r31_5[2], r31_5[3]} * TP[11] + (f32x2_t){r31_6[2], r31_6[3]} * TP[13] + (f32x2_t){r31_7[2], r31_7[3]} * TP[15]; const f32x2_t ps = pa + pb;
                  Tr[31] = (ps[0] + ps[1]) + (1.0f - fminf(fabsf(cf - 31.0f), 1.0f)); TP[15][1] = Tr[31]; }
                __builtin_amdgcn_sched_barrier(0);
            }
#pragma unroll
            for (int t = 0; t < 32; ++t) {
                Tm[(32 * hb + t) * LDP + 32 * hb + c] = (bf16_t)f2bf(Tr[t]);
            }
            if (hb == 0) {
#pragma unroll
                for (int q = 0; q < 4; ++q) { u32x4 w; w.x = pk2(Tr[8 * q], Tr[8 * q + 1]); w.y = pk2(Tr[8 * q + 2], Tr[8 * q + 3]); w.z = pk2(Tr[8 * q + 4], Tr[8 * q + 5]); w.w = pk2(Tr[8 * q + 6], Tr[8 * q + 7]);
                    *(LAS u32x4*)(TT + c * LDQ + 8 * q) = w; }
            }
            LDS_WAIT();
            f32x4 W[2][2];
#pragma unroll
            for (int mi = 0; mi < 2; ++mi)
#pragma unroll
                for (int ni = 0; ni < 2; ++ni) {
                    W[mi][ni] = (f32x4){0.f, 0.f, 0.f, 0.f};
                    MMA16(*(const LAS bf16x8*)(AbBA + (16 * mi + fr) * LDQ + fq * 8), *(const LAS bf16x8*)(TT + (16 * ni + fr) * LDQ + fq * 8), W[mi][ni]);
                    st4lds(WsT + (16 * ni + fr) * LDQ + 16 * mi + 4 * fq, W[mi][ni]);
                }
            LDS_WAIT();
#pragma unroll
            for (int mi = 0; mi < 2; ++mi)
#pragma unroll
                for (int ni = 0; ni < 2; ++ni) {
                    f32x4 r4 = (f32x4){0.f, 0.f, 0.f, 0.f};
                    MMA16(*(const LAS bf16x8*)(WsT + (16 * mi + fr) * LDQ + fq * 8), *(const LAS bf16x8*)(Tm + (32 + 16 * ni + fr) * LDP + 32 + fq * 8), r4);
                    st4lds(Tm + (32 + 16 * ni + fr) * LDP + 16 * mi + 4 * fq, r4);
                }
        }
        SBAR();
        {
            const int i0 = 16 * nio + fr;
            const bf16x8 s0 = ldfrag(Sb, i0, 0, fq), s1 = ldfrag(Sb, i0, 1, fq), v0 = ldfragT(VT, i0, 0, fq), v1 = ldfragT(VT, i0, 1, fq);
            bf16x8 fa[2][2], fk[2][2], fh[2][2]; f32x4 eg[2];
#pragma unroll
            for (int mm = 0; mm < 2; ++mm) {
                const int m0 = 16 * (mo0 + mm) + fr;
                fa[mm][0] = ldfrag(At, m0, 0, fq); fa[mm][1] = ldfrag(At, m0, 1, fq);
                fk[mm][0] = ldfrag(Aak, m0, 0, fq); fk[mm][1] = ldfrag(Aak, m0, 1, fq);
                fh[mm][0] = ldfragT(KhT, m0, 0, fq); fh[mm][1] = ldfragT(KhT, m0, 1, fq);
                eg[mm] = *(const LAS f32x4*)(EGL + 16 * (mo0 + mm) + 4 * fq);
            }
            __builtin_amdgcn_sched_barrier(0);
            f32x4 Pacc[2];
#pragma unroll
            for (int mm = 0; mm < 2; ++mm) {
                Pacc[mm] = (f32x4){0.f, 0.f, 0.f, 0.f};
                MMA16(fa[mm][0], s0, Pacc[mm]); MMA16(fa[mm][1], s1, Pacc[mm]);
                MMA16(fk[mm][0], v0, Pacc[mm]); MMA16(fk[mm][1], v1, Pacc[mm]);
                Sacc[mm] = Sacc[mm] * eg[mm];
                MMA16(fh[mm][0], v0, Sacc[mm]); MMA16(fh[mm][1], v1, Sacc[mm]);
            }
            __builtin_amdgcn_sched_barrier(0);
#pragma unroll
            for (int mm = 0; mm < 2; ++mm) st4lds(PT + i0 * LDP + 16 * (mo0 + mm) + 4 * fq, Pacc[mm]);
        }
        SBAR();
        { const int nc_ = chunk + 1 < nch ? chunk + 1 : chunk; SCAN_ISSUE(nc_); }
        {
            const int i0 = 16 * nio + fr;
            const bf16x8 p0 = ldfrag(PT, i0, 0, fq), p1 = ldfrag(PT, i0, 1, fq);
            bf16x8 ft[2][2];
#pragma unroll
            for (int mm = 0; mm < 2; ++mm) { ft[mm][0] = ldfrag(Tm, 16 * (mo0 + mm) + fr, 0, fq); ft[mm][1] = ldfrag(Tm, 16 * (mo0 + mm) + fr, 1, fq); }
            __builtin_amdgcn_sched_barrier(0);
            f32x4 Uacc[2];
#pragma unroll
            for (int mm = 0; mm < 2; ++mm) {
                Uacc[mm] = (f32x4){0.f, 0.f, 0.f, 0.f};
                MMA16(ft[mm][0], p0, Uacc[mm]); MMA16(ft[mm][1], p1, Uacc[mm]);
            }
            __builtin_amdgcn_sched_barrier(0);
#pragma unroll
            for (int mm = 0; mm < 2; ++mm) st4lds(UT + i0 * LDP + 16 * (mo0 + mm) + 4 * fq, Uacc[mm]);
        }
        SBAR();
        {
            const int i0 = 16 * nio + fr;
            const bf16x8 u0 = ldfrag(UT, i0, 0, fq), u1 = ldfrag(UT, i0, 1, fq);
            const int tl = 16 * nio + fr;
            const bf16x8 rt0 = ldfrag(Rt, tl, 0, fq), rt1 = ldfrag(Rt, tl, 1, fq), ak0 = ldfrag(Ark, tl, 0, fq), ak1 = ldfrag(Ark, tl, 1, fq), ab0 = ldfrag(Arb, tl, 0, fq), ab1 = ldfrag(Arb, tl, 1, fq);
            bf16x8 fb[2][2], fs[2][2], fv[2][2], fu[2][2];
#pragma unroll
            for (int mm = 0; mm < 2; ++mm) {
                const int m0 = 16 * (mo0 + mm) + fr;
                fb[mm][0] = ldfragT(BhT, m0, 0, fq); fb[mm][1] = ldfragT(BhT, m0, 1, fq);
                fs[mm][0] = ldfrag(Sb, m0, 0, fq); fs[mm][1] = ldfrag(Sb, m0, 1, fq);
                fv[mm][0] = ldfragT(VT, m0, 0, fq); fv[mm][1] = ldfragT(VT, m0, 1, fq);
                fu[mm][0] = ldfrag(UT, m0, 0, fq); fu[mm][1] = ldfrag(UT, m0, 1, fq);
            }
            __builtin_amdgcn_sched_barrier(0);
            f32x4 Yacc[2];
#pragma unroll
            for (int mm = 0; mm < 2; ++mm) {
                MMA16(fb[mm][0], u0, Sacc[mm]); MMA16(fb[mm][1], u1, Sacc[mm]);
                Yacc[mm] = (f32x4){0.f, 0.f, 0.f, 0.f};
                MMA16(fs[mm][0], rt0, Yacc[mm]); MMA16(fs[mm][1], rt1, Yacc[mm]);
                MMA16(fv[mm][0], ak0, Yacc[mm]); MMA16(fv[mm][1], ak1, Yacc[mm]);
                MMA16(fu[mm][0], ab0, Yacc[mm]); MMA16(fu[mm][1], ab1, Yacc[mm]);
            }
            __builtin_amdgcn_sched_barrier(0);
            SBAR();
            const int ypos = chunk * 64 + tl, yt = dir ? T - 1 - ypos : ypos;
            const size_t yoff = (size_t)(row_base + yt) * DM + h * 64;
#pragma unroll
            for (int mm = 0; mm < 2; ++mm) {
                st4lds(Sb + i0 * LDP + 16 * (mo0 + mm) + 4 * fq, Sacc[mm]);
                const int ic = 16 * (mo0 + mm) + 4 * fq;
                if (mode == 2) {
                    const int tloc = dir ? yt : yt - 2048;
                    st4bf((bf16_t*)(a.ws + WS_ZB) + ((size_t)((b * 16 + h) * 2 + dir) * 2048 + tloc) * 64 + ic, Yacc[mm]);
                } else if (ysc != 0.f) {
                    st4bf((dir == 0 ? (bf16_t*)a.out + YF_OFF : (bf16_t*)(a.ws + WS_H)) + yoff + ic, Yacc[mm]);
                }
            }
        }
    }
    if (!lat) {
        const int i = 16 * nio + fr;
#pragma unroll
        for (int mm = 0; mm < 2; ++mm)
            *(f32x4*)(a.out + (size_t)NTOK * DM + ((((size_t)b * 2 + dir) * 16 + h) * 64 + i) * 64 + 16 * (mo0 + mm) + 4 * fq) = Sacc[mm];
    } else if (mode == 0 && cend < T / 64) {
        const int i = 16 * nio + fr;
#pragma unroll
        for (int mm = 0; mm < 2; ++mm)
            st4bf((bf16_t*)(a.ws + WS_SAB) + ((size_t)((b * 16 + h) * 2 + dir) * 64 + i) * 64 + 16 * (mo0 + mm) + 4 * fq, Sacc[mm]);
    }
    __syncthreads();
}
__device__ __forceinline__ void phase_scan(const Args& a, LAS unsigned char* lds) {
    const int nb = gridDim.x, bx = blockIdx.x;
    for (int it = 0;; ++it) {
        int lat, c, cbeg = 0, cend, mode = 0;
        if (nb >= 256) {
            if (bx < 192) { if (it) break; lat = 1; c = bx & 63; const int role = bx >> 6; cbeg = role ? 32 : 0; cend = role ? 64 : 32; mode = role; }
            else { c = (bx - 192) + it * (nb - 192); if (c >= 512) break; lat = 0; cend = 4; }
        } else if (nb >= 128) {
            if (bx < 64) { if (it) break; lat = 1; c = bx; cend = 64; }
            else { c = (bx - 64) + it * (nb - 64); if (c >= 512) break; lat = 0; cend = 4; }
        } else {
            const int task = bx + it * nb; if (task >= 64 + 512) break;
            lat = task < 64; c = lat ? task : task - 64; cend = lat ? 64 : 4;
        }
        scan_chain(a, lds, lat, c >> 5, (c >> 1) & 15, c & 1, 1.0f, cbeg, cend, mode);
    }
}
__device__ __forceinline__ void phase_fixup(const Args& a) {
    const int tid = threadIdx.x, lane = tid & 63, wv = tid >> 6, gw = blockIdx.x * 8 + wv, ngw = gridDim.x * 8, fr = lane & 15, fq = lane >> 4;
    const bf16_t* SAB = (const bf16_t*)(a.ws + WS_SAB); const bf16_t* ZB = (const bf16_t*)(a.ws + WS_ZB);
    for (int wt = gw; wt < 64 * 32; wt += ngw) {
        const int chain = wt >> 5, blk = wt & 31, dir = chain & 1, h = (chain >> 1) & 15, b = chain >> 5;
        const bf16_t* ap[4]; const bf16_t* bp[4]; f32x4 acc[4][4];
#pragma unroll
        for (int mi = 0; mi < 4; ++mi)
#pragma unroll
            for (int ni = 0; ni < 4; ++ni) acc[mi][ni] = (f32x4){0.f, 0.f, 0.f, 0.f};
#pragma unroll
        for (int mi = 0; mi < 4; ++mi) ap[mi] = SAB + ((size_t)chain * 64 + 16 * mi + fr) * 64;
#pragma unroll
        for (int ni = 0; ni < 4; ++ni) bp[ni] = ZB + ((size_t)chain * 2048 + blk * 64 + 16 * ni + fr) * 64;
        wave_mma<4, 4, 2>(ap, bp, acc, fq);
#pragma unroll
        for (int ni = 0; ni < 4; ++ni) {
            const int tloc = blk * 64 + 16 * ni + fr, t = dir ? tloc : 2048 + tloc;
            const size_t yoff = (size_t)(NTOK_C + b * 4096 + t) * DM + h * 64;
#pragma unroll
            for (int mi = 0; mi < 4; ++mi) {
                const int ic = 16 * mi + 4 * fq;
                bf16_t* p = (dir == 0 ? (bf16_t*)a.out + YF_OFF : (bf16_t*)(a.ws + WS_H)) + yoff + ic; const u32x2 w = *(const u32x2*)p;
                f32x4 o; o[0] = bflo(w.x) + acc[mi][ni][0]; o[1] = bfhi(w.x) + acc[mi][ni][1]; o[2] = bflo(w.y) + acc[mi][ni][2]; o[3] = bfhi(w.y) + acc[mi][ni][3];
                st4bf(p, o);
            }
        }
    }
}

__device__ __forceinline__ void phase_gn(const Args& a) {
    const int tid = threadIdx.x;
    bf16_t* U = (bf16_t*)(a.ws + WS_U);
    const bf16_t* YB = (const bf16_t*)(a.ws + WS_H);
    const bf16_t* YF = (const bf16_t*)a.out + YF_OFF;
    const bf16_t* BON = (const bf16_t*)a.out + BON_OFF;
    for (int idx = blockIdx.x * 512 + tid; idx < NTOK * 128; idx += gridDim.x * 512) {
        const int row = idx >> 7, c0 = (idx & 127) * 8;
        const u32x4 yfw = *(const u32x4*)(YF + (size_t)row * DM + c0), ybw = *(const u32x4*)(YB + (size_t)row * DM + c0);
        const u32x4 bw = *(const u32x4*)(BON + (size_t)row * DM + c0), gw = *(const u32x4*)(U + (size_t)row * LDU + C_GR + c0);
        const f32x4 lg0 = *(const f32x4*)(a.in[17] + c0), lg1 = *(const f32x4*)(a.in[17] + c0 + 4);
        const f32x4 lb0 = *(const f32x4*)(a.in[18] + c0), lb1 = *(const f32x4*)(a.in[18] + c0 + 4);
        float y[8], sm = 0.f;
#pragma unroll
        for (int e = 0; e < 8; ++e) { y[e] = bfel(yfw, e) + bfel(ybw, e); sm += y[e]; }
        sm += __shfl_xor(sm, 1); sm += __shfl_xor(sm, 2); sm += __shfl_xor(sm, 4);
        const float mean = sm * (1.0f / 64.0f);
        float vs = 0.f;
#pragma unroll
        for (int e = 0; e < 8; ++e) { y[e] -= mean; vs += y[e] * y[e]; }
        vs += __shfl_xor(vs, 1); vs += __shfl_xor(vs, 2); vs += __shfl_xor(vs, 4);
        const float rstd = rsqrtf(vs * (1.0f / 64.0f) + GN_EPS);
        float o[8];
#pragma unroll
        for (int e = 0; e < 8; ++e) { const float yn = y[e] * rstd * (e < 4 ? lg0[e] : lg1[e - 4]) + (e < 4 ? lb0[e] : lb1[e - 4]); o[e] = (yn + bfel(bw, e)) * bfel(gw, e); }
        *(u32x4*)(U + (size_t)row * LDU + C_GR + c0) = pack8(o);
    }
}

__device__ __forceinline__ void phase_final(const Args& a) {
    const int tid = threadIdx.x, lane = tid & 63, wv = tid >> 6, gw = blockIdx.x * 8 + wv, ngw = gridDim.x * 8;
    const float* fg = a.in[22];
    for (int row = gw; row < NTOK; row += ngw) {
        float* xr = a.out + (size_t)row * DM;
        f32x4 v[4]; float ss = 0.f;
#pragma unroll
        for (int j = 0; j < 4; ++j) { v[j] = *(const f32x4*)(xr + lane * 4 + 256 * j); ss += (v[j][0] * v[j][0] + v[j][1] * v[j][1]) + (v[j][2] * v[j][2] + v[j][3] * v[j][3]); }
        const float rstd = rsqrtf(wave_sum(ss) * (1.0f / DM) + RMS_EPS);
#pragma unroll
        for (int j = 0; j < 4; ++j) { const f32x4 g4 = *(const f32x4*)(fg + lane * 4 + 256 * j); *(f32x4*)(xr + lane * 4 + 256 * j) = v[j] * rstd * g4; }
    }
}

#define XB_TMO      128
#define XB_XCNT(j)  (256  + 64 * (j))
#define XB_XSUB(j)  (1280 + 64 * (j))
#define XB_XGEN(j)  (2304 + 64 * (j))
#define XB_TOP      3328
#define XB_TOPGEN   3392
#define XCD_BAR_WORDS 3456
#define XB_SPIN_CAP (1u << 18)
__device__ __forceinline__ unsigned xb_ld(unsigned* p)              { return __hip_atomic_load(p, __ATOMIC_RELAXED, __HIP_MEMORY_SCOPE_AGENT); }
__device__ __forceinline__ unsigned xb_add(unsigned* p, unsigned v) { return __hip_atomic_fetch_add(p, v, __ATOMIC_RELAXED, __HIP_MEMORY_SCOPE_AGENT); }
__device__ __forceinline__ unsigned xb_xcc_id() { return (unsigned)__builtin_amdgcn_s_getreg((3 << 11) | 20) & 0xFu; }
#define XB_SPIN(cond, bar) do { unsigned _sp = 0; while (cond) { __builtin_amdgcn_s_sleep(1); \
    if ((++_sp & 255u) == 0u) { if (xb_ld(&(bar)[XB_TMO])) break; if (_sp > XB_SPIN_CAP) { atomicAdd(&(bar)[XB_TMO], 1u); break; } } } } while (0)
struct XcdBarrier { unsigned* bar; unsigned x; volatile LAS unsigned* st; };
__device__ __forceinline__ XcdBarrier xcd_barrier_post(unsigned* bar, volatile LAS unsigned* st) {
    XcdBarrier b; b.bar = bar; b.x = xb_xcc_id(); b.st = st;
    if (threadIdx.x == 0) (void)xb_add(&bar[XB_XCNT(b.x)], 1u);
    return b;
}
__device__ __forceinline__ void xcd_barrier_complete(unsigned* bar, unsigned x, unsigned& nloc, unsigned& nx) {
    const unsigned G = gridDim.x * gridDim.y * gridDim.z;
    unsigned sum, cnt, mine, sp = 0u;
    for (;;) {
        sum = 0u; cnt = 0u; mine = 0u;
#pragma unroll
        for (unsigned j = 0; j < 16; ++j) { const unsigned c = xb_ld(&bar[XB_XCNT(j)]); sum += c; cnt += (c > 0u) ? 1u : 0u; mine = (j == x) ? c : mine; }
        if (sum == G) break;
        __builtin_amdgcn_s_sleep(1);
        if ((++sp & 255u) == 0u) { if (xb_ld(&bar[XB_TMO])) break; if (sp > XB_SPIN_CAP) { atomicAdd(&bar[XB_TMO], 1u); break; } }
    }
    nloc = mine > 0u ? mine : 1u; nx = cnt > 0u ? cnt : 1u;
}
__device__ __forceinline__ void xcd_barrier(const XcdBarrier& b) {
    asm volatile("s_waitcnt vmcnt(0)" ::: "memory");
    __syncthreads();
    if (threadIdx.x == 0) {
        unsigned* bar = b.bar;
        __builtin_amdgcn_s_waitcnt(0);
        unsigned nloc = b.st[0], nx = b.st[1];
        if (nloc == 0u) { xcd_barrier_complete(bar, b.x, nloc, nx); b.st[0] = nloc; b.st[1] = nx; }
        const unsigned old = xb_add(&bar[XB_XSUB(b.x)], 1u);
        const unsigned gen = old / nloc;
        if (old + 1u == (gen + 1u) * nloc) {
            __builtin_amdgcn_fence(__ATOMIC_RELEASE, "agent");
            asm volatile("s_waitcnt vmcnt(0)" ::: "memory");
            const unsigned og = xb_add(&bar[XB_TOP], 1u);
            const unsigned tg = og / nx;
            if (og + 1u == (tg + 1u) * nx) xb_add(&bar[XB_TOPGEN], 1u);
            else XB_SPIN(xb_ld(&bar[XB_TOPGEN]) == tg, bar);
            __builtin_amdgcn_fence(__ATOMIC_ACQUIRE, "agent");
            xb_add(&bar[XB_XGEN(b.x)], 1u);
            asm volatile("s_waitcnt vmcnt(0)" ::: "memory");
        } else {
            XB_SPIN(xb_ld(&bar[XB_XGEN(b.x)]) == gen, bar);
            __builtin_amdgcn_fence(__ATOMIC_ACQUIRE, "agent");
            asm volatile("s_waitcnt vmcnt(0)" ::: "memory");
        }
    }
    __syncthreads();
}

__global__ void __launch_bounds__(512) mega(Args a) {
    extern __shared__ __attribute__((aligned(16))) unsigned char lds_raw[];
    LAS unsigned char* lds = (LAS unsigned char*)lds_raw;
    unsigned char* ws = a.ws;
    bf16_t* U = (bf16_t*)(ws + WS_U);
    if (threadIdx.x < 4) ((LAS unsigned*)(lds + LDS_XB))[threadIdx.x] = 0u;
    __syncthreads();
    XcdBarrier xbar; xbar.bar = (unsigned*)(ws + WS_BAR); xbar.x = 0; xbar.st = (volatile LAS unsigned*)(lds + LDS_XB);
    if (a.ph_hi - a.ph_lo > 1) xbar = xcd_barrier_post((unsigned*)(ws + WS_BAR), (volatile LAS unsigned*)(lds + LDS_XB));
#define PH_BEGIN(k) if (a.ph_lo <= (k) && (k) < a.ph_hi) { if (a.ph_lo < (k)) { if (a.ph_lo == 0x7fff0000) cg::this_grid().sync(); else xcd_barrier(xbar); }
#define PH_END }
#ifndef REPMASK
#define REPMASK 0
#endif
#define NREP(k) (((REPMASK >> (k)) & 1) ? 2 : 1)
    PH_BEGIN(0) for (int r_ = 0; r_ < NREP(0); ++r_) { __syncthreads(); phase0(a, lds); } PH_END
    PH_BEGIN(1) for (int r_ = 0; r_ < NREP(1); ++r_) { __syncthreads(); phase0_conv(a, lds); __syncthreads(); phase1(a, lds); } PH_END
    PH_BEGIN(2)
        pg8::StaticOrder S; S.init(NTOK, LDU, gridDim.x, blockIdx.x);
        pg8::Gemm g{(const bf16_t*)(ws + WS_H), (const bf16_t*)(ws + WS_WINT), NTOK, LDU, 1024, 1024, 1024};
        Epi1 E{U};
#ifndef REP_PH2
#define REP_PH2 1
#endif
#pragma unroll 1
        for (int rep_ = 0; rep_ < REP_PH2; ++rep_) { if (rep_) __syncthreads(); pg8::gemm_phase(lds, g, S, E); }
        __syncthreads();
        if (gridDim.x == 256) { if (blockIdx.x >= 112) conv_rest(a, lds, blockIdx.x - 112, 144); } else conv_rest(a, lds, blockIdx.x, gridDim.x);
    PH_END
    PH_BEGIN(3) for (int r_ = 0; r_ < NREP(3); ++r_) fourier_l1(a, lds); PH_END
    PH_BEGIN(4) for (int r_ = 0; r_ < NREP(4); ++r_) fourier_l2(a, lds); phase_premix(a); PH_END
    PH_BEGIN(5) for (int r_ = 0; r_ < NREP(5); ++r_) fourier_l3(a, lds); __syncthreads(); PH_END
    if (a.ph_lo <= 6 && 6 < a.ph_hi) { if (a.ph_lo == 6) {} else if (!(a.ph_lo <= 5)) xcd_barrier(xbar);
#ifndef SCAN_REPS
#define SCAN_REPS 1
#endif
        for (int rep = 0; rep < SCAN_REPS; ++rep) {
            if (rep) {
                cg::this_grid().sync();
                { f32x4* yo = (f32x4*)a.out; for (int i = blockIdx.x * 512 + threadIdx.x; i < NTOK * DM / 4; i += gridDim.x * 512) yo[i] = (f32x4){0.f, 0.f, 0.f, 0.f}; }
                cg::this_grid().sync();
            }
            phase_scan(a, lds);
        }
    PH_END
    PH_BEGIN(7) if (gridDim.x >= 256 && a.ph_hi - a.ph_lo > 1) { phase_fixup(a); xcd_barrier(xbar); } phase_gn(a); PH_END
    PH_BEGIN(8)
        pg8::StaticOrder S; S.init(NTOK, 1024, gridDim.x, blockIdx.x);
#pragma unroll 1
        for (int r_ = 0; r_ < NREP(8); ++r_) {
        __syncthreads();
        {
            pg8::Gemm g{U + C_XF, (const bf16_t*)(ws + WS_WPF), NTOK, 1024, 512, LDU, 512};
            Epi2<0> E{U};
            pg8::gemm_phase(lds, g, S, E);
        }
        {
            pg8::Gemm g{U + C_GR, (const bf16_t*)(ws + WS_WPR), NTOK, 1024, 1024, LDU, 1024};
            Epi2<1> E{U};
            pg8::gemm_phase(lds, g, S, E);
        }
        }
    PH_END
    PH_BEGIN(9)
        pg8::StaticOrder S; S.init(NTOK, 1024, gridDim.x, blockIdx.x);
        pg8::Gemm g{U + C_MERGED, (const bf16_t*)(ws + WS_WOUT), NTOK, 1024, 1024, LDU, 1024};
        Epi3 E{a.in[0], a.in[1], (const float*)(ws + WS_MODF), a.out};
#pragma unroll 1
        for (int r_ = 0; r_ < NREP(9); ++r_) { __syncthreads(); pg8::gemm_phase(lds, g, S, E); }
#ifdef SYNC_EXTRA
        for (int r_ = 0; r_ < SYNC_EXTRA; ++r_) cg::this_grid().sync();
#endif
    PH_END
    PH_BEGIN(10) phase_final(a); PH_END
}

extern "C" void kernel_launch(void* const* d_in, const int* in_sizes, int n_in, void* d_out, int out_size, void* d_ws, size_t ws_size, hipStream_t stream) {
    static int grid = 0;
    if (grid == 0) {
        if (n_in != 23 || ws_size < WS_END) { fprintf(stderr, "kernel_launch: unexpected n_in %d / ws_size %zu (need %zu)\n", n_in, ws_size, (size_t)WS_END); grid = -1; return; }
        int dev = 0, cus = 0, per_cu = 0;
        hipGetDevice(&dev);
        hipDeviceGetAttribute(&cus, hipDeviceAttributeMultiprocessorCount, dev);
        if (hipFuncSetAttribute((const void*)mega, hipFuncAttributeMaxDynamicSharedMemorySize, LDS_BYTES) != hipSuccess) { fprintf(stderr, "kernel_launch: hipFuncSetAttribute failed\n"); grid = -1; return; }
        if (hipOccupancyMaxActiveBlocksPerMultiprocessor(&per_cu, (const void*)mega, 512, LDS_BYTES) != hipSuccess || per_cu < 1) { fprintf(stderr, "kernel_launch: occupancy query says %d\n", per_cu); per_cu = 1; }
        (void)hipGetLastError();
        grid = cus;
    }
    if (grid < 0) return;
    Args a{};
    for (int i = 0; i < 23; ++i) a.in[i] = (const float*)d_in[i];
    a.out = (float*)d_out; a.ws = (unsigned char*)d_ws;
    (void)hipMemsetAsync((unsigned char*)d_ws + WS_BAR, 0, 16384, stream);
#if MULTI_LAUNCH
    for (int ph = 0; ph < NPH; ++ph) {
        a.ph_lo = ph; a.ph_hi = ph + 1;
        hipLaunchKernelGGL(mega, dim3(grid), dim3(512), LDS_BYTES, stream, a);
    }
#else
    a.ph_lo = 0; a.ph_hi = NPH;
    void* args[] = {&a};
    hipError_t e = hipLaunchCooperativeKernel((void*)mega, dim3(grid), dim3(512), args, LDS_BYTES, stream);
    if (e != hipSuccess) fprintf(stderr, "cooperative launch failed: %s (grid %d)\n", hipGetErrorString(e), grid);
#endif
}
```

```cpp
#include <hip/hip_runtime.h>
#include <hip/hip_cooperative_groups.h>
#include <cstdio>
namespace cg = cooperative_groups;

#ifndef MULTI_LAUNCH
#define MULTI_LAUNCH 0
#endif

#define LAS __attribute__((address_space(3)))
typedef unsigned short bf16_t;
typedef short bf16x8 __attribute__((ext_vector_type(8)));
typedef float f32x4 __attribute__((ext_vector_type(4)));
typedef unsigned u32x4 __attribute__((ext_vector_type(4)));
typedef unsigned u32x2 __attribute__((ext_vector_type(2)));

constexpr int DM = 1024, NTOK_C = 4096, NTOK_L = 8192, NTOK = 12288;
constexpr int LDU = 7424;
constexpr int C_XF = 0, C_GF = 512, C_SH = 1024, C_GR = 4224, C_MG = 5248;
constexpr int C_MERGED = 1024;
constexpr float RMS_EPS = 1e-6f, GN_EPS = 64e-5f;
constexpr int NPH = 11;
constexpr int LDS_BYTES = 152064;

constexpr size_t WS_WINT = 0;
constexpr size_t WS_WPF  = WS_WINT + (size_t)7424 * 1024 * 2;
constexpr size_t WS_WPR  = WS_WPF + (size_t)1024 * 512 * 2;
constexpr size_t WS_WOUT = WS_WPR + (size_t)1024 * 1024 * 2;
constexpr size_t WS_MODP = WS_WOUT + (size_t)1024 * 1024 * 2;
constexpr size_t WS_MODF = WS_MODP + (size_t)16 * 3 * 3072 * 4;
constexpr size_t WS_TAB  = WS_MODF + (size_t)3 * 3072 * 4;
constexpr size_t WS_WUPT = WS_TAB + 131072;
constexpr size_t WS_AUPT = WS_WUPT + 262144;
constexpr size_t WS_H    = WS_AUPT + 262144;
constexpr size_t WS_U    = WS_H + (size_t)NTOK * 1024 * 2;
constexpr size_t WS_RLAT = WS_U + (size_t)NTOK * LDU * 2;
constexpr size_t WS_BAR  = WS_RLAT + (size_t)1024 * 64 * 128 * 2;
constexpr size_t WS_MIX  = WS_BAR + 16384;
constexpr size_t WS_ZB   = WS_MIX + (size_t)NTOK * 128 * 2;
constexpr size_t WS_SAB  = WS_ZB + (size_t)64 * 2048 * 64 * 2;
constexpr size_t WS_END  = WS_SAB + (size_t)64 * 64 * 64 * 2;
static_assert(WS_END <= (size_t)256 * 1024 * 1024, "workspace map exceeds the guaranteed 256 MiB");
constexpr int LDS_XB = 151552;
constexpr int T_W128 = 0, T_WB64 = 32768, T_WC64 = 49152, T_WB16 = 57344, T_WC16 = 58368, T_END = 58880;
constexpr size_t YF_OFF = 0, BON_OFF = (size_t)NTOK * DM;
constexpr size_t QLAT_ELEMS = (size_t)1024 * 64 * 128;

struct Args { const float* in[23]; float* out; unsigned char* ws; int ph_lo, ph_hi; };

__device__ __forceinline__ unsigned f2bf(float f) { unsigned u = __float_as_uint(f); u += 0x7FFFu + ((u >> 16) & 1u); return u >> 16; }
typedef __bf16 bf16x2_t __attribute__((ext_vector_type(2)));
typedef float f32x2_t __attribute__((ext_vector_type(2)));
__device__ __forceinline__ unsigned pk2(float lo, float hi) { f32x2_t v = {lo, hi}; bf16x2_t b = __builtin_convertvector(v, bf16x2_t); return __builtin_bit_cast(unsigned, b); }
__device__ __forceinline__ float bf2f(unsigned b) { return __uint_as_float(b << 16); }
__device__ __forceinline__ float bflo(unsigned w) { return __uint_as_float(w << 16); }
__device__ __forceinline__ float bfhi(unsigned w) { return __uint_as_float(w & 0xffff0000u); }
__device__ __forceinline__ float wave_sum(float v) {
#pragma unroll
    for (int o = 1; o < 64; o <<= 1) v += __shfl_xor(v, o);
    return v;
}
__device__ __forceinline__ float sigmoidf_(float x) { return __builtin_amdgcn_rcpf(1.0f + __expf(-x)); }
__device__ __forceinline__ float siluf_(float x) { return x * __builtin_amdgcn_rcpf(1.0f + __expf(-x)); }
#define LDS_WAIT() asm volatile("s_waitcnt lgkmcnt(0)" ::: "memory")

namespace pg8 {
constexpr int BM = 256, BK = 64, HALF = 128, HTB = HALF * BK * 2, STAGE_BYTES = 8 * HTB, NXCD = 8, WGM = 8;
__device__ __forceinline__ int lds_byte(int r, int c) { const int st = (r >> 4) * 2 + (c >> 5), rr = r & 15, cc = c & 31, ob = rr * 64 + cc * 2; return st * 1024 + (ob ^ (((ob >> 9) & 1) << 5)); }
__device__ __forceinline__ void stage_rc(int b, int& R, int& C) { const int st = b / 1024, sb = b % 1024, swz = sb ^ (((sb >> 9) & 1) << 5); R = (st >> 1) * 16 + swz / 64; C = (st & 1) * 32 + (swz % 64) / 2; }
__device__ __forceinline__ int perm32(int rho) { const int n = rho >> 4, i = rho & 15; return 8 * (i >> 2) + 4 * n + (i & 3); }
struct Unit { int pm, pn; };
struct Gemm { const bf16_t* A; const bf16_t* Bt; int M, N, K, lda, ldb; };
struct StaticOrder {
    int nM, nN, nwg, G, c;
    __device__ __forceinline__ void init(int M, int N, int G_, int c_) { nM = M / BM; nN = N / BM; nwg = nM * nN; G = G_; c = c_; }
    __device__ __forceinline__ bool next(int i, Unit& u) const {
        const long L = (long)i * G + c; if (L >= nwg) return false;
        int wgid = (int)L; { const int q = nwg / NXCD, r = nwg % NXCD, xcd = wgid % NXCD, off = wgid / NXCD; wgid = (xcd < r ? xcd * (q + 1) : r * (q + 1) + (xcd - r) * q) + off; }
        const int nig = WGM * nN, gid = wgid / nig, fm = gid * WGM, gsz = (nM - fm) < WGM ? (nM - fm) : WGM;
        u.pm = fm + ((wgid % nig) % gsz); u.pn = (wgid % nig) / gsz; return true;
    }
};

template <class Epi>
__device__ __forceinline__ void gemm_phase(LAS unsigned char* lds, const Gemm g, const StaticOrder& S, const Epi& E) {
    int tid_ = threadIdx.x; asm volatile("" : "+v"(tid_));
    const int tid = tid_, wid = __builtin_amdgcn_readfirstlane(tid >> 6), lane = tid & 63, wr = wid >> 2, wc = wid & 3, fr = lane & 15, fq = lane >> 4;
    const int K = g.K, nt = K / BK;
    unsigned voffA[2], voffB[2];
#pragma unroll
    for (int i = 0; i < 2; ++i) { int R, C; stage_rc(tid * 16 + i * 8192, R, C); const int Rb = Epi::PERM ? ((R & ~31) + perm32(R & 31)) : R;
        voffA[i] = (unsigned)(R * g.lda + C) * 2u; voffB[i] = (unsigned)(Rb * g.ldb + C) * 2u; }
    const size_t kstep = (size_t)(BK * 2);
    const size_t hstepA = (size_t)HALF * g.lda * 2, hstepB = (size_t)HALF * g.ldb * 2;
    const size_t tstepA = 2 * hstepA, tstepB = 2 * hstepB;
    const unsigned ldsw = (unsigned)wid * 1024u;
    const int aoff = lds_byte(wr * 64 + fr, fq * 8), boff = lds_byte(wc * 32 + fr, fq * 8);
#define PG8_SA(b, h) (((b) * 2 + (h)) * HTB)
#define PG8_SB(b, h) ((4 + (b) * 2 + (h)) * HTB)
#define PG8_STAGE(bufoff, gbase, voff) do { _Pragma("unroll") for (int _i = 0; _i < 2; ++_i) \
        __builtin_amdgcn_global_load_lds((const unsigned*)((const char*)(gbase) + (voff)[_i]), (LAS unsigned*)(lds + (bufoff) + ldsw + _i * 8192), 16, 0, 0); } while (0)
#define PG8_LDA(dst, b, h) do { _Pragma("unroll") for (int m = 0; m < 4; ++m) _Pragma("unroll") for (int k = 0; k < 2; ++k) dst[m][k] = *(const LAS bf16x8*)(lds + PG8_SA(b, h) + aoff + m * 2048 + k * 1024); } while (0)
#define PG8_LDB(dst, b, h) do { _Pragma("unroll") for (int n = 0; n < 2; ++n) _Pragma("unroll") for (int k = 0; k < 2; ++k) dst[n][k] = *(const LAS bf16x8*)(lds + PG8_SB(b, h) + boff + n * 2048 + k * 1024); } while (0)
#define PG8_MMA(ai, bj, At, Bt) do { __builtin_amdgcn_s_setprio(1); _Pragma("unroll") for (int m = 0; m < 4; ++m) _Pragma("unroll") for (int n = 0; n < 2; ++n) _Pragma("unroll") for (int k = 0; k < 2; ++k) \
        acc[ai][bj][m][n] = __builtin_amdgcn_mfma_f32_16x16x32_bf16(Bt[n][k], At[m][k], acc[ai][bj][m][n], 0, 0, 0); __builtin_amdgcn_s_setprio(0); } while (0)
#define PG8_WAIT_V(n) asm volatile("s_waitcnt vmcnt(" #n ")" ::: "memory")
#define PG8_WAIT_L(n) asm volatile("s_waitcnt lgkmcnt(" #n ")" ::: "memory")
#define PG8_BAR __builtin_amdgcn_s_barrier()
#define PG8_SCHED __builtin_amdgcn_sched_barrier(0)
    Unit cur, nxt; int ui = 0;
    if (!S.next(0, cur)) return;
    f32x4 acc[2][2][4][2];
#pragma unroll
    for (int a = 0; a < 2; ++a)
#pragma unroll
        for (int b = 0; b < 2; ++b)
#pragma unroll
            for (int m = 0; m < 4; ++m)
#pragma unroll
                for (int n = 0; n < 2; ++n) acc[a][b][m][n] = (f32x4){0.f, 0.f, 0.f, 0.f};
    bf16x8 At[4][2], B0[2][2], B1[2][2];
    const char* cA = (const char*)g.A + (size_t)cur.pm * tstepA; const char* cB = (const char*)g.Bt + (size_t)cur.pn * tstepB;
    PG8_STAGE(PG8_SB(0, 0), cB, voffB); PG8_STAGE(PG8_SA(0, 0), cA, voffA); PG8_STAGE(PG8_SB(0, 1), cB + hstepB, voffB); PG8_STAGE(PG8_SA(0, 1), cA + hstepA, voffA);
    if (wr == 1) PG8_BAR;
    PG8_WAIT_V(4); PG8_BAR;
    PG8_STAGE(PG8_SB(1, 0), cB + kstep, voffB); PG8_STAGE(PG8_SA(1, 0), cA + kstep, voffA); PG8_STAGE(PG8_SB(1, 1), cB + hstepB + kstep, voffB);
    PG8_WAIT_V(6); PG8_BAR;
    for (;;) {
        const bool has_next = S.next(ui + 1, nxt);
        const char* nA = has_next ? (const char*)g.A + (size_t)nxt.pm * tstepA : cA; const char* nB = has_next ? (const char*)g.Bt + (size_t)nxt.pn * tstepB : cB;
        for (int t = 0; t < nt; t += 2) {
            const bool last = (t == nt - 2);
            const char* a1 = cA + (size_t)(t + 1) * kstep;
            const char* a2 = last ? nA : cA + (size_t)(t + 2) * kstep; const char* b2 = last ? nB : cB + (size_t)(t + 2) * kstep;
            const char* a3 = a2 + kstep; const char* b3 = b2 + kstep;
            PG8_LDB(B0, 0, 0); PG8_SCHED; PG8_LDA(At, 0, 0); PG8_STAGE(PG8_SA(1, 1), a1 + hstepA, voffA);
            PG8_WAIT_L(8); PG8_BAR; PG8_WAIT_L(0); PG8_MMA(0, 0, At, B0); PG8_BAR; PG8_SCHED;
            PG8_LDB(B1, 0, 1); PG8_STAGE(PG8_SB(0, 0), b2, voffB);
            PG8_BAR; PG8_WAIT_L(0); PG8_MMA(0, 1, At, B1); PG8_BAR;
            PG8_LDA(At, 0, 1); PG8_STAGE(PG8_SA(0, 0), a2, voffA);
            PG8_BAR; PG8_WAIT_L(0); PG8_MMA(1, 0, At, B0); PG8_BAR; PG8_SCHED;
            PG8_STAGE(PG8_SB(0, 1), b2 + hstepB, voffB);
            PG8_WAIT_V(6); PG8_BAR; PG8_MMA(1, 1, At, B1); PG8_BAR;
            PG8_LDB(B0, 1, 0); PG8_SCHED; PG8_LDA(At, 1, 0); PG8_STAGE(PG8_SA(0, 1), a2 + hstepA, voffA);
            PG8_WAIT_L(8); PG8_BAR; PG8_WAIT_L(0); PG8_MMA(0, 0, At, B0); PG8_BAR; PG8_SCHED;
            PG8_LDB(B1, 1, 1); PG8_STAGE(PG8_SB(1, 0), b3, voffB);
            PG8_BAR; PG8_WAIT_L(0); PG8_MMA(0, 1, At, B1); PG8_BAR;
            PG8_LDA(At, 1, 1); PG8_STAGE(PG8_SA(1, 0), a3, voffA);
            PG8_BAR; PG8_WAIT_L(0); PG8_MMA(1, 0, At, B0); PG8_BAR; PG8_SCHED;
            PG8_STAGE(PG8_SB(1, 1), b3 + hstepB, voffB);
            PG8_WAIT_V(6); PG8_BAR; PG8_MMA(1, 1, At, B1); PG8_BAR;
        }
        E(acc, cur, wr, wc, fr, fq);
        if (!has_next) break;
#pragma unroll
        for (int a = 0; a < 2; ++a)
#pragma unroll
            for (int b = 0; b < 2; ++b)
#pragma unroll
                for (int m = 0; m < 4; ++m)
#pragma unroll
                    for (int n = 0; n < 2; ++n) acc[a][b][m][n] = (f32x4){0.f, 0.f, 0.f, 0.f};
        cur = nxt; cA = nA; cB = nB; ++ui;
    }
    PG8_WAIT_V(0);
    if (wr == 0) PG8_BAR;
    PG8_BAR;
#undef PG8_SA
#undef PG8_SB
#undef PG8_STAGE
#undef PG8_LDA
#undef PG8_LDB
#undef PG8_MMA
#undef PG8_WAIT_V
#undef PG8_WAIT_L
#undef PG8_BAR
#undef PG8_SCHED
}
}
using pg8::Unit;

struct Epi1 {
    static constexpr bool PERM = true;
    bf16_t* U;
    __device__ __forceinline__ void operator()(const f32x4 (&acc)[2][2][4][2], const Unit& u, int wr, int wc, int fr, int fq) const {
        const int row0 = u.pm * 256 + wr * 64 + fr, col0 = u.pn * 256 + wc * 32 + 8 * fq;
#pragma unroll
        for (int bj = 0; bj < 2; ++bj) {
            const int c = col0 + bj * 128;
            const int act = (c < C_GF) ? 0 : (c < C_SH) ? 1 : (c < C_GR) ? 0 : (c < C_MG) ? 1 : 2;
#pragma unroll
            for (int ai = 0; ai < 2; ++ai)
#pragma unroll
                for (int m = 0; m < 4; ++m) {
                    f32x4 v0 = acc[ai][bj][m][0], v1 = acc[ai][bj][m][1];
                    if (act == 1) {
#pragma unroll
                        for (int j = 0; j < 4; ++j) { v0[j] = siluf_(v0[j]); v1[j] = siluf_(v1[j]); }
                    } else if (act == 2) {
#pragma unroll
                        for (int j = 0; j < 4; ++j) { v0[j] = sigmoidf_(v0[j]); v1[j] = sigmoidf_(v1[j]); }
                    }
                    u32x4 w; w.x = pk2(v0[0], v0[1]); w.y = pk2(v0[2], v0[3]); w.z = pk2(v1[0], v1[1]); w.w = pk2(v1[2], v1[3]);
                    *(u32x4*)(U + (size_t)(row0 + ai * 128 + m * 16) * LDU + c) = w;
                }
        }
    }
};
template <int second> struct Epi2 {
    static constexpr bool PERM = true;
    bf16_t* U;
    __device__ __forceinline__ void operator()(const f32x4 (&acc)[2][2][4][2], const Unit& u, int wr, int wc, int fr, int fq) const {
        const int row0 = u.pm * 256 + wr * 64 + fr, col0 = u.pn * 256 + wc * 32 + 8 * fq;
#pragma unroll
        for (int bj = 0; bj < 2; ++bj) {
            const int c = col0 + bj * 128;
#pragma unroll
            for (int ai = 0; ai < 2; ++ai)
#pragma unroll
                for (int m = 0; m < 4; ++m) {
                    bf16_t* rowp = U + (size_t)(row0 + ai * 128 + m * 16) * LDU;
                    const u32x4 gw = *(const u32x4*)(rowp + C_MG + (second ? 1024 : 0) + c);
                    const f32x4 v0 = acc[ai][bj][m][0], v1 = acc[ai][bj][m][1];
                    float o[8];
                    o[0] = v0[0] * bflo(gw.x); o[1] = v0[1] * bfhi(gw.x); o[2] = v0[2] * bflo(gw.y); o[3] = v0[3] * bfhi(gw.y);
                    o[4] = v1[0] * bflo(gw.z); o[5] = v1[1] * bfhi(gw.z); o[6] = v1[2] * bflo(gw.w); o[7] = v1[3] * bfhi(gw.w);
                    if (second) {
                        const u32x4 pw = *(const u32x4*)(rowp + C_MERGED + c);
                        o[0] += bflo(pw.x); o[1] += bfhi(pw.x); o[2] += bflo(pw.y); o[3] += bfhi(pw.y);
                        o[4] += bflo(pw.z); o[5] += bfhi(pw.z); o[6] += bflo(pw.w); o[7] += bfhi(pw.w);
                    }
                    u32x4 w; w.x = pk2(o[0], o[1]); w.y = pk2(o[2], o[3]); w.z = pk2(o[4], o[5]); w.w = pk2(o[6], o[7]);
                    *(u32x4*)(rowp + C_MERGED + c) = w;
                    asm volatile("" ::: "memory");
                }
        }
    }
};
struct Epi3 {
    static constexpr bool PERM = false;
    const float* xp; const float* xs; const float* modf; float* out;
    __device__ __forceinline__ void operator()(const f32x4 (&acc)[2][2][4][2], const Unit& u, int wr, int wc, int fr, int fq) const {
        const int row0 = u.pm * 256 + wr * 64 + fr, col0 = u.pn * 256 + wc * 32 + 4 * fq;
#pragma unroll
        for (int ai = 0; ai < 2; ++ai)
#pragma unroll
            for (int m = 0; m < 4; ++m) {
                const int row = row0 + ai * 128 + m * 16;
                const int set = row < NTOK_C ? 0 : 1 + ((row - NTOK_C) >> 12);
                const float* xr = row < NTOK_C ? xp + (size_t)row * DM : xs + (size_t)(row - NTOK_C) * DM;
                const float* gt = modf + set * 3072 + 2048;
#pragma unroll
                for (int bj = 0; bj < 2; ++bj)
#pragma unroll
                    for (int n = 0; n < 2; ++n) {
                        const int c = col0 + bj * 128 + n * 16;
                        const f32x4 xv = *(const f32x4*)(xr + c), gv = *(const f32x4*)(gt + c);
                        *(f32x4*)(out + (size_t)row * DM + c) = xv + gv * acc[ai][bj][m][n];
                    }
            }
    }
};

template <int MT, int NT, int KS, int UNR = 1>
__device__ __forceinline__ void wave_mma(const bf16_t* const (&ap)[MT], const bf16_t* const (&bp)[NT], f32x4 (&acc)[MT][NT], int fq) {
#pragma unroll UNR
    for (int ks = 0; ks < KS; ++ks) {
        bf16x8 av[MT], bv[NT];
#pragma unroll
        for (int mi = 0; mi < MT; ++mi) av[mi] = *(const bf16x8*)(ap[mi] + ks * 32 + fq * 8);
#pragma unroll
        for (int ni = 0; ni < NT; ++ni) bv[ni] = *(const bf16x8*)(bp[ni] + ks * 32 + fq * 8);
#pragma unroll
        for (int mi = 0; mi < MT; ++mi)
#pragma unroll
            for (int ni = 0; ni < NT; ++ni) acc[mi][ni] = __builtin_amdgcn_mfma_f32_16x16x32_bf16(av[mi], bv[ni], acc[mi][ni], 0, 0, 0);
    }
}
template <int MT, int NT, int KS, int LDB, int UNR = 1>
__device__ __forceinline__ void wave_mma_lb(const bf16_t* const (&ap)[MT], const LAS bf16_t* bl, f32x4 (&acc)[MT][NT], int fr, int fq) {
#pragma unroll UNR
    for (int ks = 0; ks < KS; ++ks) {
        bf16x8 av[MT], bv[NT];
#pragma unroll
        for (int mi = 0; mi < MT; ++mi) av[mi] = *(const bf16x8*)(ap[mi] + ks * 32 + fq * 8);
#pragma unroll
        for (int ni = 0; ni < NT; ++ni) bv[ni] = *(const LAS bf16x8*)(bl + (16 * ni + fr) * LDB + ks * 32 + fq * 8);
#pragma unroll
        for (int mi = 0; mi < MT; ++mi)
#pragma unroll
            for (int ni = 0; ni < NT; ++ni) acc[mi][ni] = __builtin_amdgcn_mfma_f32_16x16x32_bf16(av[mi], bv[ni], acc[mi][ni], 0, 0, 0);
    }
}
template <int LDB>
__device__ __forceinline__ void stage_table(LAS bf16_t* dst, const bf16_t* src, int rows, int cols) {
    const int per = cols / 8;
    for (int i = threadIdx.x; i < rows * per; i += 512) { const int r = i / per, c8 = i % per; *(LAS u32x4*)(dst + r * LDB + c8 * 8) = *(const u32x4*)(src + (size_t)r * cols + c8 * 8); }
}
__device__ __forceinline__ void st4bf(bf16_t* p, const f32x4 v) { u32x2 w; w.x = pk2(v[0], v[1]); w.y = pk2(v[2], v[3]); *(u32x2*)p = w; }

struct Ctx {
    const Args& a; LAS unsigned char* lds; int tid, lane, wv, gw, ngw;
};

__device__ __forceinline__ void transpose_item(const float* W, int K, int N, bf16_t* WT, LAS float* scr, int item, int lane) {
    const int nblk = N / 32, kb = item / nblk, nb = item % nblk, k0 = 64 * kb, n0 = 32 * nb;
#pragma unroll 8
    for (int i = 0; i < 32; ++i) { const int kk = 2 * i + (lane >> 5); scr[kk * 33 + (lane & 31)] = W[(size_t)(k0 + kk) * N + n0 + (lane & 31)]; }
    LDS_WAIT();
    const int c = lane & 7;
#pragma unroll
    for (int j = 0; j < 4; ++j) { const int n = (lane >> 3) + 8 * j; const LAS float* s = scr + (8 * c) * 33 + n;
        u32x4 o; o.x = pk2(s[0 * 33], s[1 * 33]); o.y = pk2(s[2 * 33], s[3 * 33]); o.z = pk2(s[4 * 33], s[5 * 33]); o.w = pk2(s[6 * 33], s[7 * 33]);
        *(u32x4*)(WT + (size_t)(n0 + n) * K + k0 + 8 * c) = o; }
    LDS_WAIT();
}
__device__ __forceinline__ void phase0(const Args& a, LAS unsigned char* lds) {
    const int tid = threadIdx.x, lane = tid & 63, wv = tid >> 6, gw = blockIdx.x * 8 + wv, ngw = gridDim.x * 8;
    unsigned char* ws = a.ws;
    for (int cb = blockIdx.x; cb < 256; cb += gridDim.x) {
        LAS float* sv = (LAS float*)(lds + 8 * 8448);
        LAS float* pr = sv + 3072;
        __syncthreads();
        for (int i = tid; i < 3072; i += 512) { const int v = i >> 10, k = i & 1023; sv[i] = siluf_((v == 0) ? a.in[4][k] : a.in[3][(v - 1) * 1024 + k]); }
        __syncthreads();
        const int kk = tid >> 2, cq = tid & 3, col = cb * 12 + 3 * cq;
        float acc[3][3];
#pragma unroll
        for (int v = 0; v < 3; ++v)
#pragma unroll
            for (int j = 0; j < 3; ++j) acc[v][j] = 0.f;
#pragma unroll
        for (int i = 0; i < 8; ++i) {
            const int k = kk + 128 * i;
            const float* w = a.in[6] + (size_t)k * 3072 + col;
            const float w0 = w[0], w1 = w[1], w2 = w[2];
#pragma unroll
            for (int v = 0; v < 3; ++v) { const float sk = sv[v * 1024 + k]; acc[v][0] += sk * w0; acc[v][1] += sk * w1; acc[v][2] += sk * w2; }
        }
#pragma unroll
        for (int v = 0; v < 3; ++v)
#pragma unroll
            for (int j = 0; j < 3; ++j) { float x = acc[v][j]; x += __shfl_xor(x, 4); x += __shfl_xor(x, 8); x += __shfl_xor(x, 16); x += __shfl_xor(x, 32); acc[v][j] = x; }
        if (lane < 4) {
#pragma unroll
            for (int v = 0; v < 3; ++v)
#pragma unroll
                for (int j = 0; j < 3; ++j) pr[(wv * 4 + lane) * 9 + v * 3 + j] = acc[v][j];
        }
        __syncthreads();
        if (tid < 36) {
            const int q = tid / 9, r = tid % 9, v = r / 3, j = r % 3;
            float sum = 0.f;
#pragma unroll
            for (int w8 = 0; w8 < 8; ++w8) sum += pr[(w8 * 4 + q) * 9 + r];
            const int c = cb * 12 + 3 * q + j;
            ((float*)(ws + WS_MODF))[v * 3072 + c] = sum + a.in[7][c];
        }
    }
    __syncthreads();
}
__device__ __forceinline__ void phase0_conv(const Args& a, LAS unsigned char* lds) {
    const int tid = threadIdx.x, lane = tid & 63, wv = tid >> 6, gw = blockIdx.x * 8 + wv, ngw = gridDim.x * 8;
    unsigned char* ws = a.ws;
    LAS float* scr = (LAS float*)(lds + wv * 8448);
    for (int it = gw; it < 16 * 228; it += ngw) transpose_item(a.in[8], 1024, 7296, (bf16_t*)(ws + WS_WINT), scr, it, lane);
    u32x4* padp = (u32x4*)((bf16_t*)(ws + WS_WINT) + (size_t)7296 * 1024);
    for (int i = blockIdx.x * 512 + tid; i < 128 * 1024 / 8; i += gridDim.x * 512) padp[i] = (u32x4){0u, 0u, 0u, 0u};
}
__device__ __forceinline__ void conv_rest(const Args& a, LAS unsigned char* lds, int wb, int nwb) {
    const int tid = threadIdx.x, lane = tid & 63, wv = tid >> 6, gw = wb * 8 + wv, ngw = nwb * 8;
    unsigned char* ws = a.ws;
    {
        LAS float* scr = (LAS float*)(lds + wv * 8448);
        constexpr int I_PF = 8 * 32, I_PR = 16 * 32, I_OUT = 16 * 32;
        for (int it = gw; it < I_PF + I_PR + I_OUT; it += ngw) {
            int r = it;
            if (r < I_PF) { transpose_item(a.in[19], 512, 1024, (bf16_t*)(ws + WS_WPF), scr, r, lane); continue; } r -= I_PF;
            if (r < I_PR) { transpose_item(a.in[20], 1024, 1024, (bf16_t*)(ws + WS_WPR), scr, r, lane); continue; } r -= I_PR;
            transpose_item(a.in[21], 1024, 1024, (bf16_t*)(ws + WS_WOUT), scr, r, lane);
        }
    }
    {
        bf16_t* wt = (bf16_t*)(ws + WS_WUPT); bf16_t* at = (bf16_t*)(ws + WS_AUPT);
        for (int i = wb * 512 + tid; i < 2 * 1024 * 64; i += nwb * 512) {
            const int rk = i & 63, C = (i >> 6) & 1023, d = i >> 16;
            wt[i] = (bf16_t)f2bf(a.in[11][(size_t)(d * 64 + rk) * 1024 + C]);
            at[i] = (bf16_t)f2bf(a.in[13][(size_t)(d * 64 + rk) * 1024 + C]);
        }
    }
    {
        bf16_t* tab = (bf16_t*)(ws + WS_TAB);
        for (int i = wb * 512 + tid; i < T_END; i += nwb * 512) {
            float val;
            if (i < T_WB64) {
                const int n = i >> 7, c = i & 127, part = n >> 7, kc = n & 127, m = (kc * c) & 127;
                const float x = (float)m * (1.0f / 64.0f);
                val = part ? -sinpif(x) : cospif(x);
            } else if (i < T_WC64) {
                const int j = i - T_WB64, n = j >> 7, k = j & 127, pp = n >> 6, k1 = n & 63, p = k >> 6, t1 = k & 63, m = (k1 * t1) & 63;
                const float x = (float)m * (1.0f / 32.0f), cs = cospif(x), sn = sinpif(x);
                val = (pp == p) ? cs : (pp == 0 ? sn : -sn);
            } else if (i < T_WB16) {
                const int j = i - T_WC64, k2 = j >> 7, k = j & 127, p = k >> 6, t2 = k & 63, m = (k2 * t2) & 63;
                const float x = (float)m * (1.0f / 32.0f);
                val = p ? sinpif(x) : cospif(x);
            } else if (i < T_WC16) {
                const int j = i - T_WB16, n = j >> 5, k = j & 31, pp = n >> 4, k1 = n & 15, p = k >> 4, t1 = k & 15, m = (k1 * t1) & 15;
                const float x = (float)m * (1.0f / 8.0f), cs = cospif(x), sn = sinpif(x);
                val = (pp == p) ? cs : (pp == 0 ? sn : -sn);
            } else {
                const int j = i - T_WC16, k2 = j >> 5, k = j & 31, p = k >> 4, t2 = k & 15, m = (k2 * t2) & 15;
                const float x = (float)m * (1.0f / 8.0f);
                val = p ? sinpif(x) : cospif(x);
            }
            tab[i] = (bf16_t)f2bf(val);
        }
    }
}

__device__ __forceinline__ void phase1(const Args& a, LAS unsigned char* lds) {
    const int tid = threadIdx.x, lane = tid & 63, wv = tid >> 6, gw = blockIdx.x * 8 + wv, ngw = gridDim.x * 8;
    unsigned char* ws = a.ws;
    LAS float* ml = (LAS float*)lds;
    const float* mf = (const float*)(ws + WS_MODF);
    for (int i = tid; i < 9216; i += 512) ml[i] = mf[i];
    __syncthreads();
    bf16_t* H = (bf16_t*)(ws + WS_H);
    const float* ng = a.in[5];
    for (int row0 = gw; row0 < NTOK; row0 += 3 * ngw) {
        f32x4 v[3][4];
#pragma unroll
        for (int u = 0; u < 3; ++u) {
            const int row = row0 + u * ngw < NTOK ? row0 + u * ngw : row0;
            const float* xr = row < NTOK_C ? a.in[0] + (size_t)row * DM : a.in[1] + (size_t)(row - NTOK_C) * DM;
#pragma unroll
            for (int j = 0; j < 4; ++j) v[u][j] = *(const f32x4*)(xr + lane * 4 + 256 * j);
        }
#pragma unroll
        for (int u = 0; u < 3; ++u) {
            const int row = row0 + u * ngw;
            if (row < NTOK) {
                const int set = row < NTOK_C ? 0 : 1 + ((row - NTOK_C) >> 12);
                float ss = 0.f;
#pragma unroll
                for (int j = 0; j < 4; ++j) ss += (v[u][j][0] * v[u][j][0] + v[u][j][1] * v[u][j][1]) + (v[u][j][2] * v[u][j][2] + v[u][j][3] * v[u][j][3]);
                const float rstd = rsqrtf(wave_sum(ss) * (1.0f / DM) + RMS_EPS);
#pragma unroll
                for (int j = 0; j < 4; ++j) {
                    const int c = lane * 4 + 256 * j;
                    const f32x4 g4 = *(const f32x4*)(ng + c);
                    float o[4];
#pragma unroll
                    for (int e = 0; e < 4; ++e) o[e] = (v[u][j][e] * rstd * g4[e]) * (1.0f + ml[set * 3072 + 1024 + c + e]) + ml[set * 3072 + c + e];
                    u32x2 w; w.x = pk2(o[0], o[1]); w.y = pk2(o[2], o[3]);
                    *(u32x2*)(H + (size_t)row * DM + c) = w;
                }
            }
        }
    }
}

__device__ __forceinline__ void fourier_l1(const Args& a, LAS unsigned char* lds) {
    const int tid = threadIdx.x, lane = tid & 63, wv = tid >> 6, gw = blockIdx.x * 8 + wv, ngw = gridDim.x * 8, fr = lane & 15, fq = lane >> 4;
    unsigned char* ws = a.ws;
    const bf16_t* U = (const bf16_t*)(ws + WS_U);
    const bf16_t* W128 = (const bf16_t*)(ws + WS_TAB) + T_W128;
    bf16_t* Qlat = (bf16_t*)(ws + WS_H);
    bf16_t* Qctx = Qlat + QLAT_ELEMS;
    LAS bf16_t* Wl = (LAS bf16_t*)lds;
    __syncthreads(); stage_table<136>(Wl, W128, 256, 128); __syncthreads();
    for (int wt = gw; wt < 2048 + 1024; wt += ngw) {
        const bf16_t* ap[4]; f32x4 acc[4][4];
#pragma unroll
        for (int mi = 0; mi < 4; ++mi)
#pragma unroll
            for (int ni = 0; ni < 4; ++ni) acc[mi][ni] = (f32x4){0.f, 0.f, 0.f, 0.f};
        if (wt < 2048) {
            const int nb = wt & 3, t2 = (wt >> 2) & 63, bg = wt >> 8, b = bg >> 2, g = bg & 3;
#pragma unroll
            for (int mi = 0; mi < 4; ++mi) ap[mi] = U + (size_t)(NTOK_C + b * 4096 + 64 * (16 * mi + fr) + t2) * LDU + C_XF + g * 128;
            wave_mma_lb<4, 4, 4, 136, 2>(ap, Wl + (nb * 64) * 136, acc, fr, fq);
#pragma unroll
            for (int mi = 0; mi < 4; ++mi)
#pragma unroll
                for (int ni = 0; ni < 4; ++ni) {
                    const int cn = nb * 64 + 16 * ni + fr, part = cn >> 7, kc = cn & 127;
                    st4bf(Qlat + ((((size_t)(bg * 128 + kc) * 64 + t2) * 2 + part) * 64 + 16 * mi + 4 * fq), acc[mi][ni]);
                }
        } else {
            const int w2 = wt - 2048, nb = w2 & 3, tg = (w2 >> 2) & 3, bg = w2 >> 4, b = bg >> 2, g = bg & 3;
#pragma unroll
            for (int mi = 0; mi < 4; ++mi) ap[mi] = U + (size_t)(b * 256 + 16 * fr + (tg * 4 + mi)) * LDU + C_XF + g * 128;
            wave_mma_lb<4, 4, 4, 136, 2>(ap, Wl + (nb * 64) * 136, acc, fr, fq);
#pragma unroll
            for (int mi = 0; mi < 4; ++mi)
#pragma unroll
                for (int ni = 0; ni < 4; ++ni) {
                    const int cn = nb * 64 + 16 * ni + fr, part = cn >> 7, kc = cn & 127, t2 = tg * 4 + mi;
                    st4bf(Qctx + ((((size_t)(bg * 128 + kc) * 16 + t2) * 2 + part) * 16 + 4 * fq), acc[mi][ni]);
                }
        }
    }
}
__device__ __forceinline__ void fourier_l2(const Args& a, LAS unsigned char* lds) {
    const int tid = threadIdx.x, lane = tid & 63, wv = tid >> 6, gw = blockIdx.x * 8 + wv, ngw = gridDim.x * 8, fr = lane & 15, fq = lane >> 4;
    unsigned char* ws = a.ws;
    const bf16_t* tab = (const bf16_t*)(ws + WS_TAB);
    const bf16_t* Qlat = (const bf16_t*)(ws + WS_H);
    const bf16_t* Qctx = Qlat + QLAT_ELEMS;
    bf16_t* Rlat = (bf16_t*)(ws + WS_RLAT);
    bf16_t* Rctx = (bf16_t*)(ws + WS_WINT);
    LAS bf16_t* Bl64 = (LAS bf16_t*)lds;
    LAS bf16_t* Bl16 = Bl64 + 128 * 136;
    __syncthreads(); stage_table<136>(Bl64, tab + T_WB64, 128, 128); stage_table<40>(Bl16, tab + T_WB16, 32, 32); __syncthreads();
    for (int wt = gw; wt < 2048 + 2048; wt += ngw) {
        if (wt < 2048) {
            const int bgkc = wt >> 1, mh = wt & 1;
            const bf16_t* ap[2]; f32x4 acc[2][8];
#pragma unroll
            for (int mi = 0; mi < 2; ++mi)
#pragma unroll
                for (int ni = 0; ni < 8; ++ni) acc[mi][ni] = (f32x4){0.f, 0.f, 0.f, 0.f};
#pragma unroll
            for (int mi = 0; mi < 2; ++mi) ap[mi] = Qlat + ((size_t)bgkc * 64 + 32 * mh + 16 * mi + fr) * 128;
            wave_mma_lb<2, 8, 4, 136>(ap, Bl64, acc, fr, fq);
#pragma unroll
            for (int mi = 0; mi < 2; ++mi)
#pragma unroll
                for (int ni = 0; ni < 4; ++ni) {
                    const int k1 = 16 * ni + fr;
                    f32x4 orr, oi;
#pragma unroll
                    for (int r = 0; r < 4; ++r) {
                        const int t2 = 32 * mh + 16 * mi + 4 * fq + r, m = (t2 * k1) & 4095;
                        const float x = (float)m * (1.0f / 2048.0f), cs = cospif(x), sn = sinpif(x);
                        const float br = acc[mi][ni][r], bi = acc[mi][ni + 4][r];
                        orr[r] = br * cs + bi * sn; oi[r] = bi * cs - br * sn;
                    }
                    bf16_t* dst = Rlat + ((size_t)bgkc * 64 + k1) * 128 + 32 * mh + 16 * mi + 4 * fq;
                    st4bf(dst, orr); st4bf(dst + 64, oi);
                }
        } else {
            const int bgkc0 = (wt - 2048) * 4;
            const bf16_t* ap[4]; f32x4 acc[4][2];
#pragma unroll
            for (int mi = 0; mi < 4; ++mi)
#pragma unroll
                for (int ni = 0; ni < 2; ++ni) acc[mi][ni] = (f32x4){0.f, 0.f, 0.f, 0.f};
#pragma unroll
            for (int mi = 0; mi < 4; ++mi) ap[mi] = Qctx + ((size_t)(bgkc0 + mi) * 16 + fr) * 32;
            wave_mma_lb<4, 2, 1, 40>(ap, Bl16, acc, fr, fq);
#pragma unroll
            for (int mi = 0; mi < 4; ++mi) {
                const int k1 = fr;
                f32x4 orr, oi;
#pragma unroll
                for (int r = 0; r < 4; ++r) {
                    const int t2 = 4 * fq + r, m = (t2 * k1) & 255;
                    const float x = (float)m * (1.0f / 128.0f), cs = cospif(x), sn = sinpif(x);
                    const float br = acc[mi][0][r], bi = acc[mi][1][r];
                    orr[r] = br * cs + bi * sn; oi[r] = bi * cs - br * sn;
                }
                bf16_t* dst = Rctx + ((size_t)(bgkc0 + mi) * 16 + k1) * 32 + 4 * fq;
                st4bf(dst, orr); st4bf(dst + 16, oi);
            }
        }
    }
}
__device__ __forceinline__ void fourier_l3(const Args& a, LAS unsigned char* lds) {
    const int skipb = (gridDim.x >= 128 && gridDim.x < 256) ? 64 : 0;
    if ((int)blockIdx.x < skipb) return;
    const int tid = threadIdx.x, lane = tid & 63, wv = tid >> 6, gw = ((int)blockIdx.x - skipb) * 8 + wv, ngw = ((int)gridDim.x - skipb) * 8, fr = lane & 15, fq = lane >> 4;
    unsigned char* ws = a.ws;
    const bf16_t* tab = (const bf16_t*)(ws + WS_TAB);
    const bf16_t* Rlat = (const bf16_t*)(ws + WS_RLAT);
    const bf16_t* Rctx = (const bf16_t*)(ws + WS_WINT);
    bf16_t* U = (bf16_t*)(ws + WS_U);
    LAS bf16_t* Cl64 = (LAS bf16_t*)lds;
    LAS bf16_t* Cl16 = Cl64 + 64 * 136;
    stage_table<136>(Cl64, tab + T_WC64, 64, 128); stage_table<40>(Cl16, tab + T_WC16, 16, 32); __syncthreads();
    for (int wt = gw; wt < 1024 + 2048; wt += ngw) {
        if (wt < 1024) {
            const int kb = wt & 1, k1 = (wt >> 1) & 63, bg = wt >> 7, b = bg >> 2, g = bg & 3;
            const bf16_t* ap[4]; f32x4 acc[4][4];
#pragma unroll
            for (int mi = 0; mi < 4; ++mi)
#pragma unroll
                for (int ni = 0; ni < 4; ++ni) acc[mi][ni] = (f32x4){0.f, 0.f, 0.f, 0.f};
#pragma unroll
            for (int mi = 0; mi < 4; ++mi) ap[mi] = Rlat + ((size_t)(bg * 128 + kb * 64 + 16 * mi + fr) * 64 + k1) * 128;
            wave_mma_lb<4, 4, 4, 136, 2>(ap, Cl64, acc, fr, fq);
            const float scale = 0.0013810679320049757f;
#pragma unroll
            for (int mi = 0; mi < 4; ++mi)
#pragma unroll
                for (int ni = 0; ni < 4; ++ni) {
                    const int k2 = 16 * ni + fr, kt = k1 + 64 * k2, row = NTOK_C + b * 4096 + kt, col = g * 128 + kb * 64 + 16 * mi + 4 * fq;
                    bf16_t* rp = U + (size_t)row * LDU;
                    const u32x2 gt = *(const u32x2*)(rp + C_GF + col);
                    f32x4 o; o[0] = acc[mi][ni][0] * scale * bflo(gt.x); o[1] = acc[mi][ni][1] * scale * bfhi(gt.x);
                    o[2] = acc[mi][ni][2] * scale * bflo(gt.y); o[3] = acc[mi][ni][3] * scale * bfhi(gt.y);
                    st4bf(rp + C_XF + col, o);
                }
        } else {
            const int w2 = wt - 1024, kb = w2 & 1, k1 = (w2 >> 1) & 15, bg = w2 >> 5, b = bg >> 2, g = bg & 3;
            const bf16_t* ap[4]; f32x4 acc[4][1];
#pragma unroll
            for (int mi = 0; mi < 4; ++mi) acc[mi][0] = (f32x4){0.f, 0.f, 0.f, 0.f};
#pragma unroll
            for (int mi = 0; mi < 4; ++mi) ap[mi] = Rctx + ((size_t)(bg * 128 + kb * 64 + 16 * mi + fr) * 16 + k1) * 32;
            wave_mma_lb<4, 1, 1, 40>(ap, Cl16, acc, fr, fq);
            const float scale = 0.005524271728019903f;
#pragma unroll
            for (int mi = 0; mi < 4; ++mi) {
                const int k2 = fr, kt = k1 + 16 * k2, row = b * 256 + kt, col = g * 128 + kb * 64 + 16 * mi + 4 * fq;
                bf16_t* rp = U + (size_t)row * LDU;
                const u32x2 gt = *(const u32x2*)(rp + C_GF + col);
                f32x4 o; o[0] = acc[mi][0][0] * scale * bflo(gt.x); o[1] = acc[mi][0][1] * scale * bfhi(gt.x);
                o[2] = acc[mi][0][2] * scale * bflo(gt.y); o[3] = acc[mi][0][3] * scale * bfhi(gt.y);
                st4bf(rp + C_XF + col, o);
            }
        }
    }
}

__device__ __forceinline__ float sh_mixed(const bf16_t* U, const float* mu, int row, int cs, int lat, int t) {
    int nb; bool valid;
    if (lat) {
        const int d = cs & 3, cg_ = t & 63, rg = t >> 6;
        if (d == 0) { valid = cg_ > 0; nb = row - 1; } else if (d == 1) { valid = cg_ < 63; nb = row + 1; }
        else if (d == 2) { valid = rg > 0; nb = row - 64; } else { valid = rg < 63; nb = row + 64; }
    } else {
        if (cs & 1) { valid = t < 255; nb = row + 1; } else { valid = t > 0; nb = row - 1; }
    }
    const float x = bf2f(U[(size_t)row * LDU + C_SH + cs]);
    const float s = valid ? bf2f(U[(size_t)nb * LDU + C_SH + cs]) : 0.0f;
    return x + mu[cs] * (s - x);
}

constexpr int LDP = 72;
constexpr int GS = 68;
constexpr int SC_X = 0, SC_AGF = 17408, SC_AAK = 17408, SC_ARK = 26624, SC_ARB = 35840, SC_TM = 45056, SC_TW = 54272, SC_AD = 63488,
              SC_AT = 72704, SC_RT = 81920, SC_BT = 91136, SC_KT = 100352, SC_BH = 109568, SC_KH = 118912, SC_VT = 128256, SC_SB = 137600, SC_EGL = 146816, SC_ABA = 147072, SC_PAR = 149632;
constexpr int LDQ = 40;
__device__ __forceinline__ bf16x8 ldfrag(const LAS bf16_t* arr, int row, int ks, int fq) { return *(const LAS bf16x8*)(arr + row * LDP + ks * 32 + fq * 8); }
__device__ __forceinline__ int tskew(int row) { return row * LDP + 8 * (row >> 3); }
__device__ __forceinline__ bf16x8 ldfragT(const LAS bf16_t* arr, int row, int ks, int fq) { return *(const LAS bf16x8*)(arr + tskew(row) + ks * 32 + fq * 8); }
__device__ __forceinline__ void st4lds(LAS bf16_t* p, const f32x4 v) { u32x2 w; w.x = pk2(v[0], v[1]); w.y = pk2(v[2], v[3]); *(LAS u32x2*)p = w; }
#define SBAR() do { asm volatile("s_waitcnt lgkmcnt(0)" ::: "memory"); __builtin_amdgcn_s_barrier(); asm volatile("" ::: "memory"); } while (0)
#define MMA16(a_, b_, c_) (c_) = __builtin_amdgcn_mfma_f32_16x16x32_bf16((a_), (b_), (c_), 0, 0, 0)

__device__ __forceinline__ float bfel(const u32x4 w, int e) { const unsigned x = w[e >> 1]; return (e & 1) ? bfhi(x) : bflo(x); }
__device__ __forceinline__ void mix8(const u32x4 self, const u32x4 (&nb)[4], const bool (&vl)[4], int lat, const f32x4 mu0, const f32x4 mu1, float (&out)[8]) {
#pragma unroll
    for (int e = 0; e < 8; ++e) {
        const float x = bfel(self, e);
        float s;
        if (lat) { const int d = e & 3; s = vl[d] ? bfel(nb[d], e) : 0.f; }
        else { const int d = e & 1; s = vl[d] ? bfel(nb[d], e) : 0.f; }
        const float m = (e < 4) ? mu0[e] : mu1[e - 4];
        out[e] = x + m * (s - x);
    }
}
__device__ __forceinline__ u32x4 pack8(const float (&v)[8]) { u32x4 w; w.x = pk2(v[0], v[1]); w.y = pk2(v[2], v[3]); w.z = pk2(v[4], v[5]); w.w = pk2(v[6], v[7]); return w; }
__device__ __forceinline__ float tanh_fast(float x) { const float e = __expf(2.0f * x); return 1.0f - 2.0f * __builtin_amdgcn_rcpf(e + 1.0f); }

__device__ __forceinline__ void phase_premix(const Args& a) {
    const bf16_t* U = (const bf16_t*)(a.ws + WS_U);
    bf16_t* MIX = (bf16_t*)(a.ws + WS_MIX);
    const float* mu = a.in[9];
    for (int idx = blockIdx.x * 512 + threadIdx.x; idx < NTOK * 16; idx += gridDim.x * 512) {
        const int row = idx >> 4, c0 = (idx & 15) * 8;
        const int lat = row >= NTOK_C, t = lat ? ((row - NTOK_C) & 4095) : (row & 255);
        bool nv[4]; int nrow[4];
        if (lat) { const int cx = t & 63, rg = t >> 6; nv[0] = cx > 0; nv[1] = cx < 63; nv[2] = rg > 0; nv[3] = rg < 63;
            nrow[0] = nv[0] ? row - 1 : row; nrow[1] = nv[1] ? row + 1 : row; nrow[2] = nv[2] ? row - 64 : row; nrow[3] = nv[3] ? row + 64 : row; }
        else { nv[0] = t > 0; nv[1] = t < 255; nv[2] = false; nv[3] = false; nrow[0] = nv[0] ? row - 1 : row; nrow[1] = nv[1] ? row + 1 : row; nrow[2] = row; nrow[3] = row; }
        const u32x4 Ws = *(const u32x4*)(U + (size_t)row * LDU + C_SH + 3072 + c0);
        u32x4 Wn[4];
#pragma unroll
        for (int d = 0; d < 4; ++d) { if (d < 2 || lat) Wn[d] = *(const u32x4*)(U + (size_t)nrow[d] * LDU + C_SH + 3072 + c0); else Wn[d] = Ws; }
        float o[8];
        mix8(Ws, Wn, nv, lat, *(const f32x4*)(mu + 3072 + c0), *(const f32x4*)(mu + 3072 + c0 + 4), o);
        if (c0 < 64) {
#pragma unroll
            for (int e = 0; e < 8; ++e) o[e] = tanh_fast(o[e]);
        }
        *(u32x4*)(MIX + (size_t)row * 128 + c0) = pack8(o);
    }
}

__device__ __forceinline__ void scan_chain(const Args& a, LAS unsigned char* lds, int lat, int b, int h, int dir, float ysc, int cbeg, int cend, int mode) {
    const int tid = threadIdx.x, lane = tid & 63, wv = __builtin_amdgcn_readfirstlane(tid >> 6), fr = lane & 15, fq = lane >> 4;
    const int T = lat ? 4096 : 256, row_base = lat ? NTOK_C + b * 4096 : b * 256;
    const bf16_t* U = (const bf16_t*)(a.ws + WS_U);
    const float* mu = a.in[9];
    LAS float* Gf = (LAS float*)(lds + SC_X); LAS float* AGf = (LAS float*)(lds + SC_AGF); LAS float* Aab = (LAS float*)(lds + SC_X);
    LAS bf16_t* Aak = (LAS bf16_t*)(lds + SC_AAK); LAS bf16_t* Ark = (LAS bf16_t*)(lds + SC_ARK); LAS bf16_t* Arb = (LAS bf16_t*)(lds + SC_ARB);
    LAS bf16_t* Tm = (LAS bf16_t*)(lds + SC_TM); LAS bf16_t* TW = (LAS bf16_t*)(lds + SC_TW); LAS bf16_t* AD = (LAS bf16_t*)(lds + SC_AD);
    LAS bf16_t* PT = TW; LAS bf16_t* UT = AD;
    LAS bf16_t* At = (LAS bf16_t*)(lds + SC_AT); LAS bf16_t* Rt = (LAS bf16_t*)(lds + SC_RT); LAS bf16_t* Bt = (LAS bf16_t*)(lds + SC_BT);
    LAS bf16_t* Kt = (LAS bf16_t*)(lds + SC_KT); LAS bf16_t* BhT = (LAS bf16_t*)(lds + SC_BH); LAS bf16_t* KhT = (LAS bf16_t*)(lds + SC_KH);
    LAS bf16_t* VT = (LAS bf16_t*)(lds + SC_VT); LAS bf16_t* Sb = (LAS bf16_t*)(lds + SC_SB); LAS float* EGL = (LAS float*)(lds + SC_EGL);
    const int nio = wv & 3, mo0 = 2 * (wv >> 2);
    f32x4 Sacc[2];
    {
        const int i = 16 * nio + fr;
#pragma unroll
        for (int mm = 0; mm < 2; ++mm) {
            const int j0 = 16 * (mo0 + mm) + 4 * fq;
            if (mode == 2) { Sacc[mm] = (f32x4){0.f, 0.f, 0.f, 0.f};
#pragma unroll
                for (int r = 0; r < 4; ++r) if (j0 + r == i) Sacc[mm][r] = 1.0f; }
            else if (lat && mode == 0) Sacc[mm] = *(const f32x4*)(a.in[2] + ((((size_t)b * 2 + dir) * 16 + h) * 64 + i) * 64 + j0);
            else Sacc[mm] = (f32x4){0.f, 0.f, 0.f, 0.f};
            st4lds(Sb + i * LDP + j0, Sacc[mm]);
        }
    }
    const int lr_strip = wv & 3;
    const bool lr_lo = wv < 4;
    const int lr_c = h * 64 + 16 * lr_strip + fr;
    const float lr_w0 = a.in[10][dir * 1024 + lr_c], lr_a0 = a.in[12][dir * 1024 + lr_c];
    const bf16_t* lr_bw = (const bf16_t*)(a.ws + WS_WUPT) + ((size_t)dir * 1024 + lr_c) * 64;
    const bf16_t* lr_ba = (const bf16_t*)(a.ws + WS_AUPT) + ((size_t)dir * 1024 + lr_c) * 64;
    u32x4 Rs, Ks, Vs, Rn[4], Kn[4], Vn[4]; bf16x8 Wf[2][4]; int nvm = 0;
    const bf16_t* MIXp = (const bf16_t*)(a.ws + WS_MIX);
    const int nch = cend;
#define SCAN_ISSUE(cidx) do { \
        const int l2_ = threadIdx.x & 63, p2_ = (l2_ >> 3) + 8 * wv, g2_ = l2_ & 7; \
        const int pos_ = (cidx) * 64 + p2_, t_ = dir ? T - 1 - pos_ : pos_, row_ = row_base + t_; \
        int n0_, n1_, n2_, n3_, m_ = 0; \
        if (lat) { const int cx = t_ & 63, rg = t_ >> 6; m_ = (cx > 0 ? 1 : 0) | (cx < 63 ? 2 : 0) | (rg > 0 ? 4 : 0) | (rg < 63 ? 8 : 0); \
            n0_ = (m_ & 1) ? row_ - 1 : row_; n1_ = (m_ & 2) ? row_ + 1 : row_; n2_ = (m_ & 4) ? row_ - 64 : row_; n3_ = (m_ & 8) ? row_ + 64 : row_; } \
        else { m_ = (t_ > 0 ? 1 : 0) | (t_ < 255 ? 2 : 0); n0_ = (m_ & 1) ? row_ - 1 : row_; n1_ = (m_ & 2) ? row_ + 1 : row_; n2_ = row_; n3_ = row_; } \
        nvm = m_; \
        const int colr_ = h * 64 + 8 * g2_; \
        const bf16_t* sp_ = U + (size_t)row_ * LDU + C_SH + colr_; \
        Rs = *(const u32x4*)(sp_); Ks = *(const u32x4*)(sp_ + 1024); Vs = *(const u32x4*)(sp_ + 2048); \
        { const bf16_t* q_ = U + (size_t)n0_ * LDU + C_SH + colr_; Rn[0] = *(const u32x4*)(q_); Kn[0] = *(const u32x4*)(q_ + 1024); Vn[0] = *(const u32x4*)(q_ + 2048); } \
        { const bf16_t* q_ = U + (size_t)n1_ * LDU + C_SH + colr_; Rn[1] = *(const u32x4*)(q_); Kn[1] = *(const u32x4*)(q_ + 1024); Vn[1] = *(const u32x4*)(q_ + 2048); } \
        if (lat) { \
            { const bf16_t* q_ = U + (size_t)n2_ * LDU + C_SH + colr_; Rn[2] = *(const u32x4*)(q_); Kn[2] = *(const u32x4*)(q_ + 1024); Vn[2] = *(const u32x4*)(q_ + 2048); } \
            { const bf16_t* q_ = U + (size_t)n3_ * LDU + C_SH + colr_; Rn[3] = *(const u32x4*)(q_); Kn[3] = *(const u32x4*)(q_ + 1024); Vn[3] = *(const u32x4*)(q_ + 2048); } \
        } else { Rn[2] = Rs; Kn[2] = Ks; Vn[2] = Vs; Rn[3] = Rs; Kn[3] = Ks; Vn[3] = Vs; } \
        _Pragma("unroll") for (int mi_ = 0; mi_ < 4; ++mi_) { \
            const int pw_ = (cidx) * 64 + 16 * mi_ + (l2_ & 15), tw_ = dir ? T - 1 - pw_ : pw_; \
            const bf16_t* wp_ = MIXp + (size_t)(row_base + tw_) * 128 + (((mi_ < 2) == lr_lo) ? 0 : 64) + (l2_ >> 4) * 8; \
            Wf[0][mi_] = *(const bf16x8*)(wp_); Wf[1][mi_] = *(const bf16x8*)(wp_ + 32); } \
    } while (0)
    {
        LAS float* PAR = (LAS float*)(lds + SC_PAR);
        const int tt = threadIdx.x;
        if (tt < 384) { const int w_ = tt >> 6, cc_ = h * 64 + (tt & 63);
            PAR[tt] = (w_ == 0) ? mu[cc_] : (w_ == 1) ? mu[1024 + cc_] : (w_ == 2) ? mu[2048 + cc_] : (w_ == 3) ? a.in[14][cc_] : (w_ == 4) ? a.in[15][cc_] : a.in[16][cc_]; }
    }
    for (int i_ = threadIdx.x; i_ < 32 * 32; i_ += 512) Tm[(i_ >> 5) * LDP + 32 + (i_ & 31)] = (bf16_t)0;
    SCAN_ISSUE(cbeg);
    for (int chunk = cbeg; chunk < nch; ++chunk) {
        int lv_ = threadIdx.x & 63; asm volatile("" : "+v"(lv_));
        const int lane = lv_, fr = lv_ & 15, fq = lv_ >> 4;
        const int tk_p = (lv_ >> 3) + 8 * wv, tk_cg = lv_ & 7;
        const int colr = h * 64 + 8 * tk_cg;
        {
            const int dmi = lr_lo ? 0 : 2, ami = lr_lo ? 2 : 0;
            f32x4 accd[2], acca[2];
#pragma unroll
            for (int mm = 0; mm < 2; ++mm) { accd[mm] = (f32x4){lr_w0, lr_w0, lr_w0, lr_w0}; acca[mm] = (f32x4){lr_a0, lr_a0, lr_a0, lr_a0}; }
#pragma unroll
            for (int ks = 0; ks < 2; ++ks) {
                const bf16x8 bw = *(const bf16x8*)(lr_bw + ks * 32 + fq * 8), ba = *(const bf16x8*)(lr_ba + ks * 32 + fq * 8);
                if (lr_lo) { MMA16(Wf[ks][0], bw, accd[0]); MMA16(Wf[ks][1], bw, accd[1]); MMA16(Wf[ks][2], ba, acca[0]); MMA16(Wf[ks][3], ba, acca[1]); }
                else       { MMA16(Wf[ks][2], bw, accd[0]); MMA16(Wf[ks][3], bw, accd[1]); MMA16(Wf[ks][0], ba, acca[0]); MMA16(Wf[ks][1], ba, acca[1]); }
            }
            const int ch = 16 * lr_strip + fr;
            float carry = 0.f;
#pragma unroll
            for (int mm = 0; mm < 2; ++mm) {
                float c[4];
#pragma unroll
                for (int r = 0; r < 4; ++r) {
                    const float lw = -0.87503878f * sigmoidf_(accd[mm][r]);
                    c[r] = (r ? c[r - 1] : 0.f) + lw;
                }
                const float t0 = __shfl(c[3], fr), t1 = __shfl(c[3], fr + 16), t2 = __shfl(c[3], fr + 32), t3 = __shfl(c[3], fr + 48);
                const float off = carry + (fq > 0 ? t0 : 0.f) + (fq > 1 ? t1 : 0.f) + (fq > 2 ? t2 : 0.f);
#pragma unroll
                for (int r = 0; r < 4; ++r) Gf[(16 * (dmi + mm) + 4 * fq + r) * GS + ch] = off + c[r];
                carry += (t0 + t1) + (t2 + t3);
            }
#pragma unroll
            for (int mm = 0; mm < 2; ++mm)
#pragma unroll
                for (int r = 0; r < 4; ++r) AGf[(16 * (ami + mm) + 4 * fq + r) * GS + ch] = sigmoidf_(acca[mm][r]);
        }
        SBAR();
        {
            const int c0 = 8 * tk_cg, p = tk_p;
            float rr[8], kx[8], vv[8];
            const bool nv[4] = {(nvm & 1) != 0, (nvm & 2) != 0, (nvm & 4) != 0, (nvm & 8) != 0};
            {
                const LAS float* PAR = (const LAS float*)(lds + SC_PAR) + c0;
                const f32x4 a0 = *(const LAS f32x4*)(PAR), a1 = *(const LAS f32x4*)(PAR + 4);
                mix8(Rs, Rn, nv, lat, a0, a1, rr);
                const f32x4 b0 = *(const LAS f32x4*)(PAR + 64), b1 = *(const LAS f32x4*)(PAR + 68);
                mix8(Ks, Kn, nv, lat, b0, b1, kx);
                const f32x4 d0 = *(const LAS f32x4*)(PAR + 128), d1 = *(const LAS f32x4*)(PAR + 132);
                mix8(Vs, Vn, nv, lat, d0, d1, vv);
                if (mode == 2) {
#pragma unroll
                    for (int e = 0; e < 8; ++e) vv[e] = 0.f; }
            }
            f32x4 g0 = *(const LAS f32x4*)(Gf + p * GS + c0), g1 = *(const LAS f32x4*)(Gf + p * GS + c0 + 4);
            const int pm = p > 0 ? p - 1 : 0;
            f32x4 q0 = *(const LAS f32x4*)(Gf + pm * GS + c0), q1 = *(const LAS f32x4*)(Gf + pm * GS + c0 + 4);
            const f32x4 h0 = *(const LAS f32x4*)(Gf + 31 * GS + c0), h1 = *(const LAS f32x4*)(Gf + 31 * GS + c0 + 4);
            if (p == 0) { q0 = (f32x4){0.f, 0.f, 0.f, 0.f}; q1 = q0; }
            if (p >= 32) { g0 += h0; g1 += h1; }
            if (p >= 33) { q0 += h0; q1 += h1; }
            const f32x4 ag0 = *(const LAS f32x4*)(AGf + p * GS + c0), ag1 = *(const LAS f32x4*)(AGf + p * GS + c0 + 4);
            const f32x4 l0 = *(const LAS f32x4*)(Gf + 63 * GS + c0) + h0, l1 = *(const LAS f32x4*)(Gf + 63 * GS + c0 + 4) + h1;
            const f32x4 kk0 = *(const LAS f32x4*)((const LAS float*)(lds + SC_PAR) + 192 + c0), kk1 = *(const LAS f32x4*)((const LAS float*)(lds + SC_PAR) + 196 + c0);
            const f32x4 ka0 = *(const LAS f32x4*)((const LAS float*)(lds + SC_PAR) + 256 + c0), ka1 = *(const LAS f32x4*)((const LAS float*)(lds + SC_PAR) + 260 + c0);
            float kkv[8], n2 = 0.f;
#pragma unroll
            for (int e = 0; e < 8; ++e) { kkv[e] = kx[e] * (e < 4 ? kk0[e] : kk1[e - 4]); n2 += kkv[e] * kkv[e]; }
            n2 += __shfl_xor(n2, 1); n2 += __shfl_xor(n2, 2); n2 += __shfl_xor(n2, 4);
            if (dir == 0 && mode != 2) {
                const f32x4 rk0 = *(const LAS f32x4*)((const LAS float*)(lds + SC_PAR) + 320 + c0), rk1 = *(const LAS f32x4*)((const LAS float*)(lds + SC_PAR) + 324 + c0);
                float bs = 0.f;
#pragma unroll
                for (int e = 0; e < 8; ++e) bs += rr[e] * kx[e] * (e < 4 ? rk0[e] : rk1[e - 4]);
                bs += __shfl_xor(bs, 1); bs += __shfl_xor(bs, 2); bs += __shfl_xor(bs, 4);
                float bo[8];
#pragma unroll
                for (int e = 0; e < 8; ++e) bo[e] = bs * vv[e];
                const int bpos = chunk * 64 + p, bt = bpos;
                *(u32x4*)((bf16_t*)a.out + BON_OFF + (size_t)(row_base + bt) * DM + h * 64 + c0) = pack8(bo);
            }
            const float inv = __builtin_amdgcn_rcpf(fmaxf(__builtin_amdgcn_sqrtf(n2), 1e-12f));
            float oa[8], orr[8], ob[8], ok[8];
#pragma unroll
            for (int e = 0; e < 8; ++e) {
                const float g = e < 4 ? g0[e] : g1[e - 4], gp = e < 4 ? q0[e] : q1[e - 4], ag = e < 4 ? ag0[e] : ag1[e - 4], gl = e < 4 ? l0[e] : l1[e - 4];
                const float kac = e < 4 ? ka0[e] : ka1[e - 4];
                const float kkn = kkv[e] * inv, kd = kx[e] * (1.0f + (ag - 1.0f) * kac), bb = kkn * ag;
                const float emg = __builtin_amdgcn_exp2f(-g), eh = __builtin_amdgcn_exp2f(gl - g);
                oa[e] = -kkn * __builtin_amdgcn_exp2f(gp); orr[e] = rr[e] * __builtin_amdgcn_exp2f(g); ob[e] = bb * emg; ok[e] = kd * emg;
                BhT[tskew(c0 + e) + p] = (bf16_t)f2bf(bb * eh);
                KhT[tskew(c0 + e) + p] = (bf16_t)f2bf(kd * eh);
                VT[tskew(c0 + e) + p] = (bf16_t)f2bf(vv[e]);
                if (p == 0) EGL[c0 + e] = __builtin_amdgcn_exp2f(gl);
            }
            *(LAS u32x4*)(At + p * LDP + c0) = pack8(oa); *(LAS u32x4*)(Rt + p * LDP + c0) = pack8(orr);
            *(LAS u32x4*)(Bt + p * LDP + c0) = pack8(ob); *(LAS u32x4*)(Kt + p * LDP + c0) = pack8(ok);
        }
        SBAR();
        {
#pragma unroll
            for (int rep = 0; rep < 2; ++rep) {
                const int tix = wv + 8 * rep;
                if (tix < 10) {
                    const int mi = tix < 4 ? 0 : tix < 7 ? 1 : tix < 9 ? 2 : 3, ni = tix < 4 ? tix : tix < 7 ? tix - 3 : tix < 9 ? tix - 5 : 3;
                    const bf16x8 x0 = ldfrag(Bt, 16 * mi + fr, 0, fq), x1 = ldfrag(Bt, 16 * mi + fr, 1, fq), y0 = ldfrag(At, 16 * ni + fr, 0, fq), y1 = ldfrag(At, 16 * ni + fr, 1, fq);
                    f32x4 c = (f32x4){0.f, 0.f, 0.f, 0.f};
                    MMA16(x0, y0, c); MMA16(x1, y1, c);
                    const int t = 16 * ni + fr, tau0 = 16 * mi + 4 * fq;
#pragma unroll
                    for (int r = 0; r < 4; ++r) if (tau0 + r >= t) c[r] = 0.f;
                    *(LAS f32x4*)(Aab + t * GS + tau0) = c;
                    if (mi < 2 && ni >= 2) st4lds((LAS bf16_t*)(lds + SC_ABA) + (t - 32) * LDQ + tau0, c);
                }
            }
        }
        SBAR();
        if (wv != 0) {
#pragma unroll 1
            for (int idx = wv - 1; idx < 48; idx += 7) {
                const int mat = 1 + (idx >> 4), mi = (idx >> 2) & 3, ni = idx & 3;
                const LAS bf16_t* X = (mat == 2) ? Bt : Kt;
                const LAS bf16_t* Y = (mat == 1) ? At : Rt;
                LAS bf16_t* dst = (mat == 1) ? Aak : (mat == 2) ? Arb : Ark;
                f32x4 c = (f32x4){0.f, 0.f, 0.f, 0.f};
                if (mi <= ni) {
                    const bf16x8 x0 = ldfrag(X, 16 * mi + fr, 0, fq), x1 = ldfrag(X, 16 * mi + fr, 1, fq), y0 = ldfrag(Y, 16 * ni + fr, 0, fq), y1 = ldfrag(Y, 16 * ni + fr, 1, fq);
                    MMA16(x0, y0, c); MMA16(x1, y1, c);
                }
                const int t = 16 * ni + fr, tau0 = 16 * mi + 4 * fq;
#pragma unroll
                for (int r = 0; r < 4; ++r) { const int tau = tau0 + r; if ((mat != 1) ? (tau > t) : (tau >= t)) c[r] = 0.f; }
                st4lds(dst + t * LDP + tau0, c);
            }
        }
        if (wv == 0) {
            LAS bf16_t* AbBA = (LAS bf16_t*)(lds + SC_ABA); LAS bf16_t* TT = UT; LAS bf16_t* WsT = UT + 32 * LDQ;
            const int hb = lane >> 5, c = lane & 31;
            const float cf = (float)c;
            float Tr[32];
#pragma unroll
            for (int t = 0; t < 32; ++t) Tr[t] = 0.f;
            {
                const int abase_i = (32 * hb) * GS + 32 * hb;
                f32x2_t TP[16];
#pragma unroll
                for (int q = 0; q < 16; ++q) TP[q] = (f32x2_t){0.f, 0.f};
                Tr[0] = 1.0f - fminf(cf, 1.0f); TP[0][0] = Tr[0];
                const f32x4 r1_0 = *(const LAS f32x4*)(Aab + abase_i + 68);
                const f32x4 r2_0 = *(const LAS f32x4*)(Aab + abase_i + 136);
                int o3 = abase_i + 204; asm volatile("" : "+v"(o3) : "v"(Tr[0]));
                const f32x4 r3_0 = *(const LAS f32x4*)(Aab + o3 + 0);
                __builtin_amdgcn_sched_barrier(0);
                { const f32x2_t pa = (f32x2_t){r1_0[0], r1_0[1]} * TP[0]; const f32x2_t pb = (f32x2_t){0.f, 0.f}; const f32x2_t ps = pa + pb;
                  Tr[1] = (ps[0] + ps[1]) + (1.0f - fminf(fabsf(cf - 1.0f), 1.0f)); TP[0][1] = Tr[1]; }
                __builtin_amdgcn_sched_barrier(0);
                int o4 = abase_i + 272; asm volatile("" : "+v"(o4) : "v"(Tr[1]));
                const f32x4 r4_0 = *(const LAS f32x4*)(Aab + o4 + 0);
                __builtin_amdgcn_sched_barrier(0);
                { const f32x2_t pa = (f32x2_t){r2_0[0], r2_0[1]} * TP[0]; const f32x2_t pb = (f32x2_t){0.f, 0.f}; const f32x2_t ps = pa + pb;
                  Tr[2] = (ps[0] + ps[1]) + (1.0f - fminf(fabsf(cf - 2.0f), 1.0f)); TP[1][0] = Tr[2]; }
                __builtin_amdgcn_sched_barrier(0);
                int o5 = abase_i + 340; asm volatile("" : "+v"(o5) : "v"(Tr[2]));
                const f32x4 r5_0 = *(const LAS f32x4*)(Aab + o5 + 0); const f32x4 r5_1 = *(const LAS f32x4*)(Aab + o5 + 4);
                __builtin_amdgcn_sched_barrier(0);
                { const f32x2_t pa = (f32x2_t){r3_0[0], r3_0[1]} * TP[0]; const f32x2_t pb = (f32x2_t){r3_0[2], r3_0[3]} * TP[1]; const f32x2_t ps = pa + pb;
                  Tr[3] = (ps[0] + ps[1]) + (1.0f - fminf(fabsf(cf - 3.0f), 1.0f)); TP[1][1] = Tr[3]; }
                __builtin_amdgcn_sched_barrier(0);
                int o6 = abase_i + 408; asm volatile("" : "+v"(o6) : "v"(Tr[3]));
                const f32x4 r6_0 = *(const LAS f32x4*)(Aab + o6 + 0); const f32x4 r6_1 = *(const LAS f32x4*)(Aab + o6 + 4);
                __builtin_amdgcn_sched_barrier(0);
                { const f32x2_t pa = (f32x2_t){r4_0[0], r4_0[1]} * TP[0]; const f32x2_t pb = (f32x2_t){r4_0[2], r4_0[3]} * TP[1]; const f32x2_t ps = pa + pb;
                  Tr[4] = (ps[0] + ps[1]) + (1.0f - fminf(fabsf(cf - 4.0f), 1.0f)); TP[2][0] = Tr[4]; }
                __builtin_amdgcn_sched_barrier(0);
                int o7 = abase_i + 476; asm volatile("" : "+v"(o7) : "v"(Tr[4]));
                const f32x4 r7_0 = *(const LAS f32x4*)(Aab + o7 + 0); const f32x4 r7_1 = *(const LAS f32x4*)(Aab + o7 + 4);
                __builtin_amdgcn_sched_barrier(0);
                { const f32x2_t pa = (f32x2_t){r5_0[0], r5_0[1]} * TP[0] + (f32x2_t){r5_1[0], r5_1[1]} * TP[2]; const f32x2_t pb = (f32x2_t){r5_0[2], r5_0[3]} * TP[1]; const f32x2_t ps = pa + pb;
                  Tr[5] = (ps[0] + ps[1]) + (1.0f - fminf(fabsf(cf - 5.0f), 1.0f)); TP[2][1] = Tr[5]; }
                __builtin_amdgcn_sched_barrier(0);
                int o8 = abase_i + 544; asm volatile("" : "+v"(o8) : "v"(Tr[5]));
                const f32x4 r8_0 = *(const LAS f32x4*)(Aab + o8 + 0); const f32x4 r8_1 = *(const LAS f32x4*)(Aab + o8 + 4);
                __builtin_amdgcn_sched_barrier(0);
                { const f32x2_t pa = (f32x2_t){r6_0[0], r6_0[1]} * TP[0] + (f32x2_t){r6_1[0], r6_1[1]} * TP[2]; const f32x2_t pb = (f32x2_t){r6_0[2], r6_0[3]} * TP[1]; const f32x2_t ps = pa + pb;
                  Tr[6] = (ps[0] + ps[1]) + (1.0f - fminf(fabsf(cf - 6.0f), 1.0f)); TP[3][0] = Tr[6]; }
                __builtin_amdgcn_sched_barrier(0);
                int o9 = abase_i + 612; asm volatile("" : "+v"(o9) : "v"(Tr[6]));
                const f32x4 r9_0 = *(const LAS f32x4*)(Aab + o9 + 0); const f32x4 r9_1 = *(const LAS f32x4*)(Aab + o9 + 4); const f32x4 r9_2 = *(const LAS f32x4*)(Aab + o9 + 8);
                __builtin_amdgcn_sched_barrier(0);
                { const f32x2_t pa = (f32x2_t){r7_0[0], r7_0[1]} * TP[0] + (f32x2_t){r7_1[0], r7_1[1]} * TP[2]; const f32x2_t pb = (f32x2_t){r7_0[2], r7_0[3]} * TP[1] + (f32x2_t){r7_1[2], r7_1[3]} * TP[3]; const f32x2_t ps = pa + pb;
                  Tr[7] = (ps[0] + ps[1]) + (1.0f - fminf(fabsf(cf - 7.0f), 1.0f)); TP[3][1] = Tr[7]; }
                __builtin_amdgcn_sched_barrier(0);
                int o10 = abase_i + 680; asm volatile("" : "+v"(o10) : "v"(Tr[7]));
                const f32x4 r10_0 = *(const LAS f32x4*)(Aab + o10 + 0); const f32x4 r10_1 = *(const LAS f32x4*)(Aab + o10 + 4); const f32x4 r10_2 = *(const LAS f32x4*)(Aab + o10 + 8);
                __builtin_amdgcn_sched_barrier(0);
                { const f32x2_t pa = (f32x2_t){r8_0[0], r8_0[1]} * TP[0] + (f32x2_t){r8_1[0], r8_1[1]} * TP[2]; const f32x2_t pb = (f32x2_t){r8_0[2], r8_0[3]} * TP[1] + (f32x2_t){r8_1[2], r8_1[3]} * TP[3]; const f32x2_t ps = pa + pb;
                  Tr[8] = (ps[0] + ps[1]) + (1.0f - fminf(fabsf(cf - 8.0f), 1.0f)); TP[4][0] = Tr[8]; }
                __builtin_amdgcn_sched_barrier(0);
                int o11 = abase_i + 748; asm volatile("" : "+v"(o11) : "v"(Tr[8]));
                const f32x4 r11_0 = *(const LAS f32x4*)(Aab + o11 + 0); const f32x4 r11_1 = *(const LAS f32x4*)(Aab + o11 + 4); const f32x4 r11_2 = *(const LAS f32x4*)(Aab + o11 + 8);
                __builtin_amdgcn_sched_barrier(0);
                { const f32x2_t pa = (f32x2_t){r9_0[0], r9_0[1]} * TP[0] + (f32x2_t){r9_1[0], r9_1[1]} * TP[2] + (f32x2_t){r9_2[0], r9_2[1]} * TP[4]; const f32x2_t pb = (f32x2_t){r9_0[2], r9_0[3]} * TP[1] + (f32x2_t){r9_1[2], r9_1[3]} * TP[3]; const f32x2_t ps = pa + pb;
                  Tr[9] = (ps[0] + ps[1]) + (1.0f - fminf(fabsf(cf - 9.0f), 1.0f)); TP[4][1] = Tr[9]; }
                __builtin_amdgcn_sched_barrier(0);
                int o12 = abase_i + 816; asm volatile("" : "+v"(o12) : "v"(Tr[9]));
                const f32x4 r12_0 = *(const LAS f32x4*)(Aab + o12 + 0); const f32x4 r12_1 = *(const LAS f32x4*)(Aab + o12 + 4); const f32x4 r12_2 = *(const LAS f32x4*)(Aab + o12 + 8);
                __builtin_amdgcn_sched_barrier(0);
                { const f32x2_t pa = (f32x2_t){r10_0[0], r10_0[1]} * TP[0] + (f32x2_t){r10_1[0], r10_1[1]} * TP[2] + (f32x2_t){r10_2[0], r10_2[1]} * TP[4]; const f32x2_t pb = (f32x2_t){r10_0[2], r10_0[3]} * TP[1] + (f32x2_t){r10_1[2], r10_1[3]} * TP[3]; const f32x2_t ps = pa + pb;
                  Tr[10] = (ps[0] + ps[1]) + (1.0f - fminf(fabsf(cf - 10.0f), 1.0f)); TP[5][0] = Tr[10]; }
                __builtin_amdgcn_sched_barrier(0);
                int o13 = abase_i + 884; asm volatile("" : "+v"(o13) : "v"(Tr[10]));
                const f32x4 r13_0 = *(const LAS f32x4*)(Aab + o13 + 0); const f32x4 r13_1 = *(const LAS f32x4*)(Aab + o13 + 4); const f32x4 r13_2 = *(const LAS f32x4*)(Aab + o13 + 8); const f32x4 r13_3 = *(const LAS f32x4*)(Aab + o13 + 12);
                __builtin_amdgcn_sched_barrier(0);
                { const f32x2_t pa = (f32x2_t){r11_0[0], r11_0[1]} * TP[0] + (f32x2_t){r11_1[0], r11_1[1]} * TP[2] + (f32x2_t){r11_2[0], r11_2[1]} * TP[4]; const f32x2_t pb = (f32x2_t){r11_0[2], r11_0[3]} * TP[1] + (f32x2_t){r11_1[2], r11_1[3]} * TP[3] + (f32x2_t){r11_2[2], r11_2[3]} * TP[5]; const f32x2_t ps = pa + pb;
                  Tr[11] = (ps[0] + ps[1]) + (1.0f - fminf(fabsf(cf - 11.0f), 1.0f)); TP[5][1] = Tr[11]; }
                __builtin_amdgcn_sched_barrier(0);
                int o14 = abase_i + 952; asm volatile("" : "+v"(o14) : "v"(Tr[11]));
                const f32x4 r14_0 = *(const LAS f32x4*)(Aab + o14 + 0); const f32x4 r14_1 = *(const LAS f32x4*)(Aab + o14 + 4); const f32x4 r14_2 = *(const LAS f32x4*)(Aab + o14 + 8); const f32x4 r14_3 = *(const LAS f32x4*)(Aab + o14 + 12);
                __builtin_amdgcn_sched_barrier(0);
                { const f32x2_t pa = (f32x2_t){r12_0[0], r12_0[1]} * TP[0] + (f32x2_t){r12_1[0], r12_1[1]} * TP[2] + (f32x2_t){r12_2[0], r12_2[1]} * TP[4]; const f32x2_t pb = (f32x2_t){r12_0[2], r12_0[3]} * TP[1] + (f32x2_t){r12_1[2], r12_1[3]} * TP[3] + (f32x2_t){r12_2[2], r12_2[3]} * TP[5]; const f32x2_t ps = pa + pb;
                  Tr[12] = (ps[0] + ps[1]) + (1.0f - fminf(fabsf(cf - 12.0f), 1.0f)); TP[6][0] = Tr[12]; }
                __builtin_amdgcn_sched_barrier(0);
                int o15 = abase_i + 1020; asm volatile("" : "+v"(o15) : "v"(Tr[12]));
                const f32x4 r15_0 = *(const LAS f32x4*)(Aab + o15 + 0); const f32x4 r15_1 = *(const LAS f32x4*)(Aab + o15 + 4); const f32x4 r15_2 = *(const LAS f32x4*)(Aab + o15 + 8); const f32x4 r15_3 = *(const LAS f32x4*)(Aab + o15 + 12);
                __builtin_amdgcn_sched_barrier(0);
                { const f32x2_t pa = (f32x2_t){r13_0[0], r13_0[1]} * TP[0] + (f32x2_t){r13_1[0], r13_1[1]} * TP[2] + (f32x2_t){r13_2[0], r13_2[1]} * TP[4] + (f32x2_t){r13_3[0], r13_3[1]} * TP[6]; const f32x2_t pb = (f32x2_t){r13_0[2], r13_0[3]} * TP[1] + (f32x2_t){r13_1[2], r13_1[3]} * TP[3] + (f32x2_t){r13_2[2], r13_2[3]} * TP[5]; const f32x2_t ps = pa + pb;
                  Tr[13] = (ps[0] + ps[1]) + (1.0f - fminf(fabsf(cf - 13.0f), 1.0f)); TP[6][1] = Tr[13]; }
                __builtin_amdgcn_sched_barrier(0);
                int o16 = abase_i + 1088; asm volatile("" : "+v"(o16) : "v"(Tr[13]));
                const f32x4 r16_0 = *(const LAS f32x4*)(Aab + o16 + 0); const f32x4 r16_1 = *(const LAS f32x4*)(Aab + o16 + 4); const f32x4 r16_2 = *(const LAS f32x4*)(Aab + o16 + 8); const f32x4 r16_3 = *(const LAS f32x4*)(Aab + o16 + 12);
                __builtin_amdgcn_sched_barrier(0);
                { const f32x2_t pa = (f32x2_t){r14_0[0], r14_0[1]} * TP[0] + (f32x2_t){r14_1[0], r14_1[1]} * TP[2] + (f32x2_t){r14_2[0], r14_2[1]} * TP[4] + (f32x2_t){r14_3[0], r14_3[1]} * TP[6]; const f32x2_t pb = (f32x2_t){r14_0[2], r14_0[3]} * TP[1] + (f32x2_t){r14_1[2], r14_1[3]} * TP[3] + (f32x2_t){r14_2[2], r14_2[3]} * TP[5]; const f32x2_t ps = pa + pb;
                  Tr[14] = (ps[0] + ps[1]) + (1.0f - fminf(fabsf(cf - 14.0f), 1.0f)); TP[7][0] = Tr[14]; }
                __builtin_amdgcn_sched_barrier(0);
                int o17 = abase_i + 1156; asm volatile("" : "+v"(o17) : "v"(Tr[14]));
                const f32x4 r17_0 = *(const LAS f32x4*)(Aab + o17 + 0); const f32x4 r17_1 = *(const LAS f32x4*)(Aab + o17 + 4); const f32x4 r17_2 = *(const LAS f32x4*)(Aab + o17 + 8); const f32x4 r17_3 = *(const LAS f32x4*)(Aab + o17 + 12); const f32x4 r17_4 = *(const LAS f32x4*)(Aab + o17 + 16);
                __builtin_amdgcn_sched_barrier(0);
                { const f32x2_t pa = (f32x2_t){r15_0[0], r15_0[1]} * TP[0] + (f32x2_t){r15_1[0], r15_1[1]} * TP[2] + (f32x2_t){r15_2[0], r15_2[1]} * TP[4] + (f32x2_t){r15_3[0], r15_3[1]} * TP[6]; const f32x2_t pb = (f32x2_t){r15_0[2], r15_0[3]} * TP[1] + (f32x2_t){r15_1[2], r15_1[3]} * TP[3] + (f32x2_t){r15_2[2], r15_2[3]} * TP[5] + (f32x2_t){r15_3[2], r15_3[3]} * TP[7]; const f32x2_t ps = pa + pb;
                  Tr[15] = (ps[0] + ps[1]) + (1.0f - fminf(fabsf(cf - 15.0f), 1.0f)); TP[7][1] = Tr[15]; }
                __builtin_amdgcn_sched_barrier(0);
                int o18 = abase_i + 1224; asm volatile("" : "+v"(o18) : "v"(Tr[15]));
                const f32x4 r18_0 = *(const LAS f32x4*)(Aab + o18 + 0); const f32x4 r18_1 = *(const LAS f32x4*)(Aab + o18 + 4); const f32x4 r18_2 = *(const LAS f32x4*)(Aab + o18 + 8); const f32x4 r18_3 = *(const LAS f32x4*)(Aab + o18 + 12); const f32x4 r18_4 = *(const LAS f32x4*)(Aab + o18 + 16);
                __builtin_amdgcn_sched_barrier(0);
                { const f32x2_t pa = (f32x2_t){r16_0[0], r16_0[1]} * TP[0] + (f32x2_t){r16_1[0], r16_1[1]} * TP[2] + (f32x2_t){r16_2[0], r16_2[1]} * TP[4] + (f32x2_t){r16_3[0], r16_3[1]} * TP[6]; const f32x2_t pb = (f32x2_t){r16_0[2], r16_0[3]} * TP[1] + (f32x2_t){r16_1[2], r16_1[3]} * TP[3] + (f32x2_t){r16_2[2], r16_2[3]} * TP[5] + (f32x2_t){r16_3[2], r16_3[3]} * TP[7]; const f32x2_t ps = pa + pb;
                  Tr[16] = (ps[0] + ps[1]) + (1.0f - fminf(fabsf(cf - 16.0f), 1.0f)); TP[8][0] = Tr[16]; }
                __builtin_amdgcn_sched_barrier(0);
                int o19 = abase_i + 1292; asm volatile("" : "+v"(o19) : "v"(Tr[16]));
                const f32x4 r19_0 = *(const LAS f32x4*)(Aab + o19 + 0); const f32x4 r19_1 = *(const LAS f32x4*)(Aab + o19 + 4); const f32x4 r19_2 = *(const LAS f32x4*)(Aab + o19 + 8); const f32x4 r19_3 = *(const LAS f32x4*)(Aab + o19 + 12); const f32x4 r19_4 = *(const LAS f32x4*)(Aab + o19 + 16);
                __builtin_amdgcn_sched_barrier(0);
                { const f32x2_t pa = (f32x2_t){r17_0[0], r17_0[1]} * TP[0] + (f32x2_t){r17_1[0], r17_1[1]} * TP[2] + (f32x2_t){r17_2[0], r17_2[1]} * TP[4] + (f32x2_t){r17_3[0], r17_3[1]} * TP[6] + (f32x2_t){r17_4[0], r17_4[1]} * TP[8]; const f32x2_t pb = (f32x2_t){r17_0[2], r17_0[3]} * TP[1] + (f32x2_t){r17_1[2], r17_1[3]} * TP[3] + (f32x2_t){r17_2[2], r17_2[3]} * TP[5] + (f32x2_t){r17_3[2], r17_3[3]} * TP[7]; const f32x2_t ps = pa + pb;
                  Tr[17] = (ps[0] + ps[1]) + (1.0f - fminf(fabsf(cf - 17.0f), 1.0f)); TP[8][1] = Tr[17]; }
                __builtin_amdgcn_sched_barrier(0);
                int o20 = abase_i + 1360; asm volatile("" : "+v"(o20) : "v"(Tr[17]));
                const f32x4 r20_0 = *(const LAS f32x4*)(Aab + o20 + 0); const f32x4 r20_1 = *(const LAS f32x4*)(Aab + o20 + 4); const f32x4 r20_2 = *(const LAS f32x4*)(Aab + o20 + 8); const f32x4 r20_3 = *(const LAS f32x4*)(Aab + o20 + 12); const f32x4 r20_4 = *(const LAS f32x4*)(Aab + o20 + 16);
                __builtin_amdgcn_sched_barrier(0);
                { const f32x2_t pa = (f32x2_t){r18_0[0], r18_0[1]} * TP[0] + (f32x2_t){r18_1[0], r18_1[1]} * TP[2] + (f32x2_t){r18_2[0], r18_2[1]} * TP[4] + (f32x2_t){r18_3[0], r18_3[1]} * TP[6] + (f32x2_t){r18_4[0], r18_4[1]} * TP[8]; const f32x2_t pb = (f32x2_t){r18_0[2], r18_0[3]} * TP[1] + (f32x2_t){r18_1[2], r18_1[3]} * TP[3] + (f32x2_t){r18_2[2], r18_2[3]} * TP[5] + (f32x2_t){r18_3[2], r18_3[3]} * TP[7]; const f32x2_t ps = pa + pb;
                  Tr[18] = (ps[0] + ps[1]) + (1.0f - fminf(fabsf(cf - 18.0f), 1.0f)); TP[9][0] = Tr[18]; }
                __builtin_amdgcn_sched_barrier(0);
                int o21 = abase_i + 1428; asm volatile("" : "+v"(o21) : "v"(Tr[18]));
                const f32x4 r21_0 = *(const LAS f32x4*)(Aab + o21 + 0); const f32x4 r21_1 = *(const LAS f32x4*)(Aab + o21 + 4); const f32x4 r21_2 = *(const LAS f32x4*)(Aab + o21 + 8); const f32x4 r21_3 = *(const LAS f32x4*)(Aab + o21 + 12); const f32x4 r21_4 = *(const LAS f32x4*)(Aab + o21 + 16); const f32x4 r21_5 = *(const LAS f32x4*)(Aab + o21 + 20);
                __builtin_amdgcn_sched_barrier(0);
                { const f32x2_t pa = (f32x2_t){r19_0[0], r19_0[1]} * TP[0] + (f32x2_t){r19_1[0], r19_1[1]} * TP[2] + (f32x2_t){r19_2[0], r19_2[1]} * TP[4] + (f32x2_t){r19_3[0], r19_3[1]} * TP[6] + (f32x2_t){r19_4[0], r19_4[1]} * TP[8]; const f32x2_t pb = (f32x2_t){r19_0[2], r19_0[3]} * TP[1] + (f32x2_t){r19_1[2], r19_1[3]} * TP[3] + (f32x2_t){r19_2[2], r19_2[3]} * TP[5] + (f32x2_t){r19_3[2], r19_3[3]} * TP[7] + (f32x2_t){r19_4[2], r19_4[3]} * TP[9]; const f32x2_t ps = pa + pb;
                  Tr[19] = (ps[0] + ps[1]) + (1.0f - fminf(fabsf(cf - 19.0f), 1.0f)); TP[9][1] = Tr[19]; }
                __builtin_amdgcn_sched_barrier(0);
                int o22 = abase_i + 1496; asm volatile("" : "+v"(o22) : "v"(Tr[19]));
                const f32x4 r22_0 = *(const LAS f32x4*)(Aab + o22 + 0); const f32x4 r22_1 = *(const LAS f32x4*)(Aab + o22 + 4); const f32x4 r22_2 = *(const LAS f32x4*)(Aab + o22 + 8); const f32x4 r22_3 = *(const LAS f32x4*)(Aab + o22 + 12); const f32x4 r22_4 = *(const LAS f32x4*)(Aab + o22 + 16); const f32x4 r22_5 = *(const LAS f32x4*)(Aab + o22 + 20);
                __builtin_amdgcn_sched_barrier(0);
                { const f32x2_t pa = (f32x2_t){r20_0[0], r20_0[1]} * TP[0] + (f32x2_t){r20_1[0], r20_1[1]} * TP[2] + (f32x2_t){r20_2[0], r20_2[1]} * TP[4] + (f32x2_t){r20_3[0], r20_3[1]} * TP[6] + (f32x2_t){r20_4[0], r20_4[1]} * TP[8]; const f32x2_t pb = (f32x2_t){r20_0[2], r20_0[3]} * TP[1] + (f32x2_t){r20_1[2], r20_1[3]} * TP[3] + (f32x2_t){r20_2[2], r20_2[3]} * TP[5] + (f32x2_t){r20_3[2], r20_3[3]} * TP[7] + (f32x2_t){r20_4[2], r20_4[3]} * TP[9]; const f32x2_t ps = pa + pb;
                  Tr[20] = (ps[0] + ps[1]) + (1.0f - fminf(fabsf(cf - 20.0f), 1.0f)); TP[10][0] = Tr[20]; }
                __builtin_amdgcn_sched_barrier(0);
                int o23 = abase_i + 1564; asm volatile("" : "+v"(o23) : "v"(Tr[20]));
                const f32x4 r23_0 = *(const LAS f32x4*)(Aab + o23 + 0); const f32x4 r23_1 = *(const LAS f32x4*)(Aab + o23 + 4); const f32x4 r23_2 = *(const LAS f32x4*)(Aab + o23 + 8); const f32x4 r23_3 = *(const LAS f32x4*)(Aab + o23 + 12); const f32x4 r23_4 = *(const LAS f32x4*)(Aab + o23 + 16); const f32x4 r23_5 = *(const LAS f32x4*)(Aab + o23 + 20);
                __builtin_amdgcn_sched_barrier(0);
                { const f32x2_t pa = (f32x2_t){r21_0[0], r21_0[1]} * TP[0] + (f32x2_t){r21_1[0], r21_1[1]} * TP[2] + (f32x2_t){r21_2[0], r21_2[1]} * TP[4] + (f32x2_t){r21_3[0], r21_3[1]} * TP[6] + (f32x2_t){r21_4[0], r21_4[1]} * TP[8] + (f32x2_t){r21_5[0], r21_5[1]} * TP[10]; const f32x2_t pb = (f32x2_t){r21_0[2], r21_0[3]} * TP[1] + (f32x2_t){r21_1[2], r21_1[3]} * TP[3] + (f32x2_t){r21_2[2], r21_2[3]} * TP[5] + (f32x2_t){r21_3[2], r21_3[3]} * TP[7] + (f32x2_t){r21_4[2], r21_4[3]} * TP[9]; const f32x2_t ps = pa + pb;
                  Tr[21] = (ps[0] + ps[1]) + (1.0f - fminf(fabsf(cf - 21.0f), 1.0f)); TP[10][1] = Tr[21]; }
                __builtin_amdgcn_sched_barrier(0);
                int o24 = abase_i + 1632; asm volatile("" : "+v"(o24) : "v"(Tr[21]));
                const f32x4 r24_0 = *(const LAS f32x4*)(Aab + o24 + 0); const f32x4 r24_1 = *(const LAS f32x4*)(Aab + o24 + 4); const f32x4 r24_2 = *(const LAS f32x4*)(Aab + o24 + 8); const f32x4 r24_3 = *(const LAS f32x4*)(Aab + o24 + 12); const f32x4 r24_4 = *(const LAS f32x4*)(Aab + o24 + 16); const f32x4 r24_5 = *(const LAS f32x4*)(Aab + o24 + 20);
                __builtin_amdgcn_sched_barrier(0);
                { const f32x2_t pa = (f32x2_t){r22_0[0], r22_0[1]} * TP[0] + (f32x2_t){r22_1[0], r22_1[1]} * TP[2] + (f32x2_t){r22_2[0], r22_2[1]} * TP[4] + (f32x2_t){r22_3[0], r22_3[1]} * TP[6] + (f32x2_t){r22_4[0], r22_4[1]} * TP[8] + (f32x2_t){r22_5[0], r22_5[1]} * TP[10]; const f32x2_t pb = (f32x2_t){r22_0[2], r22_0[3]} * TP[1] + (f32x2_t){r22_1[2], r22_1[3]} * TP[3] + (f32x2_t){r22_2[2], r22_2[3]} * TP[5] + (f32x2_t){r22_3[2], r22_3[3]} * TP[7] + (f32x2_t){r22_4[2], r22_4[3]} * TP[9]; const f32x2_t ps = pa + pb;
                  Tr[22] = (ps[0] + ps[1]) + (1.0f - fminf(fabsf(cf - 22.0f), 1.0f)); TP[11][0] = Tr[22]; }
                __builtin_amdgcn_sched_barrier(0);
                int o25 = abase_i + 1700; asm volatile("" : "+v"(o25) : "v"(Tr[22]));
                const f32x4 r25_0 = *(const LAS f32x4*)(Aab + o25 + 0); const f32x4 r25_1 = *(const LAS f32x4*)(Aab + o25 + 4); const f32x4 r25_2 = *(const LAS f32x4*)(Aab + o25 + 8); const f32x4 r25_3 = *(const LAS f32x4*)(Aab + o25 + 12); const f32x4 r25_4 = *(const LAS f32x4*)(Aab + o25 + 16); const f32x4 r25_5 = *(const LAS f32x4*)(Aab + o25 + 20); const f32x4 r25_6 = *(const LAS f32x4*)(Aab + o25 + 24);
                __builtin_amdgcn_sched_barrier(0);
                { const f32x2_t pa = (f32x2_t){r23_0[0], r23_0[1]} * TP[0] + (f32x2_t){r23_1[0], r23_1[1]} * TP[2] + (f32x2_t){r23_2[0], r23_2[1]} * TP[4] + (f32x2_t){r23_3[0], r23_3[1]} * TP[6] + (f32x2_t){r23_4[0], r23_4[1]} * TP[8] + (f32x2_t){r23_5[0], r23_5[1]} * TP[10]; const f32x2_t pb = (f32x2_t){r23_0[2], r23_0[3]} * TP[1] + (f32x2_t){r23_1[2], r23_1[3]} * TP[3] + (f32x2_t){r23_2[2], r23_2[3]} * TP[5] + (f32x2_t){r23_3[2], r23_3[3]} * TP[7] + (f32x2_t){r23_4[2], r23_4[3]} * TP[9] + (f32x2_t){r23_5[2], r23_5[3]} * TP[11]; const f32x2_t ps = pa + pb;
                  Tr[23] = (ps[0] + ps[1]) + (1.0f - fminf(fabsf(cf - 23.0f), 1.0f)); TP[11][1] = Tr[23]; }
                __builtin_amdgcn_sched_barrier(0);
                int o26 = abase_i + 1768; asm volatile("" : "+v"(o26) : "v"(Tr[23]));
                const f32x4 r26_0 = *(const LAS f32x4*)(Aab + o26 + 0); const f32x4 r26_1 = *(const LAS f32x4*)(Aab + o26 + 4); const f32x4 r26_2 = *(const LAS f32x4*)(Aab + o26 + 8); const f32x4 r26_3 = *(const LAS f32x4*)(Aab + o26 + 12); const f32x4 r26_4 = *(const LAS f32x4*)(Aab + o26 + 16); const f32x4 r26_5 = *(const LAS f32x4*)(Aab + o26 + 20); const f32x4 r26_6 = *(const LAS f32x4*)(Aab + o26 + 24);
                __builtin_amdgcn_sched_barrier(0);
                { const f32x2_t pa = (f32x2_t){r24_0[0], r24_0[1]} * TP[0] + (f32x2_t){r24_1[0], r24_1[1]} * TP[2] + (f32x2_t){r24_2[0], r24_2[1]} * TP[4] + (f32x2_t){r24_3[0], r24_3[1]} * TP[6] + (f32x2_t){r24_4[0], r24_4[1]} * TP[8] + (f32x2_t){r24_5[0], r24_5[1]} * TP[10]; const f32x2_t pb = (f32x2_t){r24_0[2], r24_0[3]} * TP[1] + (f32x2_t){r24_1[2], r24_1[3]} * TP[3] + (f32x2_t){r24_2[2], r24_2[3]} * TP[5] + (f32x2_t){r24_3[2], r24_3[3]} * TP[7] + (f32x2_t){r24_4[2], r24_4[3]} * TP[9] + (f32x2_t){r24_5[2], r24_5[3]} * TP[11]; const f32x2_t ps = pa + pb;
                  Tr[24] = (ps[0] + ps[1]) + (1.0f - fminf(fabsf(cf - 24.0f), 1.0f)); TP[12][0] = Tr[24]; }
                __builtin_amdgcn_sched_barrier(0);
                int o27 = abase_i + 1836; asm volatile("" : "+v"(o27) : "v"(Tr[24]));
                const f32x4 r27_0 = *(const LAS f32x4*)(Aab + o27 + 0); const f32x4 r27_1 = *(const LAS f32x4*)(Aab + o27 + 4); const f32x4 r27_2 = *(const LAS f32x4*)(Aab + o27 + 8); const f32x4 r27_3 = *(const LAS f32x4*)(Aab + o27 + 12); const f32x4 r27_4 = *(const LAS f32x4*)(Aab + o27 + 16); const f32x4 r27_5 = *(const LAS f32x4*)(Aab + o27 + 20); const f32x4 r27_6 = *(const LAS f32x4*)(Aab + o27 + 24);
                __builtin_amdgcn_sched_barrier(0);
                { const f32x2_t pa = (f32x2_t){r25_0[0], r25_0[1]} * TP[0] + (f32x2_t){r25_1[0], r25_1[1]} * TP[2] + (f32x2_t){r25_2[0], r25_2[1]} * TP[4] + (f32x2_t){r25_3[0], r25_3[1]} * TP[6] + (f32x2_t){r25_4[0], r25_4[1]} * TP[8] + (f32x2_t){r25_5[0], r25_5[1]} * TP[10] + (f32x2_t){r25_6[0], r25_6[1]} * TP[12]; const f32x2_t pb = (f32x2_t){r25_0[2], r25_0[3]} * TP[1] + (f32x2_t){r25_1[2], r25_1[3]} * TP[3] + (f32x2_t){r25_2[2], r25_2[3]} * TP[5] + (f32x2_t){r25_3[2], r25_3[3]} * TP[7] + (f32x2_t){r25_4[2], r25_4[3]} * TP[9] + (f32x2_t){r25_5[2], r25_5[3]} * TP[11]; const f32x2_t ps = pa + pb;
                  Tr[25] = (ps[0] + ps[1]) + (1.0f - fminf(fabsf(cf - 25.0f), 1.0f)); TP[12][1] = Tr[25]; }
                __builtin_amdgcn_sched_barrier(0);
                int o28 = abase_i + 1904; asm volatile("" : "+v"(o28) : "v"(Tr[25]));
                const f32x4 r28_0 = *(const LAS f32x4*)(Aab + o28 + 0); const f32x4 r28_1 = *(const LAS f32x4*)(Aab + o28 + 4); const f32x4 r28_2 = *(const LAS f32x4*)(Aab + o28 + 8); const f32x4 r28_3 = *(const LAS f32x4*)(Aab + o28 + 12); const f32x4 r28_4 = *(const LAS f32x4*)(Aab + o28 + 16); const f32x4 r28_5 = *(const LAS f32x4*)(Aab + o28 + 20); const f32x4 r28_6 = *(const LAS f32x4*)(Aab + o28 + 24);
                __builtin_amdgcn_sched_barrier(0);
                { const f32x2_t pa = (f32x2_t){r26_0[0], r26_0[1]} * TP[0] + (f32x2_t){r26_1[0], r26_1[1]} * TP[2] + (f32x2_t){r26_2[0], r26_2[1]} * TP[4] + (f32x2_t){r26_3[0], r26_3[1]} * TP[6] + (f32x2_t){r26_4[0], r26_4[1]} * TP[8] + (f32x2_t){r26_5[0], r26_5[1]} * TP[10] + (f32x2_t){r26_6[0], r26_6[1]} * TP[12]; const f32x2_t pb = (f32x2_t){r26_0[2], r26_0[3]} * TP[1] + (f32x2_t){r26_1[2], r26_1[3]} * TP[3] + (f32x2_t){r26_2[2], r26_2[3]} * TP[5] + (f32x2_t){r26_3[2], r26_3[3]} * TP[7] + (f32x2_t){r26_4[2], r26_4[3]} * TP[9] + (f32x2_t){r26_5[2], r26_5[3]} * TP[11]; const f32x2_t ps = pa + pb;
                  Tr[26] = (ps[0] + ps[1]) + (1.0f - fminf(fabsf(cf - 26.0f), 1.0f)); TP[13][0] = Tr[26]; }
                __builtin_amdgcn_sched_barrier(0);
                int o29 = abase_i + 1972; asm volatile("" : "+v"(o29) : "v"(Tr[26]));
                const f32x4 r29_0 = *(const LAS f32x4*)(Aab + o29 + 0); const f32x4 r29_1 = *(const LAS f32x4*)(Aab + o29 + 4); const f32x4 r29_2 = *(const LAS f32x4*)(Aab + o29 + 8); const f32x4 r29_3 = *(const LAS f32x4*)(Aab + o29 + 12); const f32x4 r29_4 = *(const LAS f32x4*)(Aab + o29 + 16); const f32x4 r29_5 = *(const LAS f32x4*)(Aab + o29 + 20); const f32x4 r29_6 = *(const LAS f32x4*)(Aab + o29 + 24); const f32x4 r29_7 = *(const LAS f32x4*)(Aab + o29 + 28);
                __builtin_amdgcn_sched_barrier(0);
                { const f32x2_t pa = (f32x2_t){r27_0[0], r27_0[1]} * TP[0] + (f32x2_t){r27_1[0], r27_1[1]} * TP[2] + (f32x2_t){r27_2[0], r27_2[1]} * TP[4] + (f32x2_t){r27_3[0], r27_3[1]} * TP[6] + (f32x2_t){r27_4[0], r27_4[1]} * TP[8] + (f32x2_t){r27_5[0], r27_5[1]} * TP[10] + (f32x2_t){r27_6[0], r27_6[1]} * TP[12]; const f32x2_t pb = (f32x2_t){r27_0[2], r27_0[3]} * TP[1] + (f32x2_t){r27_1[2], r27_1[3]} * TP[3] + (f32x2_t){r27_2[2], r27_2[3]} * TP[5] + (f32x2_t){r27_3[2], r27_3[3]} * TP[7] + (f32x2_t){r27_4[2], r27_4[3]} * TP[9] + (f32x2_t){r27_5[2], r27_5[3]} * TP[11] + (f32x2_t){r27_6[2], r27_6[3]} * TP[13]; const f32x2_t ps = pa + pb;
                  Tr[27] = (ps[0] + ps[1]) + (1.0f - fminf(fabsf(cf - 27.0f), 1.0f)); TP[13][1] = Tr[27]; }
                __builtin_amdgcn_sched_barrier(0);
                int o30 = abase_i + 2040; asm volatile("" : "+v"(o30) : "v"(Tr[27]));
                const f32x4 r30_0 = *(const LAS f32x4*)(Aab + o30 + 0); const f32x4 r30_1 = *(const LAS f32x4*)(Aab + o30 + 4); const f32x4 r30_2 = *(const LAS f32x4*)(Aab + o30 + 8); const f32x4 r30_3 = *(const LAS f32x4*)(Aab + o30 + 12); const f32x4 r30_4 = *(const LAS f32x4*)(Aab + o30 + 16); const f32x4 r30_5 = *(const LAS f32x4*)(Aab + o30 + 20); const f32x4 r30_6 = *(const LAS f32x4*)(Aab + o30 + 24); const f32x4 r30_7 = *(const LAS f32x4*)(Aab + o30 + 28);
                __builtin_amdgcn_sched_barrier(0);
                { const f32x2_t pa = (f32x2_t){r28_0[0], r28_0[1]} * TP[0] + (f32x2_t){r28_1[0], r28_1[1]} * TP[2] + (f32x2_t){r28_2[0], r28_2[1]} * TP[4] + (f32x2_t){r28_3[0], r28_3[1]} * TP[6] + (f32x2_t){r28_4[0], r28_4[1]} * TP[8] + (f32x2_t){r28_5[0], r28_5[1]} * TP[10] + (f32x2_t){r28_6[0], r28_6[1]} * TP[12]; const f32x2_t pb = (f32x2_t){r28_0[2], r28_0[3]} * TP[1] + (f32x2_t){r28_1[2], r28_1[3]} * TP[3] + (f32x2_t){r28_2[2], r28_2[3]} * TP[5] + (f32x2_t){r28_3[2], r28_3[3]} * TP[7] + (f32x2_t){r28_4[2], r28_4[3]} * TP[9] + (f32x2_t){r28_5[2], r28_5[3]} * TP[11] + (f32x2_t){r28_6[2], r28_6[3]} * TP[13]; const f32x2_t ps = pa + pb;
                  Tr[28] = (ps[0] + ps[1]) + (1.0f - fminf(fabsf(cf - 28.0f), 1.0f)); TP[14][0] = Tr[28]; }
                __builtin_amdgcn_sched_barrier(0);
                int o31 = abase_i + 2108; asm volatile("" : "+v"(o31) : "v"(Tr[28]));
                const f32x4 r31_0 = *(const LAS f32x4*)(Aab + o31 + 0); const f32x4 r31_1 = *(const LAS f32x4*)(Aab + o31 + 4); const f32x4 r31_2 = *(const LAS f32x4*)(Aab + o31 + 8); const f32x4 r31_3 = *(const LAS f32x4*)(Aab + o31 + 12); const f32x4 r31_4 = *(const LAS f32x4*)(Aab + o31 + 16); const f32x4 r31_5 = *(const LAS f32x4*)(Aab + o31 + 20); const f32x4 r31_6 = *(const LAS f32x4*)(Aab + o31 + 24); const f32x4 r31_7 = *(const LAS f32x4*)(Aab + o31 + 28);
                __builtin_amdgcn_sched_barrier(0);
                { const f32x2_t pa = (f32x2_t){r29_0[0], r29_0[1]} * TP[0] + (f32x2_t){r29_1[0], r29_1[1]} * TP[2] + (f32x2_t){r29_2[0], r29_2[1]} * TP[4] + (f32x2_t){r29_3[0], r29_3[1]} * TP[6] + (f32x2_t){r29_4[0], r29_4[1]} * TP[8] + (f32x2_t){r29_5[0], r29_5[1]} * TP[10] + (f32x2_t){r29_6[0], r29_6[1]} * TP[12] + (f32x2_t){r29_7[0], r29_7[1]} * TP[14]; const f32x2_t pb = (f32x2_t){r29_0[2], r29_0[3]} * TP[1] + (f32x2_t){r29_1[2], r29_1[3]} * TP[3] + (f32x2_t){r29_2[2], r29_2[3]} * TP[5] + (f32x2_t){r29_3[2], r29_3[3]} * TP[7] + (f32x2_t){r29_4[2], r29_4[3]} * TP[9] + (f32x2_t){r29_5[2], r29_5[3]} * TP[11] + (f32x2_t){r29_6[2], r29_6[3]} * TP[13]; const f32x2_t ps = pa + pb;
                  Tr[29] = (ps[0] + ps[1]) + (1.0f - fminf(fabsf(cf - 29.0f), 1.0f)); TP[14][1] = Tr[29]; }
                __builtin_amdgcn_sched_barrier(0);
                __builtin_amdgcn_sched_barrier(0);
                { const f32x2_t pa = (f32x2_t){r30_0[0], r30_0[1]} * TP[0] + (f32x2_t){r30_1[0], r30_1[1]} * TP[2] + (f32x2_t){r30_2[0], r30_2[1]} * TP[4] + (f32x2_t){r30_3[0], r30_3[1]} * TP[6] + (f32x2_t){r30_4[0], r30_4[1]} * TP[8] + (f32x2_t){r30_5[0], r30_5[1]} * TP[10] + (f32x2_t){r30_6[0], r30_6[1]} * TP[12] + (f32x2_t){r30_7[0], r30_7[1]} * TP[14]; const f32x2_t pb = (f32x2_t){r30_0[2], r30_0[3]} * TP[1] + (f32x2_t){r30_1[2], r30_1[3]} * TP[3] + (f32x2_t){r30_2[2], r30_2[3]} * TP[5] + (f32x2_t){r30_3[2], r30_3[3]} * TP[7] + (f32x2_t){r30_4[2], r30_4[3]} * TP[9] + (f32x2_t){r30_5[2], r30_5[3]} * TP[11] + (f32x2_t){r30_6[2], r30_6[3]} * TP[13]; const f32x2_t ps = pa + pb;
                  Tr[30] = (ps[0] + ps[1]) + (1.0f - fminf(fabsf(cf - 30.0f), 1.0f)); TP[15][0] = Tr[30]; }
                __builtin_amdgcn_sched_barrier(0);
                __builtin_amdgcn_sched_barrier(0);
                { const f32x2_t pa = (f32x2_t){r31_0[0], r31_0[1]} * TP[0] + (f32x2_t){r31_1[0], r31_1[1]} * TP[2] + (f32x2_t){r31_2[0], r31_2[1]} * TP[4] + (f32x2_t){r31_3[0], r31_3[1]} * TP[6] + (f32x2_t){r31_4[0], r31_4[1]} * TP[8] + (f32x2_t){r31_5[0], r31_5[1]} * TP[10] + (f32x2_t){r31_6[0], r31_6[1]} * TP[12] + (f32x2_t){r31_7[0], r31_7[1]} * TP[14]; const f32x2_t pb = (f32x2_t){r31_0[2], r31_0[3]} * TP[1] + (f32x2_t){r31_1[2], r31_1[3]} * TP[3] + (f32x2_t){r31_2[2], r31_2[3]} * TP[5] + (f32x2_t){r31_3[2], r31_3[3]} * TP[7] + (f32x2_t){r31_4[2], r31_4[3]} * TP[9] + (f32x2_t){r31_5[2], r31_5[3]} * TP[11] + (f32x2_t){r31_6[2], r31_6[3]} * TP[13] + (f32x2_t){r31_7[2], r31_7[3]} * TP[15]; const f32x2_t ps = pa + pb;
                  Tr[31] = (ps[0] + ps[1]) + (1.0f - fminf(fabsf(cf - 31.0f), 1.0f)); TP[15][1] = Tr[31]; }
                __builtin_amdgcn_sched_barrier(0);
            }
#pragma unroll
            for (int t = 0; t < 32; ++t) {
                Tm[(32 * hb + t) * LDP + 32 * hb + c] = (bf16_t)f2bf(Tr[t]);
            }
            if (hb == 0) {
#pragma unroll
                for (int q = 0; q < 4; ++q) { u32x4 w; w.x = pk2(Tr[8 * q], Tr[8 * q + 1]); w.y = pk2(Tr[8 * q + 2], Tr[8 * q + 3]); w.z = pk2(Tr[8 * q + 4], Tr[8 * q + 5]); w.w = pk2(Tr[8 * q + 6], Tr[8 * q + 7]);
                    *(LAS u32x4*)(TT + c * LDQ + 8 * q) = w; }
            }
            LDS_WAIT();
            f32x4 W[2][2];
#pragma unroll
            for (int mi = 0; mi < 2; ++mi)
#pragma unroll
                for (int ni = 0; ni < 2; ++ni) {
                    W[mi][ni] = (f32x4){0.f, 0.f, 0.f, 0.f};
                    MMA16(*(const LAS bf16x8*)(AbBA + (16 * mi + fr) * LDQ + fq * 8), *(const LAS bf16x8*)(TT + (16 * ni + fr) * LDQ + fq * 8), W[mi][ni]);
                    st4lds(WsT + (16 * ni + fr) * LDQ + 16 * mi + 4 * fq, W[mi][ni]);
                }
            LDS_WAIT();
#pragma unroll
            for (int mi = 0; mi < 2; ++mi)
#pragma unroll
                for (int ni = 0; ni < 2; ++ni) {
                    f32x4 r4 = (f32x4){0.f, 0.f, 0.f, 0.f};
                    MMA16(*(const LAS bf16x8*)(WsT + (16 * mi + fr) * LDQ + fq * 8), *(const LAS bf16x8*)(Tm + (32 + 16 * ni + fr) * LDP + 32 + fq * 8), r4);
                    st4lds(Tm + (32 + 16 * ni + fr) * LDP + 16 * mi + 4 * fq, r4);
                }
        }
        SBAR();
        {
            const int i0 = 16 * nio + fr;
            const bf16x8 s0 = ldfrag(Sb, i0, 0, fq), s1 = ldfrag(Sb, i0, 1, fq), v0 = ldfragT(VT, i0, 0, fq), v1 = ldfragT(VT, i0, 1, fq);
            bf16x8 fa[2][2], fk[2][2], fh[2][2]; f32x4 eg[2];
#pragma unroll
            for (int mm = 0; mm < 2; ++mm) {
                const int m0 = 16 * (mo0 + mm) + fr;
                fa[mm][0] = ldfrag(At, m0, 0, fq); fa[mm][1] = ldfrag(At, m0, 1, fq);
                fk[mm][0] = ldfrag(Aak, m0, 0, fq); fk[mm][1] = ldfrag(Aak, m0, 1, fq);
                fh[mm][0] = ldfragT(KhT, m0, 0, fq); fh[mm][1] = ldfragT(KhT, m0, 1, fq);
                eg[mm] = *(const LAS f32x4*)(EGL + 16 * (mo0 + mm) + 4 * fq);
            }
            __builtin_amdgcn_sched_barrier(0);
            f32x4 Pacc[2];
#pragma unroll
            for (int mm = 0; mm < 2; ++mm) {
                Pacc[mm] = (f32x4){0.f, 0.f, 0.f, 0.f};
                MMA16(fa[mm][0], s0, Pacc[mm]); MMA16(fa[mm][1], s1, Pacc[mm]);
                MMA16(fk[mm][0], v0, Pacc[mm]); MMA16(fk[mm][1], v1, Pacc[mm]);
                Sacc[mm] = Sacc[mm] * eg[mm];
                MMA16(fh[mm][0], v0, Sacc[mm]); MMA16(fh[mm][1], v1, Sacc[mm]);
            }
            __builtin_amdgcn_sched_barrier(0);
#pragma unroll
            for (int mm = 0; mm < 2; ++mm) st4lds(PT + i0 * LDP + 16 * (mo0 + mm) + 4 * fq, Pacc[mm]);
        }
        SBAR();
        { const int nc_ = chunk + 1 < nch ? chunk + 1 : chunk; SCAN_ISSUE(nc_); }
        {
            const int i0 = 16 * nio + fr;
            const bf16x8 p0 = ldfrag(PT, i0, 0, fq), p1 = ldfrag(PT, i0, 1, fq);
            bf16x8 ft[2][2];
#pragma unroll
            for (int mm = 0; mm < 2; ++mm) { ft[mm][0] = ldfrag(Tm, 16 * (mo0 + mm) + fr, 0, fq); ft[mm][1] = ldfrag(Tm, 16 * (mo0 + mm) + fr, 1, fq); }
            __builtin_amdgcn_sched_barrier(0);
            f32x4 Uacc[2];
#pragma unroll
            for (int mm = 0; mm < 2; ++mm) {
                Uacc[mm] = (f32x4){0.f, 0.f, 0.f, 0.f};
                MMA16(ft[mm][0], p0, Uacc[mm]); MMA16(ft[mm][1], p1, Uacc[mm]);
            }
            __builtin_amdgcn_sched_barrier(0);
#pragma unroll
            for (int mm = 0; mm < 2; ++mm) st4lds(UT + i0 * LDP + 16 * (mo0 + mm) + 4 * fq, Uacc[mm]);
        }
        SBAR();
        {
            const int i0 = 16 * nio + fr;
            const bf16x8 u0 = ldfrag(UT, i0, 0, fq), u1 = ldfrag(UT, i0, 1, fq);
            const int tl = 16 * nio + fr;
            const bf16x8 rt0 = ldfrag(Rt, tl, 0, fq), rt1 = ldfrag(Rt, tl, 1, fq), ak0 = ldfrag(Ark, tl, 0, fq), ak1 = ldfrag(Ark, tl, 1, fq), ab0 = ldfrag(Arb, tl, 0, fq), ab1 = ldfrag(Arb, tl, 1, fq);
            bf16x8 fb[2][2], fs[2][2], fv[2][2], fu[2][2];
#pragma unroll
            for (int mm = 0; mm < 2; ++mm) {
                const int m0 = 16 * (mo0 + mm) + fr;
                fb[mm][0] = ldfragT(BhT, m0, 0, fq); fb[mm][1] = ldfragT(BhT, m0, 1, fq);
                fs[mm][0] = ldfrag(Sb, m0, 0, fq); fs[mm][1] = ldfrag(Sb, m0, 1, fq);
                fv[mm][0] = ldfragT(VT, m0, 0, fq); fv[mm][1] = ldfragT(VT, m0, 1, fq);
                fu[mm][0] = ldfrag(UT, m0, 0, fq); fu[mm][1] = ldfrag(UT, m0, 1, fq);
            }
            __builtin_amdgcn_sched_barrier(0);
            f32x4 Yacc[2];
#pragma unroll
            for (int mm = 0; mm < 2; ++mm) {
                MMA16(fb[mm][0], u0, Sacc[mm]); MMA16(fb[mm][1], u1, Sacc[mm]);
                Yacc[mm] = (f32x4){0.f, 0.f, 0.f, 0.f};
                MMA16(fs[mm][0], rt0, Yacc[mm]); MMA16(fs[mm][1], rt1, Yacc[mm]);
                MMA16(fv[mm][0], ak0, Yacc[mm]); MMA16(fv[mm][1], ak1, Yacc[mm]);
                MMA16(fu[mm][0], ab0, Yacc[mm]); MMA16(fu[mm][1], ab1, Yacc[mm]);
            }
            __builtin_amdgcn_sched_barrier(0);
            SBAR();
            const int ypos = chunk * 64 + tl, yt = dir ? T - 1 - ypos : ypos;
            const size_t yoff = (size_t)(row_base + yt) * DM + h * 64;
#pragma unroll
            for (int mm = 0; mm < 2; ++mm) {
                st4lds(Sb + i0 * LDP + 16 * (mo0 + mm) + 4 * fq, Sacc[mm]);
                const int ic = 16 * (mo0 + mm) + 4 * fq;
                if (mode == 2) {
                    const int tloc = dir ? yt : yt - 2048;
                    st4bf((bf16_t*)(a.ws + WS_ZB) + ((size_t)((b * 16 + h) * 2 + dir) * 2048 + tloc) * 64 + ic, Yacc[mm]);
                } else if (ysc != 0.f) {
                    st4bf((dir == 0 ? (bf16_t*)a.out + YF_OFF : (bf16_t*)(a.ws + WS_H)) + yoff + ic, Yacc[mm]);
                }
            }
        }
    }
    if (!lat) {
        const int i = 16 * nio + fr;
#pragma unroll
        for (int mm = 0; mm < 2; ++mm)
            *(f32x4*)(a.out + (size_t)NTOK * DM + ((((size_t)b * 2 + dir) * 16 + h) * 64 + i) * 64 + 16 * (mo0 + mm) + 4 * fq) = Sacc[mm];
    } else if (mode == 0 && cend < T / 64) {
        const int i = 16 * nio + fr;
#pragma unroll
        for (int mm = 0; mm < 2; ++mm)
            st4bf((bf16_t*)(a.ws + WS_SAB) + ((size_t)((b * 16 + h) * 2 + dir) * 64 + i) * 64 + 16 * (mo0 + mm) + 4 * fq, Sacc[mm]);
    }
    __syncthreads();
}
__device__ __forceinline__ void phase_scan(const Args& a, LAS unsigned char* lds) {
    const int nb = gridDim.x, bx = blockIdx.x;
    for (int it = 0;; ++it) {
        int lat, c, cbeg = 0, cend, mode = 0;
        if (nb >= 256) {
            if (bx < 192) { if (it) break; lat = 1; c = bx & 63; const int role = bx >> 6; cbeg = role ? 32 : 0; cend = role ? 64 : 32; mode = role; }
            else { c = (bx - 192) + it * (nb - 192); if (c >= 512) break; lat = 0; cend = 4; }
        } else if (nb >= 128) {
            if (bx < 64) { if (it) break; lat = 1; c = bx; cend = 64; }
            else { c = (bx - 64) + it * (nb - 64); if (c >= 512) break; lat = 0; cend = 4; }
        } else {
            const int task = bx + it * nb; if (task >= 64 + 512) break;
            lat = task < 64; c = lat ? task : task - 64; cend = lat ? 64 : 4;
        }
        scan_chain(a, lds, lat, c >> 5, (c >> 1) & 15, c & 1, 1.0f, cbeg, cend, mode);
    }
}
__device__ __forceinline__ void phase_fixup(const Args& a) {
    const int tid = threadIdx.x, lane = tid & 63, wv = tid >> 6, gw = blockIdx.x * 8 + wv, ngw = gridDim.x * 8, fr = lane & 15, fq = lane >> 4;
    const bf16_t* SAB = (const bf16_t*)(a.ws + WS_SAB); const bf16_t* ZB = (const bf16_t*)(a.ws + WS_ZB);
    for (int wt = gw; wt < 64 * 32; wt += ngw) {
        const int chain = wt >> 5, blk = wt & 31, dir = chain & 1, h = (chain >> 1) & 15, b = chain >> 5;
        const bf16_t* ap[4]; const bf16_t* bp[4]; f32x4 acc[4][4];
#pragma unroll
        for (int mi = 0; mi < 4; ++mi)
#pragma unroll
            for (int ni = 0; ni < 4; ++ni) acc[mi][ni] = (f32x4){0.f, 0.f, 0.f, 0.f};
#pragma unroll
        for (int mi = 0; mi < 4; ++mi) ap[mi] = SAB + ((size_t)chain * 64 + 16 * mi + fr) * 64;
#pragma unroll
        for (int ni = 0; ni < 4; ++ni) bp[ni] = ZB + ((size_t)chain * 2048 + blk * 64 + 16 * ni + fr) * 64;
        wave_mma<4, 4, 2, 2>(ap, bp, acc, fq);
#pragma unroll
        for (int ni = 0; ni < 4; ++ni) {
            const int tloc = blk * 64 + 16 * ni + fr, t = dir ? tloc : 2048 + tloc;
            const size_t yoff = (size_t)(NTOK_C + b * 4096 + t) * DM + h * 64;
#pragma unroll
            for (int mi = 0; mi < 4; ++mi) {
                const int ic = 16 * mi + 4 * fq;
                bf16_t* p = (dir == 0 ? (bf16_t*)a.out + YF_OFF : (bf16_t*)(a.ws + WS_H)) + yoff + ic; const u32x2 w = *(const u32x2*)p;
                f32x4 o; o[0] = bflo(w.x) + acc[mi][ni][0]; o[1] = bfhi(w.x) + acc[mi][ni][1]; o[2] = bflo(w.y) + acc[mi][ni][2]; o[3] = bfhi(w.y) + acc[mi][ni][3];
                st4bf(p, o);
            }
        }
    }
}

__device__ __forceinline__ void phase_gn(const Args& a) {
    const int tid = threadIdx.x;
    bf16_t* U = (bf16_t*)(a.ws + WS_U);
    const bf16_t* YB = (const bf16_t*)(a.ws + WS_H);
    const bf16_t* YF = (const bf16_t*)a.out + YF_OFF;
    const bf16_t* BON = (const bf16_t*)a.out + BON_OFF;
    for (int idx = blockIdx.x * 512 + tid; idx < NTOK * 128; idx += gridDim.x * 512) {
        const int row = idx >> 7, c0 = (idx & 127) * 8;
        const u32x4 yfw = *(const u32x4*)(YF + (size_t)row * DM + c0), ybw = *(const u32x4*)(YB + (size_t)row * DM + c0);
        const u32x4 bw = *(const u32x4*)(BON + (size_t)row * DM + c0), gw = *(const u32x4*)(U + (size_t)row * LDU + C_GR + c0);
        const f32x4 lg0 = *(const f32x4*)(a.in[17] + c0), lg1 = *(const f32x4*)(a.in[17] + c0 + 4);
        const f32x4 lb0 = *(const f32x4*)(a.in[18] + c0), lb1 = *(const f32x4*)(a.in[18] + c0 + 4);
        float y[8], sm = 0.f;
#pragma unroll
        for (int e = 0; e < 8; ++e) { y[e] = bfel(yfw, e) + bfel(ybw, e); sm += y[e]; }
        sm += __shfl_xor(sm, 1); sm += __shfl_xor(sm, 2); sm += __shfl_xor(sm, 4);
        const float mean = sm * (1.0f / 64.0f);
        float vs = 0.f;
#pragma unroll
        for (int e = 0; e < 8; ++e) { y[e] -= mean; vs += y[e] * y[e]; }
        vs += __shfl_xor(vs, 1); vs += __shfl_xor(vs, 2); vs += __shfl_xor(vs, 4);
        const float rstd = rsqrtf(vs * (1.0f / 64.0f) + GN_EPS);
        float o[8];
#pragma unroll
        for (int e = 0; e < 8; ++e) { const float yn = y[e] * rstd * (e < 4 ? lg0[e] : lg1[e - 4]) + (e < 4 ? lb0[e] : lb1[e - 4]); o[e] = (yn + bfel(bw, e)) * bfel(gw, e); }
        *(u32x4*)(U + (size_t)row * LDU + C_GR + c0) = pack8(o);
    }
}

__device__ __forceinline__ void phase_final(const Args& a) {
    const int tid = threadIdx.x, lane = tid & 63, wv = tid >> 6, gw = blockIdx.x * 8 + wv, ngw = gridDim.x * 8;
    const float* fg = a.in[22];
    for (int row = gw; row < NTOK; row += ngw) {
        float* xr = a.out + (size_t)row * DM;
        f32x4 v[4]; float ss = 0.f;
#pragma unroll
        for (int j = 0; j < 4; ++j) { v[j] = *(const f32x4*)(xr + lane * 4 + 256 * j); ss += (v[j][0] * v[j][0] + v[j][1] * v[j][1]) + (v[j][2] * v[j][2] + v[j][3] * v[j][3]); }
        const float rstd = rsqrtf(wave_sum(ss) * (1.0f / DM) + RMS_EPS);
#pragma unroll
        for (int j = 0; j < 4; ++j) { const f32x4 g4 = *(const f32x4*)(fg + lane * 4 + 256 * j); *(f32x4*)(xr + lane * 4 + 256 * j) = v[j] * rstd * g4; }
    }
}

#define XB_TMO      128
#define XB_XCNT(j)  (256  + 64 * (j))
#define XB_XSUB(j)  (1280 + 64 * (j))
#define XB_XGEN(j)  (2304 + 64 * (j))
#define XB_TOP      3328
#define XB_TOPGEN   3392
#define XCD_BAR_WORDS 3456
#define XB_SPIN_CAP (1u << 18)
__device__ __forceinline__ unsigned xb_ld(unsigned* p)              { return __hip_atomic_load(p, __ATOMIC_RELAXED, __HIP_MEMORY_SCOPE_AGENT); }
__device__ __forceinline__ unsigned xb_add(unsigned* p, unsigned v) { return __hip_atomic_fetch_add(p, v, __ATOMIC_RELAXED, __HIP_MEMORY_SCOPE_AGENT); }
__device__ __forceinline__ unsigned xb_xcc_id() { return (unsigned)__builtin_amdgcn_s_getreg((3 << 11) | 20) & 0xFu; }
#define XB_SPIN(cond, bar) do { unsigned _sp = 0; while (cond) { __builtin_amdgcn_s_sleep(1); \
    if ((++_sp & 255u) == 0u) { if (xb_ld(&(bar)[XB_TMO])) break; if (_sp > XB_SPIN_CAP) { atomicAdd(&(bar)[XB_TMO], 1u); break; } } } } while (0)
struct XcdBarrier { unsigned* bar; unsigned x; volatile LAS unsigned* st; };
__device__ __forceinline__ XcdBarrier xcd_barrier_post(unsigned* bar, volatile LAS unsigned* st) {
    XcdBarrier b; b.bar = bar; b.x = xb_xcc_id(); b.st = st;
    if (threadIdx.x == 0) (void)xb_add(&bar[XB_XCNT(b.x)], 1u);
    return b;
}
__device__ __forceinline__ void xcd_barrier_complete(unsigned* bar, unsigned x, unsigned& nloc, unsigned& nx) {
    const unsigned G = gridDim.x * gridDim.y * gridDim.z;
    unsigned sum, cnt, mine, sp = 0u;
    for (;;) {
        sum = 0u; cnt = 0u; mine = 0u;
#pragma unroll
        for (unsigned j = 0; j < 16; ++j) { const unsigned c = xb_ld(&bar[XB_XCNT(j)]); sum += c; cnt += (c > 0u) ? 1u : 0u; mine = (j == x) ? c : mine; }
        if (sum == G) break;
        __builtin_amdgcn_s_sleep(1);
        if ((++sp & 255u) == 0u) { if (xb_ld(&bar[XB_TMO])) break; if (sp > XB_SPIN_CAP) { atomicAdd(&bar[XB_TMO], 1u); break; } }
    }
    nloc = mine > 0u ? mine : 1u; nx = cnt > 0u ? cnt : 1u;
}
__device__ __forceinline__ void xcd_barrier(const XcdBarrier& b) {
    asm volatile("s_waitcnt vmcnt(0)" ::: "memory");
    __syncthreads();
    if (threadIdx.x == 0) {
        unsigned* bar = b.bar;
        __builtin_amdgcn_s_waitcnt(0);
        unsigned nloc = b.st[0], nx = b.st[1];
        if (nloc == 0u) { xcd_barrier_complete(bar, b.x, nloc, nx); b.st[0] = nloc; b.st[1] = nx; }
        const unsigned old = xb_add(&bar[XB_XSUB(b.x)], 1u);
        const unsigned gen = old / nloc;
        if (old + 1u == (gen + 1u) * nloc) {
            __builtin_amdgcn_fence(__ATOMIC_RELEASE, "agent");
            asm volatile("s_waitcnt vmcnt(0)" ::: "memory");
            const unsigned og = xb_add(&bar[XB_TOP], 1u);
            const unsigned tg = og / nx;
            if (og + 1u == (tg + 1u) * nx) xb_add(&bar[XB_TOPGEN], 1u);
            else XB_SPIN(xb_ld(&bar[XB_TOPGEN]) == tg, bar);
            __builtin_amdgcn_fence(__ATOMIC_ACQUIRE, "agent");
            xb_add(&bar[XB_XGEN(b.x)], 1u);
            asm volatile("s_waitcnt vmcnt(0)" ::: "memory");
        } else {
            XB_SPIN(xb_ld(&bar[XB_XGEN(b.x)]) == gen, bar);
            __builtin_amdgcn_fence(__ATOMIC_ACQUIRE, "agent");
            asm volatile("s_waitcnt vmcnt(0)" ::: "memory");
        }
    }
    __syncthreads();
}

__global__ void __launch_bounds__(512) mega(Args a) {
    extern __shared__ __attribute__((aligned(16))) unsigned char lds_raw[];
    LAS unsigned char* lds = (LAS unsigned char*)lds_raw;
    unsigned char* ws = a.ws;
    bf16_t* U = (bf16_t*)(ws + WS_U);
    if (threadIdx.x < 4) ((LAS unsigned*)(lds + LDS_XB))[threadIdx.x] = 0u;
    __syncthreads();
    XcdBarrier xbar; xbar.bar = (unsigned*)(ws + WS_BAR); xbar.x = 0; xbar.st = (volatile LAS unsigned*)(lds + LDS_XB);
    if (a.ph_hi - a.ph_lo > 1) xbar = xcd_barrier_post((unsigned*)(ws + WS_BAR), (volatile LAS unsigned*)(lds + LDS_XB));
#define PH_BEGIN(k) if (a.ph_lo <= (k) && (k) < a.ph_hi) { if (a.ph_lo < (k)) { if (a.ph_lo == 0x7fff0000) cg::this_grid().sync(); else xcd_barrier(xbar); }
#define PH_END }
#ifndef REPMASK
#define REPMASK 0
#endif
#define NREP(k) (((REPMASK >> (k)) & 1) ? 2 : 1)
    PH_BEGIN(0) for (int r_ = 0; r_ < NREP(0); ++r_) { __syncthreads(); phase0(a, lds); } PH_END
    PH_BEGIN(1) for (int r_ = 0; r_ < NREP(1); ++r_) { __syncthreads(); phase0_conv(a, lds); __syncthreads(); phase1(a, lds); } PH_END
    PH_BEGIN(2)
        pg8::StaticOrder S; S.init(NTOK, LDU, gridDim.x, blockIdx.x);
        pg8::Gemm g{(const bf16_t*)(ws + WS_H), (const bf16_t*)(ws + WS_WINT), NTOK, LDU, 1024, 1024, 1024};
        Epi1 E{U};
#ifndef REP_PH2
#define REP_PH2 1
#endif
#pragma unroll 1
        for (int rep_ = 0; rep_ < REP_PH2; ++rep_) { if (rep_) __syncthreads(); pg8::gemm_phase(lds, g, S, E); }
        __syncthreads();
        if (gridDim.x == 256) { if (blockIdx.x >= 112) conv_rest(a, lds, blockIdx.x - 112, 144); } else conv_rest(a, lds, blockIdx.x, gridDim.x);
    PH_END
    PH_BEGIN(3) for (int r_ = 0; r_ < NREP(3); ++r_) fourier_l1(a, lds); PH_END
    PH_BEGIN(4) for (int r_ = 0; r_ < NREP(4); ++r_) fourier_l2(a, lds); phase_premix(a); PH_END
    PH_BEGIN(5) for (int r_ = 0; r_ < NREP(5); ++r_) fourier_l3(a, lds); __syncthreads(); PH_END
    if (a.ph_lo <= 6 && 6 < a.ph_hi) { if (a.ph_lo == 6) {} else if (!(a.ph_lo <= 5)) xcd_barrier(xbar);
#ifndef SCAN_REPS
#define SCAN_REPS 1
#endif
        for (int rep = 0; rep < SCAN_REPS; ++rep) {
            if (rep) {
                cg::this_grid().sync();
                { f32x4* yo = (f32x4*)a.out; for (int i = blockIdx.x * 512 + threadIdx.x; i < NTOK * DM / 4; i += gridDim.x * 512) yo[i] = (f32x4){0.f, 0.f, 0.f, 0.f}; }
                cg::this_grid().sync();
            }
            phase_scan(a, lds);
        }
    PH_END
    PH_BEGIN(7) if (gridDim.x >= 256 && a.ph_hi - a.ph_lo > 1) { phase_fixup(a); xcd_barrier(xbar); } phase_gn(a); PH_END
    PH_BEGIN(8)
        pg8::StaticOrder S; S.init(NTOK, 1024, gridDim.x, blockIdx.x);
#pragma unroll 1
        for (int r_ = 0; r_ < NREP(8); ++r_) {
        __syncthreads();
        {
            pg8::Gemm g{U + C_XF, (const bf16_t*)(ws + WS_WPF), NTOK, 1024, 512, LDU, 512};
            Epi2<0> E{U};
            pg8::gemm_phase(lds, g, S, E);
        }
        {
            pg8::Gemm g{U + C_GR, (const bf16_t*)(ws + WS_WPR), NTOK, 1024, 1024, LDU, 1024};
            Epi2<1> E{U};
            pg8::gemm_phase(lds, g, S, E);
        }
        }
    PH_END
    PH_BEGIN(9)
        pg8::StaticOrder S; S.init(NTOK, 1024, gridDim.x, blockIdx.x);
        pg8::Gemm g{U + C_MERGED, (const bf16_t*)(ws + WS_WOUT), NTOK, 1024, 1024, LDU, 1024};
        Epi3 E{a.in[0], a.in[1], (const float*)(ws + WS_MODF), a.out};
#pragma unroll 1
        for (int r_ = 0; r_ < NREP(9); ++r_) { __syncthreads(); pg8::gemm_phase(lds, g, S, E); }
#ifdef SYNC_EXTRA
        for (int r_ = 0; r_ < SYNC_EXTRA; ++r_) cg::this_grid().sync();
#endif
    PH_END
    PH_BEGIN(10) phase_final(a); PH_END
}

extern "C" void kernel_launch(void* const* d_in, const int* in_sizes, int n_in, void* d_out, int out_size, void* d_ws, size_t ws_size, hipStream_t stream) {
    static int grid = 0;
    if (grid == 0) {
        if (n_in != 23 || ws_size < WS_END) { fprintf(stderr, "kernel_launch: unexpected n_in %d / ws_size %zu (need %zu)\n", n_in, ws_size, (size_t)WS_END); grid = -1; return; }
        int dev = 0, cus = 0, per_cu = 0;
        hipGetDevice(&dev);
        hipDeviceGetAttribute(&cus, hipDeviceAttributeMultiprocessorCount, dev);
        if (hipFuncSetAttribute((const void*)mega, hipFuncAttributeMaxDynamicSharedMemorySize, LDS_BYTES) != hipSuccess) { fprintf(stderr, "kernel_launch: hipFuncSetAttribute failed\n"); grid = -1; return; }
        if (hipOccupancyMaxActiveBlocksPerMultiprocessor(&per_cu, (const void*)mega, 512, LDS_BYTES) != hipSuccess || per_cu < 1) { fprintf(stderr, "kernel_launch: occupancy query says %d\n", per_cu); per_cu = 1; }
        (void)hipGetLastError();
        grid = cus;
    }
    if (grid < 0) return;
    Args a{};
    for (int i = 0; i < 23; ++i) a.in[i] = (const float*)d_in[i];
    a.out = (float*)d_out; a.ws = (unsigned char*)d_ws;
    (void)hipMemsetAsync((unsigned char*)d_ws + WS_BAR, 0, 16384, stream);
#if MULTI_LAUNCH
    for (int ph = 0; ph < NPH; ++ph) {
        a.ph_lo = ph; a.ph_hi = ph + 1;
        hipLaunchKernelGGL(mega, dim3(grid), dim3(512), LDS_BYTES, stream, a);
    }
#else
    a.ph_lo = 0; a.ph_hi = NPH;
    void* args[] = {&a};
    hipError_t e = hipLaunchCooperativeKernel((void*)mega, dim3(grid), dim3(512), args, LDS_BYTES, stream);
    if (e != hipSuccess) fprintf(stderr, "cooperative launch failed: %s (grid %d)\n", hipGetErrorString(e), grid);
#endif
}
```

```cpp
#include <hip/hip_runtime.h>
#include <hip/hip_cooperative_groups.h>
#include <cstdio>
namespace cg = cooperative_groups;

#ifndef MULTI_LAUNCH
#define MULTI_LAUNCH 0
#endif

#define LAS __attribute__((address_space(3)))
typedef unsigned short bf16_t;
typedef short bf16x8 __attribute__((ext_vector_type(8)));
typedef float f32x4 __attribute__((ext_vector_type(4)));
typedef unsigned u32x4 __attribute__((ext_vector_type(4)));
typedef unsigned u32x2 __attribute__((ext_vector_type(2)));

constexpr int DM = 1024, NTOK_C = 4096, NTOK_L = 8192, NTOK = 12288;
constexpr int LDU = 7424;
constexpr int C_XF = 0, C_GF = 512, C_SH = 1024, C_GR = 4224, C_MG = 5248;
constexpr int C_MERGED = 1024;
constexpr float RMS_EPS = 1e-6f, GN_EPS = 64e-5f;
constexpr int NPH = 11;
constexpr int LDS_BYTES = 152064;

constexpr size_t WS_WINT = 0;
constexpr size_t WS_WPF  = WS_WINT + (size_t)7424 * 1024 * 2;
constexpr size_t WS_WPR  = WS_WPF + (size_t)1024 * 512 * 2;
constexpr size_t WS_WOUT = WS_WPR + (size_t)1024 * 1024 * 2;
constexpr size_t WS_MODP = WS_WOUT + (size_t)1024 * 1024 * 2;
constexpr size_t WS_MODF = WS_MODP + (size_t)16 * 3 * 3072 * 4;
constexpr size_t WS_TAB  = WS_MODF + (size_t)3 * 3072 * 4;
constexpr size_t WS_WUPT = WS_TAB + 131072;
constexpr size_t WS_AUPT = WS_WUPT + 262144;
constexpr size_t WS_H    = WS_AUPT + 262144;
constexpr size_t WS_U    = WS_H + (size_t)NTOK * 1024 * 2;
constexpr size_t WS_RLAT = WS_U + (size_t)NTOK * LDU * 2;
constexpr size_t WS_BAR  = WS_RLAT + (size_t)1024 * 64 * 128 * 2;
constexpr size_t WS_MIX  = WS_BAR + 16384;
constexpr size_t WS_ZB   = WS_MIX + (size_t)NTOK * 128 * 2;
constexpr size_t WS_SAB  = WS_ZB + (size_t)64 * 2048 * 64 * 2;
constexpr size_t WS_END  = WS_SAB + (size_t)64 * 64 * 64 * 2;
static_assert(WS_END <= (size_t)256 * 1024 * 1024, "workspace map exceeds the guaranteed 256 MiB");
constexpr int LDS_XB = 151552;
constexpr int T_W128 = 0, T_WB64 = 32768, T_WC64 = 49152, T_WB16 = 57344, T_WC16 = 58368, T_END = 58880;
constexpr size_t YF_OFF = 0, BON_OFF = (size_t)NTOK * DM;
constexpr size_t QLAT_ELEMS = (size_t)1024 * 64 * 128;

struct Args { const float* in[23]; float* out; unsigned char* ws; int ph_lo, ph_hi; };

__device__ __forceinline__ unsigned f2bf(float f) { unsigned u = __float_as_uint(f); u += 0x7FFFu + ((u >> 16) & 1u); return u >> 16; }
typedef __bf16 bf16x2_t __attribute__((ext_vector_type(2)));
typedef float f32x2_t __attribute__((ext_vector_type(2)));
__device__ __forceinline__ unsigned pk2(float lo, float hi) { f32x2_t v = {lo, hi}; bf16x2_t b = __builtin_convertvector(v, bf16x2_t); return __builtin_bit_cast(unsigned, b); }
__device__ __forceinline__ float bf2f(unsigned b) { return __uint_as_float(b << 16); }
__device__ __forceinline__ float bflo(unsigned w) { return __uint_as_float(w << 16); }
__device__ __forceinline__ float bfhi(unsigned w) { return __uint_as_float(w & 0xffff0000u); }
__device__ __forceinline__ float wave_sum(float v) {
#pragma unroll
    for (int o = 1; o < 64; o <<= 1) v += __shfl_xor(v, o);
    return v;
}
__device__ __forceinline__ float sigmoidf_(float x) { return __builtin_amdgcn_rcpf(1.0f + __expf(-x)); }
__device__ __forceinline__ float siluf_(float x) { return x * __builtin_amdgcn_rcpf(1.0f + __expf(-x)); }
#define LDS_WAIT() asm volatile("s_waitcnt lgkmcnt(0)" ::: "memory")

namespace pg8 {
constexpr int BM = 256, BK = 64, HALF = 128, HTB = HALF * BK * 2, STAGE_BYTES = 8 * HTB, NXCD = 8, WGM = 8;
__device__ __forceinline__ int lds_byte(int r, int c) { const int st = (r >> 4) * 2 + (c >> 5), rr = r & 15, cc = c & 31, ob = rr * 64 + cc * 2; return st * 1024 + (ob ^ (((ob >> 9) & 1) << 5)); }
__device__ __forceinline__ void stage_rc(int b, int& R, int& C) { const int st = b / 1024, sb = b % 1024, swz = sb ^ (((sb >> 9) & 1) << 5); R = (st >> 1) * 16 + swz / 64; C = (st & 1) * 32 + (swz % 64) / 2; }
__device__ __forceinline__ int perm32(int rho) { const int n = rho >> 4, i = rho & 15; return 8 * (i >> 2) + 4 * n + (i & 3); }
struct Unit { int pm, pn; };
struct Gemm { const bf16_t* A; const bf16_t* Bt; int M, N, K, lda, ldb; };
struct StaticOrder {
    int nM, nN, nwg, G, c;
    __device__ __forceinline__ void init(int M, int N, int G_, int c_) { nM = M / BM; nN = N / BM; nwg = nM * nN; G = G_; c = c_; }
    __device__ __forceinline__ bool next(int i, Unit& u) const {
        const long L = (long)i * G + c; if (L >= nwg) return false;
        int wgid = (int)L; { const int q = nwg / NXCD, r = nwg % NXCD, xcd = wgid % NXCD, off = wgid / NXCD; wgid = (xcd < r ? xcd * (q + 1) : r * (q + 1) + (xcd - r) * q) + off; }
        const int nig = WGM * nN, gid = wgid / nig, fm = gid * WGM, gsz = (nM - fm) < WGM ? (nM - fm) : WGM;
        u.pm = fm + ((wgid % nig) % gsz); u.pn = (wgid % nig) / gsz; return true;
    }
};

template <class Epi>
__device__ __forceinline__ void gemm_phase(LAS unsigned char* lds, const Gemm g, const StaticOrder& S, const Epi& E) {
    int tid_ = threadIdx.x; asm volatile("" : "+v"(tid_));
    const int tid = tid_, wid = __builtin_amdgcn_readfirstlane(tid >> 6), lane = tid & 63, wr = wid >> 2, wc = wid & 3, fr = lane & 15, fq = lane >> 4;
    const int K = g.K, nt = K / BK;
    unsigned voffA[2], voffB[2];
#pragma unroll
    for (int i = 0; i < 2; ++i) { int R, C; stage_rc(tid * 16 + i * 8192, R, C); const int Rb = Epi::PERM ? ((R & ~31) + perm32(R & 31)) : R;
        voffA[i] = (unsigned)(R * g.lda + C) * 2u; voffB[i] = (unsigned)(Rb * g.ldb + C) * 2u; }
    const size_t kstep = (size_t)(BK * 2);
    const size_t hstepA = (size_t)HALF * g.lda * 2, hstepB = (size_t)HALF * g.ldb * 2;
    const size_t tstepA = 2 * hstepA, tstepB = 2 * hstepB;
    const unsigned ldsw = (unsigned)wid * 1024u;
    const int aoff = lds_byte(wr * 64 + fr, fq * 8), boff = lds_byte(wc * 32 + fr, fq * 8);
#define PG8_SA(b, h) (((b) * 2 + (h)) * HTB)
#define PG8_SB(b, h) ((4 + (b) * 2 + (h)) * HTB)
#define PG8_STAGE(bufoff, gbase, voff) do { _Pragma("unroll") for (int _i = 0; _i < 2; ++_i) \
        __builtin_amdgcn_global_load_lds((const unsigned*)((const char*)(gbase) + (voff)[_i]), (LAS unsigned*)(lds + (bufoff) + ldsw + _i * 8192), 16, 0, 0); } while (0)
#define PG8_LDA(dst, b, h) do { _Pragma("unroll") for (int m = 0; m < 4; ++m) _Pragma("unroll") for (int k = 0; k < 2; ++k) dst[m][k] = *(const LAS bf16x8*)(lds + PG8_SA(b, h) + aoff + m * 2048 + k * 1024); } while (0)
#define PG8_LDB(dst, b, h) do { _Pragma("unroll") for (int n = 0; n < 2; ++n) _Pragma("unroll") for (int k = 0; k < 2; ++k) dst[n][k] = *(const LAS bf16x8*)(lds + PG8_SB(b, h) + boff + n * 2048 + k * 1024); } while (0)
#define PG8_MMA(ai, bj, At, Bt) do { __builtin_amdgcn_s_setprio(1); _Pragma("unroll") for (int m = 0; m < 4; ++m) _Pragma("unroll") for (int n = 0; n < 2; ++n) _Pragma("unroll") for (int k = 0; k < 2; ++k) \
        acc[ai][bj][m][n] = __builtin_amdgcn_mfma_f32_16x16x32_bf16(Bt[n][k], At[m][k], acc[ai][bj][m][n], 0, 0, 0); __builtin_amdgcn_s_setprio(0); } while (0)
#define PG8_WAIT_V(n) asm volatile("s_waitcnt vmcnt(" #n ")" ::: "memory")
#define PG8_WAIT_L(n) asm volatile("s_waitcnt lgkmcnt(" #n ")" ::: "memory")
#define PG8_BAR __builtin_amdgcn_s_barrier()
#define PG8_SCHED __builtin_amdgcn_sched_barrier(0)
    Unit cur, nxt; int ui = 0;
    if (!S.next(0, cur)) return;
    f32x4 acc[2][2][4][2];
#pragma unroll
    for (int a = 0; a < 2; ++a)
#pragma unroll
        for (int b = 0; b < 2; ++b)
#pragma unroll
            for (int m = 0; m < 4; ++m)
#pragma unroll
                for (int n = 0; n < 2; ++n) acc[a][b][m][n] = (f32x4){0.f, 0.f, 0.f, 0.f};
    bf16x8 At[4][2], B0[2][2], B1[2][2];
    const char* cA = (const char*)g.A + (size_t)cur.pm * tstepA; const char* cB = (const char*)g.Bt + (size_t)cur.pn * tstepB;
    PG8_STAGE(PG8_SB(0, 0), cB, voffB); PG8_STAGE(PG8_SA(0, 0), cA, voffA); PG8_STAGE(PG8_SB(0, 1), cB + hstepB, voffB); PG8_STAGE(PG8_SA(0, 1), cA + hstepA, voffA);
    if (wr == 1) PG8_BAR;
    PG8_WAIT_V(4); PG8_BAR;
    PG8_STAGE(PG8_SB(1, 0), cB + kstep, voffB); PG8_STAGE(PG8_SA(1, 0), cA + kstep, voffA); PG8_STAGE(PG8_SB(1, 1), cB + hstepB + kstep, voffB);
    PG8_WAIT_V(6); PG8_BAR;
    for (;;) {
        const bool has_next = S.next(ui + 1, nxt);
        const char* nA = has_next ? (const char*)g.A + (size_t)nxt.pm * tstepA : cA; const char* nB = has_next ? (const char*)g.Bt + (size_t)nxt.pn * tstepB : cB;
        for (int t = 0; t < nt; t += 2) {
            const bool last = (t == nt - 2);
            const char* a1 = cA + (size_t)(t + 1) * kstep;
            const char* a2 = last ? nA : cA + (size_t)(t + 2) * kstep; const char* b2 = last ? nB : cB + (size_t)(t + 2) * kstep;
            const char* a3 = a2 + kstep; const char* b3 = b2 + kstep;
            PG8_LDB(B0, 0, 0); PG8_SCHED; PG8_LDA(At, 0, 0); PG8_STAGE(PG8_SA(1, 1), a1 + hstepA, voffA);
            PG8_WAIT_L(8); PG8_BAR; PG8_WAIT_L(0); PG8_MMA(0, 0, At, B0); PG8_BAR; PG8_SCHED;
            PG8_LDB(B1, 0, 1); PG8_STAGE(PG8_SB(0, 0), b2, voffB);
            PG8_BAR; PG8_WAIT_L(0); PG8_MMA(0, 1, At, B1); PG8_BAR;
            PG8_LDA(At, 0, 1); PG8_STAGE(PG8_SA(0, 0), a2, voffA);
            PG8_BAR; PG8_WAIT_L(0); PG8_MMA(1, 0, At, B0); PG8_BAR; PG8_SCHED;
            PG8_STAGE(PG8_SB(0, 1), b2 + hstepB, voffB);
            PG8_WAIT_V(6); PG8_BAR; PG8_MMA(1, 1, At, B1); PG8_BAR;
            PG8_LDB(B0, 1, 0); PG8_SCHED; PG8_LDA(At, 1, 0); PG8_STAGE(PG8_SA(0, 1), a2 + hstepA, voffA);
            PG8_WAIT_L(8); PG8_BAR; PG8_WAIT_L(0); PG8_MMA(0, 0, At, B0); PG8_BAR; PG8_SCHED;
            PG8_LDB(B1, 1, 1); PG8_STAGE(PG8_SB(1, 0), b3, voffB);
            PG8_BAR; PG8_WAIT_L(0); PG8_MMA(0, 1, At, B1); PG8_BAR;
            PG8_LDA(At, 1, 1); PG8_STAGE(PG8_SA(1, 0), a3, voffA);
            PG8_BAR; PG8_WAIT_L(0); PG8_MMA(1, 0, At, B0); PG8_BAR; PG8_SCHED;
            PG8_STAGE(PG8_SB(1, 1), b3 + hstepB, voffB);
            PG8_WAIT_V(6); PG8_BAR; PG8_MMA(1, 1, At, B1); PG8_BAR;
        }
        E(acc, cur, wr, wc, fr, fq);
        if (!has_next) break;
#pragma unroll
        for (int a = 0; a < 2; ++a)
#pragma unroll
            for (int b = 0; b < 2; ++b)
#pragma unroll
                for (int m = 0; m < 4; ++m)
#pragma unroll
                    for (int n = 0; n < 2; ++n) acc[a][b][m][n] = (f32x4){0.f, 0.f, 0.f, 0.f};
        cur = nxt; cA = nA; cB = nB; ++ui;
    }
    PG8_WAIT_V(0);
    if (wr == 0) PG8_BAR;
    PG8_BAR;
#undef PG8_SA
#undef PG8_SB
#undef PG8_STAGE
#undef PG8_LDA
#undef PG8_LDB
#undef PG8_MMA
#undef PG8_WAIT_V
#undef PG8_WAIT_L
#undef PG8_BAR
#undef PG8_SCHED
}
}
using pg8::Unit;

struct Epi1 {
    static constexpr bool PERM = true;
    bf16_t* U;
    __device__ __forceinline__ void operator()(const f32x4 (&acc)[2][2][4][2], const Unit& u, int wr, int wc, int fr, int fq) const {
        const int row0 = u.pm * 256 + wr * 64 + fr, col0 = u.pn * 256 + wc * 32 + 8 * fq;
#pragma unroll
        for (int bj = 0; bj < 2; ++bj) {
            const int c = col0 + bj * 128;
            const int act = (c < C_GF) ? 0 : (c < C_SH) ? 1 : (c < C_GR) ? 0 : (c < C_MG) ? 1 : 2;
#pragma unroll
            for (int ai = 0; ai < 2; ++ai)
#pragma unroll
                for (int m = 0; m < 4; ++m) {
                    f32x4 v0 = acc[ai][bj][m][0], v1 = acc[ai][bj][m][1];
                    if (act == 1) {
#pragma unroll
                        for (int j = 0; j < 4; ++j) { v0[j] = siluf_(v0[j]); v1[j] = siluf_(v1[j]); }
                    } else if (act == 2) {
#pragma unroll
                        for (int j = 0; j < 4; ++j) { v0[j] = sigmoidf_(v0[j]); v1[j] = sigmoidf_(v1[j]); }
                    }
                    u32x4 w; w.x = pk2(v0[0], v0[1]); w.y = pk2(v0[2], v0[3]); w.z = pk2(v1[0], v1[1]); w.w = pk2(v1[2], v1[3]);
                    *(u32x4*)(U + (size_t)(row0 + ai * 128 + m * 16) * LDU + c) = w;
                }
        }
    }
};
template <int second> struct Epi2 {
    static constexpr bool PERM = true;
    bf16_t* U;
    __device__ __forceinline__ void operator()(const f32x4 (&acc)[2][2][4][2], const Unit& u, int wr, int wc, int fr, int fq) const {
        const int row0 = u.pm * 256 + wr * 64 + fr, col0 = u.pn * 256 + wc * 32 + 8 * fq;
#pragma unroll
        for (int bj = 0; bj < 2; ++bj) {
            const int c = col0 + bj * 128;
#pragma unroll
            for (int ai = 0; ai < 2; ++ai)
#pragma unroll
                for (int m = 0; m < 4; ++m) {
                    bf16_t* rowp = U + (size_t)(row0 + ai * 128 + m * 16) * LDU;
                    const u32x4 gw = *(const u32x4*)(rowp + C_MG + (second ? 1024 : 0) + c);
                    const f32x4 v0 = acc[ai][bj][m][0], v1 = acc[ai][bj][m][1];
                    float o[8];
                    o[0] = v0[0] * bflo(gw.x); o[1] = v0[1] * bfhi(gw.x); o[2] = v0[2] * bflo(gw.y); o[3] = v0[3] * bfhi(gw.y);
                    o[4] = v1[0] * bflo(gw.z); o[5] = v1[1] * bfhi(gw.z); o[6] = v1[2] * bflo(gw.w); o[7] = v1[3] * bfhi(gw.w);
                    if (second) {
                        const u32x4 pw = *(const u32x4*)(rowp + C_MERGED + c);
                        o[0] += bflo(pw.x); o[1] += bfhi(pw.x); o[2] += bflo(pw.y); o[3] += bfhi(pw.y);
                        o[4] += bflo(pw.z); o[5] += bfhi(pw.z); o[6] += bflo(pw.w); o[7] += bfhi(pw.w);
                    }
                    u32x4 w; w.x = pk2(o[0], o[1]); w.y = pk2(o[2], o[3]); w.z = pk2(o[4], o[5]); w.w = pk2(o[6], o[7]);
                    *(u32x4*)(rowp + C_MERGED + c) = w;
                    asm volatile("" ::: "memory");
                }
        }
    }
};
struct Epi3 {
    static constexpr bool PERM = false;
    const float* xp; const float* xs; const float* modf; float* out;
    __device__ __forceinline__ void operator()(const f32x4 (&acc)[2][2][4][2], const Unit& u, int wr, int wc, int fr, int fq) const {
        const int row0 = u.pm * 256 + wr * 64 + fr, col0 = u.pn * 256 + wc * 32 + 4 * fq;
#pragma unroll
        for (int ai = 0; ai < 2; ++ai)
#pragma unroll
            for (int m = 0; m < 4; ++m) {
                const int row = row0 + ai * 128 + m * 16;
                const int set = row < NTOK_C ? 0 : 1 + ((row - NTOK_C) >> 12);
                const float* xr = row < NTOK_C ? xp + (size_t)row * DM : xs + (size_t)(row - NTOK_C) * DM;
                const float* gt = modf + set * 3072 + 2048;
#pragma unroll
                for (int bj = 0; bj < 2; ++bj)
#pragma unroll
                    for (int n = 0; n < 2; ++n) {
                        const int c = col0 + bj * 128 + n * 16;
                        const f32x4 xv = *(const f32x4*)(xr + c), gv = *(const f32x4*)(gt + c);
                        *(f32x4*)(out + (size_t)row * DM + c) = xv + gv * acc[ai][bj][m][n];
                    }
            }
    }
};

template <int MT, int NT, int KS, int UNR = 1>
__device__ __forceinline__ void wave_mma(const bf16_t* const (&ap)[MT], const bf16_t* const (&bp)[NT], f32x4 (&acc)[MT][NT], int fq) {
#pragma unroll UNR
    for (int ks = 0; ks < KS; ++ks) {
        bf16x8 av[MT], bv[NT];
#pragma unroll
        for (int mi = 0; mi < MT; ++mi) av[mi] = *(const bf16x8*)(ap[mi] + ks * 32 + fq * 8);
#pragma unroll
        for (int ni = 0; ni < NT; ++ni) bv[ni] = *(const bf16x8*)(bp[ni] + ks * 32 + fq * 8);
#pragma unroll
        for (int mi = 0; mi < MT; ++mi)
#pragma unroll
            for (int ni = 0; ni < NT; ++ni) acc[mi][ni] = __builtin_amdgcn_mfma_f32_16x16x32_bf16(av[mi], bv[ni], acc[mi][ni], 0, 0, 0);
    }
}
template <int MT, int NT, int KS, int LDB, int UNR = 1>
__device__ __forceinline__ void wave_mma_lb(const bf16_t* const (&ap)[MT], const LAS bf16_t* bl, f32x4 (&acc)[MT][NT], int fr, int fq) {
#pragma unroll UNR
    for (int ks = 0; ks < KS; ++ks) {
        bf16x8 av[MT], bv[NT];
#pragma unroll
        for (int mi = 0; mi < MT; ++mi) av[mi] = *(const bf16x8*)(ap[mi] + ks * 32 + fq * 8);
#pragma unroll
        for (int ni = 0; ni < NT; ++ni) bv[ni] = *(const LAS bf16x8*)(bl + (16 * ni + fr) * LDB + ks * 32 + fq * 8);
#pragma unroll
        for (int mi = 0; mi < MT; ++mi)
#pragma unroll
            for (int ni = 0; ni < NT; ++ni) acc[mi][ni] = __builtin_amdgcn_mfma_f32_16x16x32_bf16(av[mi], bv[ni], acc[mi][ni], 0, 0, 0);
    }
}
template <int LDB>
__device__ __forceinline__ void stage_table(LAS bf16_t* dst, const bf16_t* src, int rows, int cols) {
    const int per = cols / 8;
    for (int i = threadIdx.x; i < rows * per; i += 512) { const int r = i / per, c8 = i % per; *(LAS u32x4*)(dst + r * LDB + c8 * 8) = *(const u32x4*)(src + (size_t)r * cols + c8 * 8); }
}
__device__ __forceinline__ void st4bf(bf16_t* p, const f32x4 v) { u32x2 w; w.x = pk2(v[0], v[1]); w.y = pk2(v[2], v[3]); *(u32x2*)p = w; }

struct Ctx {
    const Args& a; LAS unsigned char* lds; int tid, lane, wv, gw, ngw;
};

__device__ __forceinline__ void transpose_item(const float* W, int K, int N, bf16_t* WT, LAS float* scr, int item, int lane) {
    const int nblk = N / 32, kb = item / nblk, nb = item % nblk, k0 = 64 * kb, n0 = 32 * nb;
#pragma unroll 8
    for (int i = 0; i < 32; ++i) { const int kk = 2 * i + (lane >> 5); scr[kk * 33 + (lane & 31)] = W[(size_t)(k0 + kk) * N + n0 + (lane & 31)]; }
    LDS_WAIT();
    const int c = lane & 7;
#pragma unroll
    for (int j = 0; j < 4; ++j) { const int n = (lane >> 3) + 8 * j; const LAS float* s = scr + (8 * c) * 33 + n;
        u32x4 o; o.x = pk2(s[0 * 33], s[1 * 33]); o.y = pk2(s[2 * 33], s[3 * 33]); o.z = pk2(s[4 * 33], s[5 * 33]); o.w = pk2(s[6 * 33], s[7 * 33]);
        *(u32x4*)(WT + (size_t)(n0 + n) * K + k0 + 8 * c) = o; }
    LDS_WAIT();
}
__device__ __forceinline__ void phase0(const Args& a, LAS unsigned char* lds) {
    const int tid = threadIdx.x, lane = tid & 63, wv = tid >> 6, gw = blockIdx.x * 8 + wv, ngw = gridDim.x * 8;
    unsigned char* ws = a.ws;
    for (int cb = blockIdx.x; cb < 256; cb += gridDim.x) {
        LAS float* sv = (LAS float*)(lds + 8 * 8448);
        LAS float* pr = sv + 3072;
        __syncthreads();
        for (int i = tid; i < 3072; i += 512) { const int v = i >> 10, k = i & 1023; sv[i] = siluf_((v == 0) ? a.in[4][k] : a.in[3][(v - 1) * 1024 + k]); }
        __syncthreads();
        const int kk = tid >> 2, cq = tid & 3, col = cb * 12 + 3 * cq;
        float acc[3][3];
#pragma unroll
        for (int v = 0; v < 3; ++v)
#pragma unroll
            for (int j = 0; j < 3; ++j) acc[v][j] = 0.f;
#pragma unroll
        for (int i = 0; i < 8; ++i) {
            const int k = kk + 128 * i;
            const float* w = a.in[6] + (size_t)k * 3072 + col;
            const float w0 = w[0], w1 = w[1], w2 = w[2];
#pragma unroll
            for (int v = 0; v < 3; ++v) { const float sk = sv[v * 1024 + k]; acc[v][0] += sk * w0; acc[v][1] += sk * w1; acc[v][2] += sk * w2; }
        }
#pragma unroll
        for (int v = 0; v < 3; ++v)
#pragma unroll
            for (int j = 0; j < 3; ++j) { float x = acc[v][j]; x += __shfl_xor(x, 4); x += __shfl_xor(x, 8); x += __shfl_xor(x, 16); x += __shfl_xor(x, 32); acc[v][j] = x; }
        if (lane < 4) {
#pragma unroll
            for (int v = 0; v < 3; ++v)
#pragma unroll
                for (int j = 0; j < 3; ++j) pr[(wv * 4 + lane) * 9 + v * 3 + j] = acc[v][j];
        }
        __syncthreads();
        if (tid < 36) {
            const int q = tid / 9, r = tid % 9, v = r / 3, j = r % 3;
            float sum = 0.f;
#pragma unroll
            for (int w8 = 0; w8 < 8; ++w8) sum += pr[(w8 * 4 + q) * 9 + r];
            const int c = cb * 12 + 3 * q + j;
            ((float*)(ws + WS_MODF))[v * 3072 + c] = sum + a.in[7][c];
        }
    }
    __syncthreads();
}
__device__ __forceinline__ void phase0_conv(const Args& a, LAS unsigned char* lds) {
    const int tid = threadIdx.x, lane = tid & 63, wv = tid >> 6, gw = blockIdx.x * 8 + wv, ngw = gridDim.x * 8;
    unsigned char* ws = a.ws;
    LAS float* scr = (LAS float*)(lds + wv * 8448);
    for (int it = gw; it < 16 * 228; it += ngw) transpose_item(a.in[8], 1024, 7296, (bf16_t*)(ws + WS_WINT), scr, it, lane);
    u32x4* padp = (u32x4*)((bf16_t*)(ws + WS_WINT) + (size_t)7296 * 1024);
    for (int i = blockIdx.x * 512 + tid; i < 128 * 1024 / 8; i += gridDim.x * 512) padp[i] = (u32x4){0u, 0u, 0u, 0u};
}
__device__ __forceinline__ void conv_rest(const Args& a, LAS unsigned char* lds, int wb, int nwb) {
    const int tid = threadIdx.x, lane = tid & 63, wv = tid >> 6, gw = wb * 8 + wv, ngw = nwb * 8;
    unsigned char* ws = a.ws;
    {
        LAS float* scr = (LAS float*)(lds + wv * 8448);
        constexpr int I_PF = 8 * 32, I_PR = 16 * 32, I_OUT = 16 * 32;
        for (int it = gw; it < I_PF + I_PR + I_OUT; it += ngw) {
            int r = it;
            if (r < I_PF) { transpose_item(a.in[19], 512, 1024, (bf16_t*)(ws + WS_WPF), scr, r, lane); continue; } r -= I_PF;
            if (r < I_PR) { transpose_item(a.in[20], 1024, 1024, (bf16_t*)(ws + WS_WPR), scr, r, lane); continue; } r -= I_PR;
            transpose_item(a.in[21], 1024, 1024, (bf16_t*)(ws + WS_WOUT), scr, r, lane);
        }
    }
    {
        bf16_t* wt = (bf16_t*)(ws + WS_WUPT); bf16_t* at = (bf16_t*)(ws + WS_AUPT);
        for (int i = wb * 512 + tid; i < 2 * 1024 * 64; i += nwb * 512) {
            const int rk = i & 63, C = (i >> 6) & 1023, d = i >> 16;
            wt[i] = (bf16_t)f2bf(a.in[11][(size_t)(d * 64 + rk) * 1024 + C]);
            at[i] = (bf16_t)f2bf(a.in[13][(size_t)(d * 64 + rk) * 1024 + C]);
        }
    }
    {
        bf16_t* tab = (bf16_t*)(ws + WS_TAB);
        for (int i = wb * 512 + tid; i < T_END; i += nwb * 512) {
            float val;
            if (i < T_WB64) {
                const int n = i >> 7, c = i & 127, part = n >> 7, kc = n & 127, m = (kc * c) & 127;
                const float x = (float)m * (1.0f / 64.0f);
                val = part ? -sinpif(x) : cospif(x);
            } else if (i < T_WC64) {
                const int j = i - T_WB64, n = j >> 7, k = j & 127, pp = n >> 6, k1 = n & 63, p = k >> 6, t1 = k & 63, m = (k1 * t1) & 63;
                const float x = (float)m * (1.0f / 32.0f), cs = cospif(x), sn = sinpif(x);
                val = (pp == p) ? cs : (pp == 0 ? sn : -sn);
            } else if (i < T_WB16) {
                const int j = i - T_WC64, k2 = j >> 7, k = j & 127, p = k >> 6, t2 = k & 63, m = (k2 * t2) & 63;
                const float x = (float)m * (1.0f / 32.0f);
                val = p ? sinpif(x) : cospif(x);
            } else if (i < T_WC16) {
                const int j = i - T_WB16, n = j >> 5, k = j & 31, pp = n >> 4, k1 = n & 15, p = k >> 4, t1 = k & 15, m = (k1 * t1) & 15;
                const float x = (float)m * (1.0f / 8.0f), cs = cospif(x), sn = sinpif(x);
                val = (pp == p) ? cs : (pp == 0 ? sn : -sn);
            } else {
                const int j = i - T_WC16, k2 = j >> 5, k = j & 31, p = k >> 4, t2 = k & 15, m = (k2 * t2) & 15;
                const float x = (float)m * (1.0f / 8.0f);
                val = p ? sinpif(x) : cospif(x);
            }
            tab[i] = (bf16_t)f2bf(val);
        }
    }
}

__device__ __forceinline__ void phase1(const Args& a, LAS unsigned char* lds) {
    const int tid = threadIdx.x, lane = tid & 63, wv = tid >> 6, gw = blockIdx.x * 8 + wv, ngw = gridDim.x * 8;
    unsigned char* ws = a.ws;
    LAS float* ml = (LAS float*)lds;
    const float* mf = (const float*)(ws + WS_MODF);
    for (int i = tid; i < 9216; i += 512) ml[i] = mf[i];
    __syncthreads();
    bf16_t* H = (bf16_t*)(ws + WS_H);
    const float* ng = a.in[5];
    for (int row0 = gw; row0 < NTOK; row0 += 3 * ngw) {
        f32x4 v[3][4];
#pragma unroll
        for (int u = 0; u < 3; ++u) {
            const int row = row0 + u * ngw < NTOK ? row0 + u * ngw : row0;
            const float* xr = row < NTOK_C ? a.in[0] + (size_t)row * DM : a.in[1] + (size_t)(row - NTOK_C) * DM;
#pragma unroll
            for (int j = 0; j < 4; ++j) v[u][j] = *(const f32x4*)(xr + lane * 4 + 256 * j);
        }
#pragma unroll
        for (int u = 0; u < 3; ++u) {
            const int row = row0 + u * ngw;
            if (row < NTOK) {
                const int set = row < NTOK_C ? 0 : 1 + ((row - NTOK_C) >> 12);
                float ss = 0.f;
#pragma unroll
                for (int j = 0; j < 4; ++j) ss += (v[u][j][0] * v[u][j][0] + v[u][j][1] * v[u][j][1]) + (v[u][j][2] * v[u][j][2] + v[u][j][3] * v[u][j][3]);
                const float rstd = rsqrtf(wave_sum(ss) * (1.0f / DM) + RMS_EPS);
#pragma unroll
                for (int j = 0; j < 4; ++j) {
                    const int c = lane * 4 + 256 * j;
                    const f32x4 g4 = *(const f32x4*)(ng + c);
                    float o[4];
#pragma unroll
                    for (int e = 0; e < 4; ++e) o[e] = (v[u][j][e] * rstd * g4[e]) * (1.0f + ml[set * 3072 + 1024 + c + e]) + ml[set * 3072 + c + e];
                    u32x2 w; w.x = pk2(o[0], o[1]); w.y = pk2(o[2], o[3]);
                    *(u32x2*)(H + (size_t)row * DM + c) = w;
                }
            }
        }
    }
}

__device__ __forceinline__ void fourier_l1(const Args& a, LAS unsigned char* lds) {
    const int tid = threadIdx.x, lane = tid & 63, wv = tid >> 6, gw = blockIdx.x * 8 + wv, ngw = gridDim.x * 8, fr = lane & 15, fq = lane >> 4;
    unsigned char* ws = a.ws;
    const bf16_t* U = (const bf16_t*)(ws + WS_U);
    const bf16_t* W128 = (const bf16_t*)(ws + WS_TAB) + T_W128;
    bf16_t* Qlat = (bf16_t*)(ws + WS_H);
    bf16_t* Qctx = Qlat + QLAT_ELEMS;
    LAS bf16_t* Wl = (LAS bf16_t*)lds;
    __syncthreads(); stage_table<136>(Wl, W128, 256, 128); __syncthreads();
    for (int wt = gw; wt < 2048 + 1024; wt += ngw) {
        const bf16_t* ap[4]; f32x4 acc[4][4];
#pragma unroll
        for (int mi = 0; mi < 4; ++mi)
#pragma unroll
            for (int ni = 0; ni < 4; ++ni) acc[mi][ni] = (f32x4){0.f, 0.f, 0.f, 0.f};
        if (wt < 2048) {
            const int nb = wt & 3, t2 = (wt >> 2) & 63, bg = wt >> 8, b = bg >> 2, g = bg & 3;
#pragma unroll
            for (int mi = 0; mi < 4; ++mi) ap[mi] = U + (size_t)(NTOK_C + b * 4096 + 64 * (16 * mi + fr) + t2) * LDU + C_XF + g * 128;
            wave_mma_lb<4, 4, 4, 136, 2>(ap, Wl + (nb * 64) * 136, acc, fr, fq);
#pragma unroll
            for (int mi = 0; mi < 4; ++mi)
#pragma unroll
                for (int ni = 0; ni < 4; ++ni) {
                    const int cn = nb * 64 + 16 * ni + fr, part = cn >> 7, kc = cn & 127;
                    st4bf(Qlat + ((((size_t)(bg * 128 + kc) * 64 + t2) * 2 + part) * 64 + 16 * mi + 4 * fq), acc[mi][ni]);
                }
        } else {
            const int w2 = wt - 2048, nb = w2 & 3, tg = (w2 >> 2) & 3, bg = w2 >> 4, b = bg >> 2, g = bg & 3;
#pragma unroll
            for (int mi = 0; mi < 4; ++mi) ap[mi] = U + (size_t)(b * 256 + 16 * fr + (tg * 4 + mi)) * LDU + C_XF + g * 128;
            wave_mma_lb<4, 4, 4, 136, 2>(ap, Wl + (nb * 64) * 136, acc, fr, fq);
#pragma unroll
            for (int mi = 0; mi < 4; ++mi)
#pragma unroll
                for (int ni = 0; ni < 4; ++ni) {
                    const int cn = nb * 64 + 16 * ni + fr, part = cn >> 7, kc = cn & 127, t2 = tg * 4 + mi;
                    st4bf(Qctx + ((((size_t)(bg * 128 + kc) * 16 + t2) * 2 + part) * 16 + 4 * fq), acc[mi][ni]);
                }
        }
    }
}
__device__ __forceinline__ void fourier_l2(const Args& a, LAS unsigned char* lds) {
    const int tid = threadIdx.x, lane = tid & 63, wv = tid >> 6, gw = blockIdx.x * 8 + wv, ngw = gridDim.x * 8, fr = lane & 15, fq = lane >> 4;
    unsigned char* ws = a.ws;
    const bf16_t* tab = (const bf16_t*)(ws + WS_TAB);
    const bf16_t* Qlat = (const bf16_t*)(ws + WS_H);
    const bf16_t* Qctx = Qlat + QLAT_ELEMS;
    bf16_t* Rlat = (bf16_t*)(ws + WS_RLAT);
    bf16_t* Rctx = (bf16_t*)(ws + WS_WINT);
    LAS bf16_t* Bl64 = (LAS bf16_t*)lds;
    LAS bf16_t* Bl16 = Bl64 + 128 * 136;
    __syncthreads(); stage_table<136>(Bl64, tab + T_WB64, 128, 128); stage_table<40>(Bl16, tab + T_WB16, 32, 32); __syncthreads();
    for (int wt = gw; wt < 2048 + 2048; wt += ngw) {
        if (wt < 2048) {
            const int bgkc = wt >> 1, mh = wt & 1;
            const bf16_t* ap[2]; f32x4 acc[2][8];
#pragma unroll
            for (int mi = 0; mi < 2; ++mi)
#pragma unroll
                for (int ni = 0; ni < 8; ++ni) acc[mi][ni] = (f32x4){0.f, 0.f, 0.f, 0.f};
#pragma unroll
            for (int mi = 0; mi < 2; ++mi) ap[mi] = Qlat + ((size_t)bgkc * 64 + 32 * mh + 16 * mi + fr) * 128;
            wave_mma_lb<2, 8, 4, 136>(ap, Bl64, acc, fr, fq);
#pragma unroll
            for (int mi = 0; mi < 2; ++mi)
#pragma unroll
                for (int ni = 0; ni < 4; ++ni) {
                    const int k1 = 16 * ni + fr;
                    f32x4 orr, oi;
#pragma unroll
                    for (int r = 0; r < 4; ++r) {
                        const int t2 = 32 * mh + 16 * mi + 4 * fq + r, m = (t2 * k1) & 4095;
                        const float x = (float)m * (1.0f / 2048.0f), cs = cospif(x), sn = sinpif(x);
                        const float br = acc[mi][ni][r], bi = acc[mi][ni + 4][r];
                        orr[r] = br * cs + bi * sn; oi[r] = bi * cs - br * sn;
                    }
                    bf16_t* dst = Rlat + ((size_t)bgkc * 64 + k1) * 128 + 32 * mh + 16 * mi + 4 * fq;
                    st4bf(dst, orr); st4bf(dst + 64, oi);
                }
        } else {
            const int bgkc0 = (wt - 2048) * 4;
            const bf16_t* ap[4]; f32x4 acc[4][2];
#pragma unroll
            for (int mi = 0; mi < 4; ++mi)
#pragma unroll
                for (int ni = 0; ni < 2; ++ni) acc[mi][ni] = (f32x4){0.f, 0.f, 0.f, 0.f};
#pragma unroll
            for (int mi = 0; mi < 4; ++mi) ap[mi] = Qctx + ((size_t)(bgkc0 + mi) * 16 + fr) * 32;
            wave_mma_lb<4, 2, 1, 40>(ap, Bl16, acc, fr, fq);
#pragma unroll
            for (int mi = 0; mi < 4; ++mi) {
                const int k1 = fr;
                f32x4 orr, oi;
#pragma unroll
                for (int r = 0; r < 4; ++r) {
                    const int t2 = 4 * fq + r, m = (t2 * k1) & 255;
                    const float x = (float)m * (1.0f / 128.0f), cs = cospif(x), sn = sinpif(x);
                    const float br = acc[mi][0][r], bi = acc[mi][1][r];
                    orr[r] = br * cs + bi * sn; oi[r] = bi * cs - br * sn;
                }
                bf16_t* dst = Rctx + ((size_t)(bgkc0 + mi) * 16 + k1) * 32 + 4 * fq;
                st4bf(dst, orr); st4bf(dst + 16, oi);
            }
        }
    }
}
__device__ __forceinline__ void fourier_l3(const Args& a, LAS unsigned char* lds) {
    const int skipb = (gridDim.x >= 128 && gridDim.x < 256) ? 64 : 0;
    if ((int)blockIdx.x < skipb) return;
    const int tid = threadIdx.x, lane = tid & 63, wv = tid >> 6, gw = ((int)blockIdx.x - skipb) * 8 + wv, ngw = ((int)gridDim.x - skipb) * 8, fr = lane & 15, fq = lane >> 4;
    unsigned char* ws = a.ws;
    const bf16_t* tab = (const bf16_t*)(ws + WS_TAB);
    const bf16_t* Rlat = (const bf16_t*)(ws + WS_RLAT);
    const bf16_t* Rctx = (const bf16_t*)(ws + WS_WINT);
    bf16_t* U = (bf16_t*)(ws + WS_U);
    LAS bf16_t* Cl64 = (LAS bf16_t*)lds;
    LAS bf16_t* Cl16 = Cl64 + 64 * 136;
    stage_table<136>(Cl64, tab + T_WC64, 64, 128); stage_table<40>(Cl16, tab + T_WC16, 16, 32); __syncthreads();
    for (int wt = gw; wt < 1024 + 2048; wt += ngw) {
        if (wt < 1024) {
            const int kb = wt & 1, k1 = (wt >> 1) & 63, bg = wt >> 7, b = bg >> 2, g = bg & 3;
            const bf16_t* ap[4]; f32x4 acc[4][4];
#pragma unroll
            for (int mi = 0; mi < 4; ++mi)
#pragma unroll
                for (int ni = 0; ni < 4; ++ni) acc[mi][ni] = (f32x4){0.f, 0.f, 0.f, 0.f};
#pragma unroll
            for (int mi = 0; mi < 4; ++mi) ap[mi] = Rlat + ((size_t)(bg * 128 + kb * 64 + 16 * mi + fr) * 64 + k1) * 128;
            wave_mma_lb<4, 4, 4, 136, 2>(ap, Cl64, acc, fr, fq);
            const float scale = 0.0013810679320049757f;
#pragma unroll
            for (int mi = 0; mi < 4; ++mi)
#pragma unroll
                for (int ni = 0; ni < 4; ++ni) {
                    const int k2 = 16 * ni + fr, kt = k1 + 64 * k2, row = NTOK_C + b * 4096 + kt, col = g * 128 + kb * 64 + 16 * mi + 4 * fq;
                    bf16_t* rp = U + (size_t)row * LDU;
                    const u32x2 gt = *(const u32x2*)(rp + C_GF + col);
                    f32x4 o; o[0] = acc[mi][ni][0] * scale * bflo(gt.x); o[1] = acc[mi][ni][1] * scale * bfhi(gt.x);
                    o[2] = acc[mi][ni][2] * scale * bflo(gt.y); o[3] = acc[mi][ni][3] * scale * bfhi(gt.y);
                    st4bf(rp + C_XF + col, o);
                }
        } else {
            const int w2 = wt - 1024, kb = w2 & 1, k1 = (w2 >> 1) & 15, bg = w2 >> 5, b = bg >> 2, g = bg & 3;
            const bf16_t* ap[4]; f32x4 acc[4][1];
#pragma unroll
            for (int mi = 0; mi < 4; ++mi) acc[mi][0] = (f32x4){0.f, 0.f, 0.f, 0.f};
#pragma unroll
            for (int mi = 0; mi < 4; ++mi) ap[mi] = Rctx + ((size_t)(bg * 128 + kb * 64 + 16 * mi + fr) * 16 + k1) * 32;
            wave_mma_lb<4, 1, 1, 40>(ap, Cl16, acc, fr, fq);
            const float scale = 0.005524271728019903f;
#pragma unroll
            for (int mi = 0; mi < 4; ++mi) {
                const int k2 = fr, kt = k1 + 16 * k2, row = b * 256 + kt, col = g * 128 + kb * 64 + 16 * mi + 4 * fq;
                bf16_t* rp = U + (size_t)row * LDU;
                const u32x2 gt = *(const u32x2*)(rp + C_GF + col);
                f32x4 o; o[0] = acc[mi][0][0] * scale * bflo(gt.x); o[1] = acc[mi][0][1] * scale * bfhi(gt.x);
                o[2] = acc[mi][0][2] * scale * bflo(gt.y); o[3] = acc[mi][0][3] * scale * bfhi(gt.y);
                st4bf(rp + C_XF + col, o);
            }
        }
    }
}

__device__ __forceinline__ float sh_mixed(const bf16_t* U, const float* mu, int row, int cs, int lat, int t) {
    int nb; bool valid;
    if (lat) {
        const int d = cs & 3, cg_ = t & 63, rg = t >> 6;
        if (d == 0) { valid = cg_ > 0; nb = row - 1; } else if (d == 1) { valid = cg_ < 63; nb = row + 1; }
        else if (d == 2) { valid = rg > 0; nb = row - 64; } else { valid = rg < 63; nb = row + 64; }
    } else {
        if (cs & 1) { valid = t < 255; nb = row + 1; } else { valid = t > 0; nb = row - 1; }
    }
    const float x = bf2f(U[(size_t)row * LDU + C_SH + cs]);
    const float s = valid ? bf2f(U[(size_t)nb * LDU + C_SH + cs]) : 0.0f;
    return x + mu[cs] * (s - x);
}

constexpr int LDP = 72;
constexpr int GS = 68;
constexpr int SC_X = 0, SC_AGF = 17408, SC_AAK = 17408, SC_ARK = 26624, SC_ARB = 35840, SC_TM = 45056, SC_TW = 54272, SC_AD = 63488,
              SC_AT = 72704, SC_RT = 81920, SC_BT = 91136, SC_KT = 100352, SC_BH = 109568, SC_KH = 118912, SC_VT = 128256, SC_SB = 137600, SC_EGL = 146816, SC_ABA = 147072, SC_PAR = 149632;
constexpr int LDQ = 40;
__device__ __forceinline__ bf16x8 ldfrag(const LAS bf16_t* arr, int row, int ks, int fq) { return *(const LAS bf16x8*)(arr + row * LDP + ks * 32 + fq * 8); }
__device__ __forceinline__ int tskew(int row) { return row * LDP + 8 * (row >> 3); }
__device__ __forceinline__ bf16x8 ldfragT(const LAS bf16_t* arr, int row, int ks, int fq) { return *(const LAS bf16x8*)(arr + tskew(row) + ks * 32 + fq * 8); }
__device__ __forceinline__ void st4lds(LAS bf16_t* p, const f32x4 v) { u32x2 w; w.x = pk2(v[0], v[1]); w.y = pk2(v[2], v[3]); *(LAS u32x2*)p = w; }
#define SBAR() do { asm volatile("s_waitcnt lgkmcnt(0)" ::: "memory"); __builtin_amdgcn_s_barrier(); asm volatile("" ::: "memory"); } while (0)
#define MMA16(a_, b_, c_) (c_) = __builtin_amdgcn_mfma_f32_16x16x32_bf16((a_), (b_), (c_), 0, 0, 0)

__device__ __forceinline__ float bfel(const u32x4 w, int e) { const unsigned x = w[e >> 1]; return (e & 1) ? bfhi(x) : bflo(x); }
__device__ __forceinline__ void mix8(const u32x4 self, const u32x4 (&nb)[4], const bool (&vl)[4], int lat, const f32x4 mu0, const f32x4 mu1, float (&out)[8]) {
#pragma unroll
    for (int e = 0; e < 8; ++e) {
        const float x = bfel(self, e);
        float s;
        if (lat) { const int d = e & 3; s = vl[d] ? bfel(nb[d], e) : 0.f; }
        else { const int d = e & 1; s = vl[d] ? bfel(nb[d], e) : 0.f; }
        const float m = (e < 4) ? mu0[e] : mu1[e - 4];
        out[e] = x + m * (s - x);
    }
}
__device__ __forceinline__ u32x4 pack8(const float (&v)[8]) { u32x4 w; w.x = pk2(v[0], v[1]); w.y = pk2(v[2], v[3]); w.z = pk2(v[4], v[5]); w.w = pk2(v[6], v[7]); return w; }
__device__ __forceinline__ float tanh_fast(float x) { const float e = __expf(2.0f * x); return 1.0f - 2.0f * __builtin_amdgcn_rcpf(e + 1.0f); }

__device__ __forceinline__ void phase_premix(const Args& a) {
    const bf16_t* U = (const bf16_t*)(a.ws + WS_U);
    bf16_t* MIX = (bf16_t*)(a.ws + WS_MIX);
    const float* mu = a.in[9];
    for (int idx = blockIdx.x * 512 + threadIdx.x; idx < NTOK * 16; idx += gridDim.x * 512) {
        const int row = idx >> 4, c0 = (idx & 15) * 8;
        const int lat = row >= NTOK_C, t = lat ? ((row - NTOK_C) & 4095) : (row & 255);
        bool nv[4]; int nrow[4];
        if (lat) { const int cx = t & 63, rg = t >> 6; nv[0] = cx > 0; nv[1] = cx < 63; nv[2] = rg > 0; nv[3] = rg < 63;
            nrow[0] = nv[0] ? row - 1 : row; nrow[1] = nv[1] ? row + 1 : row; nrow[2] = nv[2] ? row - 64 : row; nrow[3] = nv[3] ? row + 64 : row; }
        else { nv[0] = t > 0; nv[1] = t < 255; nv[2] = false; nv[3] = false; nrow[0] = nv[0] ? row - 1 : row; nrow[1] = nv[1] ? row + 1 : row; nrow[2] = row; nrow[3] = row; }
        const u32x4 Ws = *(const u32x4*)(U + (size_t)row * LDU + C_SH + 3072 + c0);
        u32x4 Wn[4];
#pragma unroll
        for (int d = 0; d < 4; ++d) { if (d < 2 || lat) Wn[d] = *(const u32x4*)(U + (size_t)nrow[d] * LDU + C_SH + 3072 + c0); else Wn[d] = Ws; }
        float o[8];
        mix8(Ws, Wn, nv, lat, *(const f32x4*)(mu + 3072 + c0), *(const f32x4*)(mu + 3072 + c0 + 4), o);
        if (c0 < 64) {
#pragma unroll
            for (int e = 0; e < 8; ++e) o[e] = tanh_fast(o[e]);
        }
        *(u32x4*)(MIX + (size_t)row * 128 + c0) = pack8(o);
    }
}

__device__ __forceinline__ void scan_chain(const Args& a, LAS unsigned char* lds, int lat, int b, int h, int dir, float ysc, int cbeg, int cend, int mode) {
    const int tid = threadIdx.x, lane = tid & 63, wv = __builtin_amdgcn_readfirstlane(tid >> 6), fr = lane & 15, fq = lane >> 4;
    const int T = lat ? 4096 : 256, row_base = lat ? NTOK_C + b * 4096 : b * 256;
    const bf16_t* U = (const bf16_t*)(a.ws + WS_U);
    const float* mu = a.in[9];
    LAS float* Gf = (LAS float*)(lds + SC_X); LAS float* AGf = (LAS float*)(lds + SC_AGF); LAS float* Aab = (LAS float*)(lds + SC_X);
    LAS bf16_t* Aak = (LAS bf16_t*)(lds + SC_AAK); LAS bf16_t* Ark = (LAS bf16_t*)(lds + SC_ARK); LAS bf16_t* Arb = (LAS bf16_t*)(lds + SC_ARB);
    LAS bf16_t* Tm = (LAS bf16_t*)(lds + SC_TM); LAS bf16_t* TW = (LAS bf16_t*)(lds + SC_TW); LAS bf16_t* AD = (LAS bf16_t*)(lds + SC_AD);
    LAS bf16_t* PT = TW; LAS bf16_t* UT = AD;
    LAS bf16_t* At = (LAS bf16_t*)(lds + SC_AT); LAS bf16_t* Rt = (LAS bf16_t*)(lds + SC_RT); LAS bf16_t* Bt = (LAS bf16_t*)(lds + SC_BT);
    LAS bf16_t* Kt = (LAS bf16_t*)(lds + SC_KT); LAS bf16_t* BhT = (LAS bf16_t*)(lds + SC_BH); LAS bf16_t* KhT = (LAS bf16_t*)(lds + SC_KH);
    LAS bf16_t* VT = (LAS bf16_t*)(lds + SC_VT); LAS bf16_t* Sb = (LAS bf16_t*)(lds + SC_SB); LAS float* EGL = (LAS float*)(lds + SC_EGL);
    const int nio = wv & 3, mo0 = 2 * (wv >> 2);
    f32x4 Sacc[2];
    {
        const int i = 16 * nio + fr;
#pragma unroll
        for (int mm = 0; mm < 2; ++mm) {
            const int j0 = 16 * (mo0 + mm) + 4 * fq;
            if (mode == 2) { Sacc[mm] = (f32x4){0.f, 0.f, 0.f, 0.f};
#pragma unroll
                for (int r = 0; r < 4; ++r) if (j0 + r == i) Sacc[mm][r] = 1.0f; }
            else if (lat && mode == 0) Sacc[mm] = *(const f32x4*)(a.in[2] + ((((size_t)b * 2 + dir) * 16 + h) * 64 + i) * 64 + j0);
            else Sacc[mm] = (f32x4){0.f, 0.f, 0.f, 0.f};
            st4lds(Sb + i * LDP + j0, Sacc[mm]);
        }
    }
    const int lr_strip = wv & 3;
    const bool lr_lo = wv < 4;
    const int lr_c = h * 64 + 16 * lr_strip + fr;
    const float lr_w0 = a.in[10][dir * 1024 + lr_c], lr_a0 = a.in[12][dir * 1024 + lr_c];
    const bf16_t* lr_bw = (const bf16_t*)(a.ws + WS_WUPT) + ((size_t)dir * 1024 + lr_c) * 64;
    const bf16_t* lr_ba = (const bf16_t*)(a.ws + WS_AUPT) + ((size_t)dir * 1024 + lr_c) * 64;
    u32x4 Rs, Ks, Vs, Rn[4], Kn[4], Vn[4]; bf16x8 Wf[2][4]; int nvm = 0;
    const bf16_t* MIXp = (const bf16_t*)(a.ws + WS_MIX);
    const int nch = cend;
#define SCAN_ISSUE(cidx) do { \
        const int l2_ = threadIdx.x & 63, p2_ = (l2_ >> 3) + 8 * wv, g2_ = l2_ & 7; \
        const int pos_ = (cidx) * 64 + p2_, t_ = dir ? T - 1 - pos_ : pos_, row_ = row_base + t_; \
        int n0_, n1_, n2_, n3_, m_ = 0; \
        if (lat) { const int cx = t_ & 63, rg = t_ >> 6; m_ = (cx > 0 ? 1 : 0) | (cx < 63 ? 2 : 0) | (rg > 0 ? 4 : 0) | (rg < 63 ? 8 : 0); \
            n0_ = (m_ & 1) ? row_ - 1 : row_; n1_ = (m_ & 2) ? row_ + 1 : row_; n2_ = (m_ & 4) ? row_ - 64 : row_; n3_ = (m_ & 8) ? row_ + 64 : row_; } \
        else { m_ = (t_ > 0 ? 1 : 0) | (t_ < 255 ? 2 : 0); n0_ = (m_ & 1) ? row_ - 1 : row_; n1_ = (m_ & 2) ? row_ + 1 : row_; n2_ = row_; n3_ = row_; } \
        nvm = m_; \
        const int colr_ = h * 64 + 8 * g2_; \
        const bf16_t* sp_ = U + (size_t)row_ * LDU + C_SH + colr_; \
        Rs = *(const u32x4*)(sp_); Ks = *(const u32x4*)(sp_ + 1024); Vs = *(const u32x4*)(sp_ + 2048); \
        { const bf16_t* q_ = U + (size_t)n0_ * LDU + C_SH + colr_; Rn[0] = *(const u32x4*)(q_); Kn[0] = *(const u32x4*)(q_ + 1024); Vn[0] = *(const u32x4*)(q_ + 2048); } \
        { const bf16_t* q_ = U + (size_t)n1_ * LDU + C_SH + colr_; Rn[1] = *(const u32x4*)(q_); Kn[1] = *(const u32x4*)(q_ + 1024); Vn[1] = *(const u32x4*)(q_ + 2048); } \
        if (lat) { \
            { const bf16_t* q_ = U + (size_t)n2_ * LDU + C_SH + colr_; Rn[2] = *(const u32x4*)(q_); Kn[2] = *(const u32x4*)(q_ + 1024); Vn[2] = *(const u32x4*)(q_ + 2048); } \
            { const bf16_t* q_ = U + (size_t)n3_ * LDU + C_SH + colr_; Rn[3] = *(const u32x4*)(q_); Kn[3] = *(const u32x4*)(q_ + 1024); Vn[3] = *(const u32x4*)(q_ + 2048); } \
        } else { Rn[2] = Rs; Kn[2] = Ks; Vn[2] = Vs; Rn[3] = Rs; Kn[3] = Ks; Vn[3] = Vs; } \
        _Pragma("unroll") for (int mi_ = 0; mi_ < 4; ++mi_) { \
            const int pw_ = (cidx) * 64 + 16 * mi_ + (l2_ & 15), tw_ = dir ? T - 1 - pw_ : pw_; \
            const bf16_t* wp_ = MIXp + (size_t)(row_base + tw_) * 128 + (((mi_ < 2) == lr_lo) ? 0 : 64) + (l2_ >> 4) * 8; \
            Wf[0][mi_] = *(const bf16x8*)(wp_); Wf[1][mi_] = *(const bf16x8*)(wp_ + 32); } \
    } while (0)
    {
        LAS float* PAR = (LAS float*)(lds + SC_PAR);
        const int tt = threadIdx.x;
        if (tt < 384) { const int w_ = tt >> 6, cc_ = h * 64 + (tt & 63);
            PAR[tt] = (w_ == 0) ? mu[cc_] : (w_ == 1) ? mu[1024 + cc_] : (w_ == 2) ? mu[2048 + cc_] : (w_ == 3) ? a.in[14][cc_] : (w_ == 4) ? a.in[15][cc_] : a.in[16][cc_]; }
    }
    for (int i_ = threadIdx.x; i_ < 32 * 32; i_ += 512) Tm[(i_ >> 5) * LDP + 32 + (i_ & 31)] = (bf16_t)0;
    SCAN_ISSUE(cbeg);
    for (int chunk = cbeg; chunk < nch; ++chunk) {
        int lv_ = threadIdx.x & 63; asm volatile("" : "+v"(lv_));
        const int lane = lv_, fr = lv_ & 15, fq = lv_ >> 4;
        const int tk_p = (lv_ >> 3) + 8 * wv, tk_cg = lv_ & 7;
        const int colr = h * 64 + 8 * tk_cg;
        {
            const int dmi = lr_lo ? 0 : 2, ami = lr_lo ? 2 : 0;
            f32x4 accd[2], acca[2];
#pragma unroll
            for (int mm = 0; mm < 2; ++mm) { accd[mm] = (f32x4){lr_w0, lr_w0, lr_w0, lr_w0}; acca[mm] = (f32x4){lr_a0, lr_a0, lr_a0, lr_a0}; }
#pragma unroll
            for (int ks = 0; ks < 2; ++ks) {
                const bf16x8 bw = *(const bf16x8*)(lr_bw + ks * 32 + fq * 8), ba = *(const bf16x8*)(lr_ba + ks * 32 + fq * 8);
                if (lr_lo) { MMA16(Wf[ks][0], bw, accd[0]); MMA16(Wf[ks][1], bw, accd[1]); MMA16(Wf[ks][2], ba, acca[0]); MMA16(Wf[ks][3], ba, acca[1]); }
                else       { MMA16(Wf[ks][2], bw, accd[0]); MMA16(Wf[ks][3], bw, accd[1]); MMA16(Wf[ks][0], ba, acca[0]); MMA16(Wf[ks][1], ba, acca[1]); }
            }
            const int ch = 16 * lr_strip + fr;
            float carry = 0.f;
#pragma unroll
            for (int mm = 0; mm < 2; ++mm) {
                float c[4];
#pragma unroll
                for (int r = 0; r < 4; ++r) {
                    const float lw = -0.87503878f * sigmoidf_(accd[mm][r]);
                    c[r] = (r ? c[r - 1] : 0.f) + lw;
                }
                const float t0 = __shfl(c[3], fr), t1 = __shfl(c[3], fr + 16), t2 = __shfl(c[3], fr + 32), t3 = __shfl(c[3], fr + 48);
                const float off = carry + (fq > 0 ? t0 : 0.f) + (fq > 1 ? t1 : 0.f) + (fq > 2 ? t2 : 0.f);
#pragma unroll
                for (int r = 0; r < 4; ++r) Gf[(16 * (dmi + mm) + 4 * fq + r) * GS + ch] = off + c[r];
                carry += (t0 + t1) + (t2 + t3);
            }
#pragma unroll
            for (int mm = 0; mm < 2; ++mm)
#pragma unroll
                for (int r = 0; r < 4; ++r) AGf[(16 * (ami + mm) + 4 * fq + r) * GS + ch] = sigmoidf_(acca[mm][r]);
        }
        SBAR();
        {
            const int c0 = 8 * tk_cg, p = tk_p;
            float rr[8], kx[8], vv[8];
            const bool nv[4] = {(nvm & 1) != 0, (nvm & 2) != 0, (nvm & 4) != 0, (nvm & 8) != 0};
            {
                const LAS float* PAR = (const LAS float*)(lds + SC_PAR) + c0;
                const f32x4 a0 = *(const LAS f32x4*)(PAR), a1 = *(const LAS f32x4*)(PAR + 4);
                mix8(Rs, Rn, nv, lat, a0, a1, rr);
                const f32x4 b0 = *(const LAS f32x4*)(PAR + 64), b1 = *(const LAS f32x4*)(PAR + 68);
                mix8(Ks, Kn, nv, lat, b0, b1, kx);
                const f32x4 d0 = *(const LAS f32x4*)(PAR + 128), d1 = *(const LAS f32x4*)(PAR + 132);
                mix8(Vs, Vn, nv, lat, d0, d1, vv);
                if (mode == 2) {
#pragma unroll
                    for (int e = 0; e < 8; ++e) vv[e] = 0.f; }
            }
            f32x4 g0 = *(const LAS f32x4*)(Gf + p * GS + c0), g1 = *(const LAS f32x4*)(Gf + p * GS + c0 + 4);
            const int pm = p > 0 ? p - 1 : 0;
            f32x4 q0 = *(const LAS f32x4*)(Gf + pm * GS + c0), q1 = *(const LAS f32x4*)(Gf + pm * GS + c0 + 4);
            const f32x4 h0 = *(const LAS f32x4*)(Gf + 31 * GS + c0), h1 = *(const LAS f32x4*)(Gf + 31 * GS + c0 + 4);
            if (p == 0) { q0 = (f32x4){0.f, 0.f, 0.f, 0.f}; q1 = q0; }
            if (p >= 32) { g0 += h0; g1 += h1; }
            if (p >= 33) { q0 += h0; q1 += h1; }
            const f32x4 ag0 = *(const LAS f32x4*)(AGf + p * GS + c0), ag1 = *(const LAS f32x4*)(AGf + p * GS + c0 + 4);
            const f32x4 l0 = *(const LAS f32x4*)(Gf + 63 * GS + c0) + h0, l1 = *(const LAS f32x4*)(Gf + 63 * GS + c0 + 4) + h1;
            const f32x4 kk0 = *(const LAS f32x4*)((const LAS float*)(lds + SC_PAR) + 192 + c0), kk1 = *(const LAS f32x4*)((const LAS float*)(lds + SC_PAR) + 196 + c0);
            const f32x4 ka0 = *(const LAS f32x4*)((const LAS float*)(lds + SC_PAR) + 256 + c0), ka1 = *(const LAS f32x4*)((const LAS float*)(lds + SC_PAR) + 260 + c0);
            float kkv[8], n2 = 0.f;
#pragma unroll
            for (int e = 0; e < 8; ++e) { kkv[e] = kx[e] * (e < 4 ? kk0[e] : kk1[e - 4]); n2 += kkv[e] * kkv[e]; }
            n2 += __shfl_xor(n2, 1); n2 += __shfl_xor(n2, 2); n2 += __shfl_xor(n2, 4);
            if (dir == 0 && mode != 2) {
                const f32x4 rk0 = *(const LAS f32x4*)((const LAS float*)(lds + SC_PAR) + 320 + c0), rk1 = *(const LAS f32x4*)((const LAS float*)(lds + SC_PAR) + 324 + c0);
                float bs = 0.f;
#pragma unroll
                for (int e = 0; e < 8; ++e) bs += rr[e] * kx[e] * (e < 4 ? rk0[e] : rk1[e - 4]);
                bs += __shfl_xor(bs, 1); bs += __shfl_xor(bs, 2); bs += __shfl_xor(bs, 4);
                float bo[8];
#pragma unroll
                for (int e = 0; e < 8; ++e) bo[e] = bs * vv[e];
                const int bpos = chunk * 64 + p, bt = bpos;
                *(u32x4*)((bf16_t*)a.out + BON_OFF + (size_t)(row_base + bt) * DM + h * 64 + c0) = pack8(bo);
            }
            const float inv = __builtin_amdgcn_rcpf(fmaxf(__builtin_amdgcn_sqrtf(n2), 1e-12f));
            float oa[8], orr[8], ob[8], ok[8];
#pragma unroll
            for (int e = 0; e < 8; ++e) {
                const float g = e < 4 ? g0[e] : g1[e - 4], gp = e < 4 ? q0[e] : q1[e - 4], ag = e < 4 ? ag0[e] : ag1[e - 4], gl = e < 4 ? l0[e] : l1[e - 4];
                const float kac = e < 4 ? ka0[e] : ka1[e - 4];
                const float kkn = kkv[e] * inv, kd = kx[e] * (1.0f + (ag - 1.0f) * kac), bb = kkn * ag;
                const float emg = __builtin_amdgcn_exp2f(-g), eh = __builtin_amdgcn_exp2f(gl - g);
                oa[e] = -kkn * __builtin_amdgcn_exp2f(gp); orr[e] = rr[e] * __builtin_amdgcn_exp2f(g); ob[e] = bb * emg; ok[e] = kd * emg;
                BhT[tskew(c0 + e) + p] = (bf16_t)f2bf(bb * eh);
                KhT[tskew(c0 + e) + p] = (bf16_t)f2bf(kd * eh);
                VT[tskew(c0 + e) + p] = (bf16_t)f2bf(vv[e]);
                if (p == 0) EGL[c0 + e] = __builtin_amdgcn_exp2f(gl);
            }
            *(LAS u32x4*)(At + p * LDP + c0) = pack8(oa); *(LAS u32x4*)(Rt + p * LDP + c0) = pack8(orr);
            *(LAS u32x4*)(Bt + p * LDP + c0) = pack8(ob); *(LAS u32x4*)(Kt + p * LDP + c0) = pack8(ok);
        }
        SBAR();
        {
#pragma unroll
            for (int rep = 0; rep < 2; ++rep) {
                const int tix = wv + 8 * rep;
                if (tix < 10) {
                    const int mi = tix < 4 ? 0 : tix < 7 ? 1 : tix < 9 ? 2 : 3, ni = tix < 4 ? tix : tix < 7 ? tix - 3 : tix < 9 ? tix - 5 : 3;
                    const bf16x8 x0 = ldfrag(Bt, 16 * mi + fr, 0, fq), x1 = ldfrag(Bt, 16 * mi + fr, 1, fq), y0 = ldfrag(At, 16 * ni + fr, 0, fq), y1 = ldfrag(At, 16 * ni + fr, 1, fq);
                    f32x4 c = (f32x4){0.f, 0.f, 0.f, 0.f};
                    MMA16(x0, y0, c); MMA16(x1, y1, c);
                    const int t = 16 * ni + fr, tau0 = 16 * mi + 4 * fq;
#pragma unroll
                    for (int r = 0; r < 4; ++r) if (tau0 + r >= t) c[r] = 0.f;
                    *(LAS f32x4*)(Aab + t * GS + tau0) = c;
                    if (mi < 2 && ni >= 2) st4lds((LAS bf16_t*)(lds + SC_ABA) + (t - 32) * LDQ + tau0, c);
                }
            }
        }
        SBAR();
        if (wv != 0) {
#pragma unroll 1
            for (int idx = wv - 1; idx < 48; idx += 7) {
                const int mat = 1 + (idx >> 4), mi = (idx >> 2) & 3, ni = idx & 3;
                const LAS bf16_t* X = (mat == 2) ? Bt : Kt;
                const LAS bf16_t* Y = (mat == 1) ? At : Rt;
                LAS bf16_t* dst = (mat == 1) ? Aak : (mat == 2) ? Arb : Ark;
                f32x4 c = (f32x4){0.f, 0.f, 0.f, 0.f};
                if (mi <= ni) {
                    const bf16x8 x0 = ldfrag(X, 16 * mi + fr, 0, fq), x1 = ldfrag(X, 16 * mi + fr, 1, fq), y0 = ldfrag(Y, 16 * ni + fr, 0, fq), y1 = ldfrag(Y, 16 * ni + fr, 1, fq);
                    MMA16(x0, y0, c); MMA16(x1, y1, c);
                }
                const int t = 16 * ni + fr, tau0 = 16 * mi + 4 * fq;
#pragma unroll
                for (int r = 0; r < 4; ++r) { const int tau = tau0 + r; if ((mat != 1) ? (tau > t) : (tau >= t)) c[r] = 0.f; }
                st4lds(dst + t * LDP + tau0, c);
            }
        }
        if (wv == 0) {
            LAS bf16_t* AbBA = (LAS bf16_t*)(lds + SC_ABA); LAS bf16_t* TT = UT; LAS bf16_t* WsT = UT + 32 * LDQ;
            const int hb = lane >> 5, c = lane & 31;
            const float cf = (float)c;
            float Tr[32];
#pragma unroll
            for (int t = 0; t < 32; ++t) Tr[t] = 0.f;
            {
                const int abase_i = (32 * hb) * GS + 32 * hb;
                f32x2_t TP[16];
#pragma unroll
                for (int q = 0; q < 16; ++q) TP[q] = (f32x2_t){0.f, 0.f};
                Tr[0] = 1.0f - fminf(cf, 1.0f); TP[0][0] = Tr[0];
                const f32x4 r1_0 = *(const LAS f32x4*)(Aab + abase_i + 68);
                const f32x4 r2_0 = *(const LAS f32x4*)(Aab + abase_i + 136);
                int o3 = abase_i + 204; asm volatile("" : "+v"(o3) : "v"(Tr[0]));
                const f32x4 r3_0 = *(const LAS f32x4*)(Aab + o3 + 0);
                __builtin_amdgcn_sched_barrier(0);
                { const f32x2_t pa = (f32x2_t){r1_0[0], r1_0[1]} * TP[0]; const f32x2_t pb = (f32x2_t){0.f, 0.f}; const f32x2_t ps = pa + pb;
                  Tr[1] = (ps[0] + ps[1]) + (1.0f - fminf(fabsf(cf - 1.0f), 1.0f)); TP[0][1] = Tr[1]; }
                __builtin_amdgcn_sched_barrier(0);
                int o4 = abase_i + 272; asm volatile("" : "+v"(o4) : "v"(Tr[1]));
                const f32x4 r4_0 = *(const LAS f32x4*)(Aab + o4 + 0);
                __builtin_amdgcn_sched_barrier(0);
                { const f32x2_t pa = (f32x2_t){r2_0[0], r2_0[1]} * TP[0]; const f32x2_t pb = (f32x2_t){0.f, 0.f}; const f32x2_t ps = pa + pb;
                  Tr[2] = (ps[0] + ps[1]) + (1.0f - fminf(fabsf(cf - 2.0f), 1.0f)); TP[1][0] = Tr[2]; }
                __builtin_amdgcn_sched_barrier(0);
                int o5 = abase_i + 340; asm volatile("" : "+v"(o5) : "v"(Tr[2]));
                const f32x4 r5_0 = *(const LAS f32x4*)(Aab + o5 + 0); const f32x4 r5_1 = *(const LAS f32x4*)(Aab + o5 + 4);
                __builtin_amdgcn_sched_barrier(0);
                { const f32x2_t pa = (f32x2_t){r3_0[0], r3_0[1]} * TP[0]; const f32x2_t pb = (f32x2_t){r3_0[2], r3_0[3]} * TP[1]; const f32x2_t ps = pa + pb;
                  Tr[3] = (ps[0] + ps[1]) + (1.0f - fminf(fabsf(cf - 3.0f), 1.0f)); TP[1][1] = Tr[3]; }
                __builtin_amdgcn_sched_barrier(0);
                int o6 = abase_i + 408; asm volatile("" : "+v"(o6) : "v"(Tr[3]));
                const f32x4 r6_0 = *(const LAS f32x4*)(Aab + o6 + 0); const f32x4 r6_1 = *(const LAS f32x4*)(Aab + o6 + 4);
                __builtin_amdgcn_sched_barrier(0);
                { const f32x2_t pa = (f32x2_t){r4_0[0], r4_0[1]} * TP[0]; const f32x2_t pb = (f32x2_t){r4_0[2], r4_0[3]} * TP[1]; const f32x2_t ps = pa + pb;
                  Tr[4] = (ps[0] + ps[1]) + (1.0f - fminf(fabsf(cf - 4.0f), 1.0f)); TP[2][0] = Tr[4]; }
                __builtin_amdgcn_sched_barrier(0);
                int o7 = abase_i + 476; asm volatile("" : "+v"(o7) : "v"(Tr[4]));
                const f32x4 r7_0 = *(const LAS f32x4*)(Aab + o7 + 0); const f32x4 r7_1 = *(const LAS f32x4*)(Aab + o7 + 4);
                __builtin_amdgcn_sched_barrier(0);
                { const f32x2_t pa = (f32x2_t){r5_0[0], r5_0[1]} * TP[0] + (f32x2_t){r5_1[0], r5_1[1]} * TP[2]; const f32x2_t pb = (f32x2_t){r5_0[2], r5_0[3]} * TP[1]; const f32x2_t ps = pa + pb;
                  Tr[5] = (ps[0] + ps[1]) + (1.0f - fminf(fabsf(cf - 5.0f), 1.0f)); TP[2][1] = Tr[5]; }
                __builtin_amdgcn_sched_barrier(0);
                int o8 = abase_i + 544; asm volatile("" : "+v"(o8) : "v"(Tr[5]));
                const f32x4 r8_0 = *(const LAS f32x4*)(Aab + o8 + 0); const f32x4 r8_1 = *(const LAS f32x4*)(Aab + o8 + 4);
                __builtin_amdgcn_sched_barrier(0);
                { const f32x2_t pa = (f32x2_t){r6_0[0], r6_0[1]} * TP[0] + (f32x2_t){r6_1[0], r6_1[1]} * TP[2]; const f32x2_t pb = (f32x2_t){r6_0[2], r6_0[3]} * TP[1]; const f32x2_t ps = pa + pb;
                  Tr[6] = (ps[0] + ps[1]) + (1.0f - fminf(fabsf(cf - 6.0f), 1.0f)); TP[3][0] = Tr[6]; }
                __builtin_amdgcn_sched_barrier(0);
                int o9 = abase_i + 612; asm volatile("" : "+v"(o9) : "v"(Tr[6]));
                const f32x4 r9_0 = *(const LAS f32x4*)(Aab + o9 + 0); const f32x4 r9_1 = *(const LAS f32x4*)(Aab + o9 + 4); const f32x4 r9_2 = *(const LAS f32x4*)(Aab + o9 + 8);
                __builtin_amdgcn_sched_barrier(0);
                { const f32x2_t pa = (f32x2_t){r7_0[0], r7_0[1]} * TP[0] + (f32x2_t){r7_1[0], r7_1[1]} * TP[2]; const f32x2_t pb = (f32x2_t){r7_0[2], r7_0[3]} * TP[1] + (f32x2_t){r7_1[2], r7_1[3]} * TP[3]; const f32x2_t ps = pa + pb;
                  Tr[7] = (ps[0] + ps[1]) + (1.0f - fminf(fabsf(cf - 7.0f), 1.0f)); TP[3][1] = Tr[7]; }
                __builtin_amdgcn_sched_barrier(0);
                int o10 = abase_i + 680; asm volatile("" : "+v"(o10) : "v"(Tr[7]));
                const f32x4 r10_0 = *(const LAS f32x4*)(Aab + o10 + 0); const f32x4 r10_1 = *(const LAS f32x4*)(Aab + o10 + 4); const f32x4 r10_2 = *(const LAS f32x4*)(Aab + o10 + 8);
                __builtin_amdgcn_sched_barrier(0);
                { const f32x2_t pa = (f32x2_t){r8_0[0], r8_0[1]} * TP[0] + (f32x2_t){r8_1[0], r8_1[1]} * TP[2]; const f32x2_t pb = (f32x2_t){r8_0[2], r8_0[3]} * TP[1] + (f32x2_t){r8_1[2], r8_1[3]} * TP[3]; const f32x2_t ps = pa + pb;
                  Tr[8] = (ps[0] + ps[1]) + (1.0f - fminf(fabsf(cf - 8.0f), 1.0f)); TP[4][0] = Tr[8]; }
                __builtin_amdgcn_sched_barrier(0);
                int o11 = abase_i + 748; asm volatile("" : "+v"(o11) : "v"(Tr[8]));
                const f32x4 r11_0 = *(const LAS f32x4*)(Aab + o11 + 0); const f32x4 r11_1 = *(const LAS f32x4*)(Aab + o11 + 4); const f32x4 r11_2 = *(const LAS f32x4*)(Aab + o11 + 8);
                __builtin_amdgcn_sched_barrier(0);
                { const f32x2_t pa = (f32x2_t){r9_0[0], r9_0[1]} * TP[0] + (f32x2_t){r9_1[0], r9_1[1]} * TP[2] + (f32x2_t){r9_2[0], r9_2[1]} * TP[4]; const f32x2_t pb = (f32x2_t){r9_0[2], r9_0[3]} * TP[1] + (f32x2_t){r9_1[2], r9_1[3]} * TP[3]; const f32x2_t ps = pa + pb;
                  Tr[9] = (ps[0] + ps[1]) + (1.0f - fminf(fabsf(cf - 9.0f), 1.0f)); TP[4][1] = Tr[9]; }
                __builtin_amdgcn_sched_barrier(0);
                int o12 = abase_i + 816; asm volatile("" : "+v"(o12) : "v"(Tr[9]));
                const f32x4 r12_0 = *(const LAS f32x4*)(Aab + o12 + 0); const f32x4 r12_1 = *(const LAS f32x4*)(Aab + o12 + 4); const f32x4 r12_2 = *(const LAS f32x4*)(Aab + o12 + 8);
                __builtin_amdgcn_sched_barrier(0);
                { const f32x2_t pa = (f32x2_t){r10_0[0], r10_0[1]} * TP[0] + (f32x2_t){r10_1[0], r10_1[1]} * TP[2] + (f32x2_t){r10_2[0], r10_2[1]} * TP[4]; const f32x2_t pb = (f32x2_t){r10_0[2], r10_0[3]} * TP[1] + (f32x2_t){r10_1[2], r10_1[3]} * TP[3]; const f32x2_t ps = pa + pb;
                  Tr[10] = (ps[0] + ps[1]) + (1.0f - fminf(fabsf(cf - 10.0f), 1.0f)); TP[5][0] = Tr[10]; }
                __builtin_amdgcn_sched_barrier(0);
                int o13 = abase_i + 884; asm volatile("" : "+v"(o13) : "v"(Tr[10]));
                const f32x4 r13_0 = *(const LAS f32x4*)(Aab + o13 + 0); const f32x4 r13_1 = *(const LAS f32x4*)(Aab + o13 + 4); const f32x4 r13_2 = *(const LAS f32x4*)(Aab + o13 + 8); const f32x4 r13_3 = *(const LAS f32x4*)(Aab + o13 + 12);
                __builtin_amdgcn_sched_barrier(0);
                { const f32x2_t pa = (f32x2_t){r11_0[0], r11_0[1]} * TP[0] + (f32x2_t){r11_1[0], r11_1[1]} * TP[2] + (f32x2_t){r11_2[0], r11_2[1]} * TP[4]; const f32x2_t pb = (f32x2_t){r11_0[2], r11_0[3]} * TP[1] + (f32x2_t){r11_1[2], r11_1[3]} * TP[3] + (f32x2_t){r11_2[2], r11_2[3]} * TP[5]; const f32x2_t ps = pa + pb;
                  Tr[11] = (ps[0] + ps[1]) + (1.0f - fminf(fabsf(cf - 11.0f), 1.0f)); TP[5][1] = Tr[11]; }
                __builtin_amdgcn_sched_barrier(0);
                int o14 = abase_i + 952; asm volatile("" : "+v"(o14) : "v"(Tr[11]));
                const f32x4 r14_0 = *(const LAS f32x4*)(Aab + o14 + 0); const f32x4 r14_1 = *(const LAS f32x4*)(Aab + o14 + 4); const f32x4 r14_2 = *(const LAS f32x4*)(Aab + o14 + 8); const f32x4 r14_3 = *(const LAS f32x4*)(Aab + o14 + 12);
                __builtin_amdgcn_sched_barrier(0);
                { const f32x2_t pa = (f32x2_t){r12_0[0], r12_0[1]} * TP[0] + (f32x2_t){r12_1[0], r12_1[1]} * TP[2] + (f32x2_t){r12_2[0], r12_2[1]} * TP[4]; const f32x2_t pb = (f32x2_t){r12_0[2], r12_0[3]} * TP[1] + (f32x2_t){r12_1[2], r12_1[3]} * TP[3] + (f32x2_t){r12_2[2], r12_2[3]} * TP[5]; const f32x2_t ps = pa + pb;
                  Tr[12] = (ps[0] + ps[1]) + (1.0f - fminf(fabsf(cf - 12.0f), 1.0f)); TP[6][0] = Tr[12]; }
                __builtin_amdgcn_sched_barrier(0);
                int o15 = abase_i + 1020; asm volatile("" : "+v"(o15) : "v"(Tr[12]));
                const f32x4 r15_0 = *(const LAS f32x4*)(Aab + o15 + 0); const f32x4 r15_1 = *(const LAS f32x4*)(Aab + o15 + 4); const f32x4 r15_2 = *(const LAS f32x4*)(Aab + o15 + 8); const f32x4 r15_3 = *(const LAS f32x4*)(Aab + o15 + 12);
                __builtin_amdgcn_sched_barrier(0);
                { const f32x2_t pa = (f32x2_t){r13_0[0], r13_0[1]} * TP[0] + (f32x2_t){r13_1[0], r13_1[1]} * TP[2] + (f32x2_t){r13_2[0], r13_2[1]} * TP[4] + (f32x2_t){r13_3[0], r13_3[1]} * TP[6]; const f32x2_t pb = (f32x2_t){r13_0[2], r13_0[3]} * TP[1] + (f32x2_t){r13_1[2], r13_1[3]} * TP[3] + (f32x2_t){r13_2[2], r13_2[3]} * TP[5]; const f32x2_t ps = pa + pb;
                  Tr[13] = (ps[0] + ps[1]) + (1.0f - fminf(fabsf(cf - 13.0f), 1.0f)); TP[6][1] = Tr[13]; }
                __builtin_amdgcn_sched_barrier(0);
                int o16 = abase_i + 1088; asm volatile("" : "+v"(o16) : "v"(Tr[13]));
                const f32x4 r16_0 = *(const LAS f32x4*)(Aab + o16 + 0); const f32x4 r16_1 = *(const LAS f32x4*)(Aab + o16 + 4); const f32x4 r16_2 = *(const LAS f32x4*)(Aab + o16 + 8); const f32x4 r16_3 = *(const LAS f32x4*)(Aab + o16 + 12);
                __builtin_amdgcn_sched_barrier(0);
                { const f32x2_t pa = (f32x2_t){r14_0[0], r14_0[1]} * TP[0] + (f32x2_t){r14_1[0], r14_1[1]} * TP[2] + (f32x2_t){r14_2[0], r14_2[1]} * TP[4] + (f32x2_t){r14_3[0], r14_3[1]} * TP[6]; const f32x2_t pb = (f32x2_t){r14_0[2], r14_0[3]} * TP[1] + (f32x2_t){r14_1[2], r14_1[3]} * TP[3] + (f32x2_t){r14_2[2], r14_2[3]} * TP[5]; const f32x2_t ps = pa + pb;
                  Tr[14] = (ps[0] + ps[1]) + (1.0f - fminf(fabsf(cf - 14.0f), 1.0f)); TP[7][0] = Tr[14]; }
                __builtin_amdgcn_sched_barrier(0);
                int o17 = abase_i + 1156; asm volatile("" : "+v"(o17) : "v"(Tr[14]));
                const f32x4 r17_0 = *(const LAS f32x4*)(Aab + o17 + 0); const f32x4 r17_1 = *(const LAS f32x4*)(Aab + o17 + 4); const f32x4 r17_2 = *(const LAS f32x4*)(Aab + o17 + 8); const f32x4 r17_3 = *(const LAS f32x4*)(Aab + o17 + 12); const f32x4 r17_4 = *(const LAS f32x4*)(Aab + o17 + 16);
                __builtin_amdgcn_sched_barrier(0);
                { const f32x2_t pa = (f32x2_t){r15_0[0], r15_0[1]} * TP[0] + (f32x2_t){r15_1[0], r15_1[1]} * TP[2] + (f32x2_t){r15_2[0], r15_2[1]} * TP[4] + (f32x2_t){r15_3[0], r15_3[1]} * TP[6]; const f32x2_t pb = (f32x2_t){r15_0[2], r15_0[3]} * TP[1] + (f32x2_t){r15_1[2], r15_1[3]} * TP[3] + (f32x2_t){r15_2[2], r15_2[3]} * TP[5] + (f32x2_t){r15_3[2], r15_3[3]} * TP[7]; const f32x2_t ps = pa + pb;
                  Tr[15] = (ps[0] + ps[1]) + (1.0f - fminf(fabsf(cf - 15.0f), 1.0f)); TP[7][1] = Tr[15]; }
                __builtin_amdgcn_sched_barrier(0);
                int o18 = abase_i + 1224; asm volatile("" : "+v"(o18) : "v"(Tr[15]));
                const f32x4 r18_0 = *(const LAS f32x4*)(Aab + o18 + 0); const f32x4 r18_1 = *(const LAS f32x4*)(Aab + o18 + 4); const f32x4 r18_2 = *(const LAS f32x4*)(Aab + o18 + 8); const f32x4 r18_3 = *(const LAS f32x4*)(Aab + o18 + 12); const f32x4 r18_4 = *(const LAS f32x4*)(Aab + o18 + 16);
                __builtin_amdgcn_sched_barrier(0);
                { const f32x2_t pa = (f32x2_t){r16_0[0], r16_0[1]} * TP[0] + (f32x2_t){r16_1[0], r16_1[1]} * TP[2] + (f32x2_t){r16_2[0], r16_2[1]} * TP[4] + (f32x2_t){r16_3[0], r16_3[1]} * TP[6]; const f32x2_t pb = (f32x2_t){r16_0[2], r16_0[3]} * TP[1] + (f32x2_t){r16_1[2], r16_1[3]} * TP[3] + (f32x2_t){r16_2[2], r16_2[3]} * TP[5] + (f32x2_t){r16_3[2], r16_3[3]} * TP[7]; const f32x2_t ps = pa + pb;
                  Tr[16] = (ps[0] + ps[1]) + (1.0f - fminf(fabsf(cf - 16.0f), 1.0f)); TP[8][0] = Tr[16]; }
                __builtin_amdgcn_sched_barrier(0);
                int o19 = abase_i + 1292; asm volatile("" : "+v"(o19) : "v"(Tr[16]));
                const f32x4 r19_0 = *(const LAS f32x4*)(Aab + o19 + 0); const f32x4 r19_1 = *(const LAS f32x4*)(Aab + o19 + 4); const f32x4 r19_2 = *(const LAS f32x4*)(Aab + o19 + 8); const f32x4 r19_3 = *(const LAS f32x4*)(Aab + o19 + 12); const f32x4 r19_4 = *(const LAS f32x4*)(Aab + o19 + 16);
                __builtin_amdgcn_sched_barrier(0);
                { const f32x2_t pa = (f32x2_t){r17_0[0], r17_0[1]} * TP[0] + (f32x2_t){r17_1[0], r17_1[1]} * TP[2] + (f32x2_t){r17_2[0], r17_2[1]} * TP[4] + (f32x2_t){r17_3[0], r17_3[1]} * TP[6] + (f32x2_t){r17_4[0], r17_4[1]} * TP[8]; const f32x2_t pb = (f32x2_t){r17_0[2], r17_0[3]} * TP[1] + (f32x2_t){r17_1[2], r17_1[3]} * TP[3] + (f32x2_t){r17_2[2], r17_2[3]} * TP[5] + (f32x2_t){r17_3[2], r17_3[3]} * TP[7]; const f32x2_t ps = pa + pb;
                  Tr[17] = (ps[0] + ps[1]) + (1.0f - fminf(fabsf(cf - 17.0f), 1.0f)); TP[8][1] = Tr[17]; }
                __builtin_amdgcn_sched_barrier(0);
                int o20 = abase_i + 1360; asm volatile("" : "+v"(o20) : "v"(Tr[17]));
                const f32x4 r20_0 = *(const LAS f32x4*)(Aab + o20 + 0); const f32x4 r20_1 = *(const LAS f32x4*)(Aab + o20 + 4); const f32x4 r20_2 = *(const LAS f32x4*)(Aab + o20 + 8); const f32x4 r20_3 = *(const LAS f32x4*)(Aab + o20 + 12); const f32x4 r20_4 = *(const LAS f32x4*)(Aab + o20 + 16);
                __builtin_amdgcn_sched_barrier(0);
                { const f32x2_t pa = (f32x2_t){r18_0[0], r18_0[1]} * TP[0] + (f32x2_t){r18_1[0], r18_1[1]} * TP[2] + (f32x2_t){r18_2[0], r18_2[1]} * TP[4] + (f32x2_t){r18_3[0], r18_3[1]} * TP[6] + (f32x2_t){r18_4[0], r18_4[1]} * TP[8]; const f32x2_t pb = (f32x2_t){r18_0[2], r18_0[3]} * TP[1] + (f32x2_t){r18_1[2], r18_1[3]} * TP[3] + (f32x2_t){r18_2[2], r18_2[3]} * TP[5] + (f32x2_t){r18_3[2], r18_3[3]} * TP[7]; const f32x2_t ps = pa + pb;
                  Tr[18] = (ps[0] + ps[1]) + (1.0f - fminf(fabsf(cf - 18.0f), 1.0f)); TP[9][0] = Tr[18]; }
                __builtin_amdgcn_sched_barrier(0);
                int o21 = abase_i + 1428; asm volatile("" : "+v"(o21) : "v"(Tr[18]));
                const f32x4 r21_0 = *(const LAS f32x4*)(Aab + o21 + 0); const f32x4 r21_1 = *(const LAS f32x4*)(Aab + o21 + 4); const f32x4 r21_2 = *(const LAS f32x4*)(Aab + o21 + 8); const f32x4 r21_3 = *(const LAS f32x4*)(Aab + o21 + 12); const f32x4 r21_4 = *(const LAS f32x4*)(Aab + o21 + 16); const f32x4 r21_5 = *(const LAS f32x4*)(Aab + o21 + 20);
                __builtin_amdgcn_sched_barrier(0);
                { const f32x2_t pa = (f32x2_t){r19_0[0], r19_0[1]} * TP[0] + (f32x2_t){r19_1[0], r19_1[1]} * TP[2] + (f32x2_t){r19_2[0], r19_2[1]} * TP[4] + (f32x2_t){r19_3[0], r19_3[1]} * TP[6] + (f32x2_t){r19_4[0], r19_4[1]} * TP[8]; const f32x2_t pb = (f32x2_t){r19_0[2], r19_0[3]} * TP[1] + (f32x2_t){r19_1[2], r19_1[3]} * TP[3] + (f32x2_t){r19_2[2], r19_2[3]} * TP[5] + (f32x2_t){r19_3[2], r19_3[3]} * TP[7] + (f32x2_t){r19_4[2], r19_4[3]} * TP[9]; const f32x2_t ps = pa + pb;
                  Tr[19] = (ps[0] + ps[1]) + (1.0f - fminf(fabsf(cf - 19.0f), 1.0f)); TP[9][1] = Tr[19]; }
                __builtin_amdgcn_sched_barrier(0);
                int o22 = abase_i + 1496; asm volatile("" : "+v"(o22) : "v"(Tr[19]));
                const f32x4 r22_0 = *(const LAS f32x4*)(Aab + o22 + 0); const f32x4 r22_1 = *(const LAS f32x4*)(Aab + o22 + 4); const f32x4 r22_2 = *(const LAS f32x4*)(Aab + o22 + 8); const f32x4 r22_3 = *(const LAS f32x4*)(Aab + o22 + 12); const f32x4 r22_4 = *(const LAS f32x4*)(Aab + o22 + 16); const f32x4 r22_5 = *(const LAS f32x4*)(Aab + o22 + 20);
                __builtin_amdgcn_sched_barrier(0);
                { const f32x2_t pa = (f32x2_t){r20_0[0], r20_0[1]} * TP[0] + (f32x2_t){r20_1[0], r20_1[1]} * TP[2] + (f32x2_t){r20_2[0], r20_2[1]} * TP[4] + (f32x2_t){r20_3[0], r20_3[1]} * TP[6] + (f32x2_t){r20_4[0], r20_4[1]} * TP[8]; const f32x2_t pb = (f32x2_t){r20_0[2], r20_0[3]} * TP[1] + (f32x2_t){r20_1[2], r20_1[3]} * TP[3] + (f32x2_t){r20_2[2], r20_2[3]} * TP[5] + (f32x2_t){r20_3[2], r20_3[3]} * TP[7] + (f32x2_t){r20_4[2], r20_4[3]} * TP[9]; const f32x2_t ps = pa + pb;
                  Tr[20] = (ps[0] + ps[1]) + (1.0f - fminf(fabsf(cf - 20.0f), 1.0f)); TP[10][0] = Tr[20]; }
                __builtin_amdgcn_sched_barrier(0);
                int o23 = abase_i + 1564; asm volatile("" : "+v"(o23) : "v"(Tr[20]));
                const f32x4 r23_0 = *(const LAS f32x4*)(Aab + o23 + 0); const f32x4 r23_1 = *(const LAS f32x4*)(Aab + o23 + 4); const f32x4 r23_2 = *(const LAS f32x4*)(Aab + o23 + 8); const f32x4 r23_3 = *(const LAS f32x4*)(Aab + o23 + 12); const f32x4 r23_4 = *(const LAS f32x4*)(Aab + o23 + 16); const f32x4 r23_5 = *(const LAS f32x4*)(Aab + o23 + 20);
                __builtin_amdgcn_sched_barrier(0);
                { const f32x2_t pa = (f32x2_t){r21_0[0], r21_0[1]} * TP[0] + (f32x2_t){r21_1[0], r21_1[1]} * TP[2] + (f32x2_t){r21_2[0], r21_2[1]} * TP[4] + (f32x2_t){r21_3[0], r21_3[1]} * TP[6] + (f32x2_t){r21_4[0], r21_4[1]} * TP[8] + (f32x2_t){r21_5[0], r21_5[1]} * TP[10]; const f32x2_t pb = (f32x2_t){r21_0[2], r21_0[3]} * TP[1] + (f32x2_t){r21_1[2], r21_1[3]} * TP[3] + (f32x2_t){r21_2[2], r21_2[3]} * TP[5] + (f32x2_t){r21_3[2], r21_3[3]} * TP[7] + (f32x2_t){r21_4[2], r21_4[3]} * TP[9]; const f32x2_t ps = pa + pb;
                  Tr[21] = (ps[0] + ps[1]) + (1.0f - fminf(fabsf(cf - 21.0f), 1.0f)); TP[10][1] = Tr[21]; }
                __builtin_amdgcn_sched_barrier(0);
                int o24 = abase_i + 1632; asm volatile("" : "+v"(o24) : "v"(Tr[21]));
                const f32x4 r24_0 = *(const LAS f32x4*)(Aab + o24 + 0); const f32x4 r24_1 = *(const LAS f32x4*)(Aab + o24 + 4); const f32x4 r24_2 = *(const LAS f32x4*)(Aab + o24 + 8); const f32x4 r24_3 = *(const LAS f32x4*)(Aab + o24 + 12); const f32x4 r24_4 = *(const LAS f32x4*)(Aab + o24 + 16); const f32x4 r24_5 = *(const LAS f32x4*)(Aab + o24 + 20);
                __builtin_amdgcn_sched_barrier(0);
                { const f32x2_t pa = (f32x2_t){r22_0[0], r22_0[1]} * TP[0] + (f32x2_t){r22_1[0], r22_1[1]} * TP[2] + (f32x2_t){r22_2[0], r22_2[1]} * TP[4] + (f32x2_t){r22_3[0], r22_3[1]} * TP[6] + (f32x2_t){r22_4[0], r22_4[1]} * TP[8] + (f32x2_t){r22_5[0], r22_5[1]} * TP[10]; const f32x2_t pb = (f32x2_t){r22_0[2], r22_0[3]} * TP[1] + (f32x2_t){r22_1[2], r22_1[3]} * TP[3] + (f32x2_t){r22_2[2], r22_2[3]} * TP[5] + (f32x2_t){r22_3[2], r22_3[3]} * TP[7] + (f32x2_t){r22_4[2], r22_4[3]} * TP[9]; const f32x2_t ps = pa + pb;
                  Tr[22] = (ps[0] + ps[1]) + (1.0f - fminf(fabsf(cf - 22.0f), 1.0f)); TP[11][0] = Tr[22]; }
                __builtin_amdgcn_sched_barrier(0);
                int o25 = abase_i + 1700; asm volatile("" : "+v"(o25) : "v"(Tr[22]));
                const f32x4 r25_0 = *(const LAS f32x4*)(Aab + o25 + 0); const f32x4 r25_1 = *(const LAS f32x4*)(Aab + o25 + 4); const f32x4 r25_2 = *(const LAS f32x4*)(Aab + o25 + 8); const f32x4 r25_3 = *(const LAS f32x4*)(Aab + o25 + 12); const f32x4 r25_4 = *(const LAS f32x4*)(Aab + o25 + 16); const f32x4 r25_5 = *(const LAS f32x4*)(Aab + o25 + 20); const f32x4 r25_6 = *(const LAS f32x4*)(Aab + o25 + 24);
                __builtin_amdgcn_sched_barrier(0);
                { const f32x2_t pa = (f32x2_t){r23_0[0], r23_0[1]} * TP[0] + (f32x2_t){r23_1[0], r23_1[1]} * TP[2] + (f32x2_t){r23_2[0], r23_2[1]} * TP[4] + (f32x2_t){r23_3[0], r23_3[1]} * TP[6] + (f32x2_t){r23_4[0], r23_4[1]} * TP[8] + (f32x2_t){r23_5[0], r23_5[1]} * TP[10]; const f32x2_t pb = (f32x2_t){r23_0[2], r23_0[3]} * TP[1] + (f32x2_t){r23_1[2], r23_1[3]} * TP[3] + (f32x2_t){r23_2[2], r23_2[3]} * TP[5] + (f32x2_t){r23_3[2], r23_3[3]} * TP[7] + (f32x2_t){r23_4[2], r23_4[3]} * TP[9] + (f32x2_t){r23_5[2], r23_5[3]} * TP[11]; const f32x2_t ps = pa + pb;
                  Tr[23] = (ps[0] + ps[1]) + (1.0f - fminf(fabsf(cf - 23.0f), 1.0f)); TP[11][1] = Tr[23]; }
                __builtin_amdgcn_sched_barrier(0);
                int o26 = abase_i + 1768; asm volatile("" : "+v"(o26) : "v"(Tr[23]));
                const f32x4 r26_0 = *(const LAS f32x4*)(Aab + o26 + 0); const f32x4 r26_1 = *(const LAS f32x4*)(Aab + o26 + 4); const f32x4 r26_2 = *(const LAS f32x4*)(Aab + o26 + 8); const f32x4 r26_3 = *(const LAS f32x4*)(Aab + o26 + 12); const f32x4 r26_4 = *(const LAS f32x4*)(Aab + o26 + 16); const f32x4 r26_5 = *(const LAS f32x4*)(Aab + o26 + 20); const f32x4 r26_6 = *(const LAS f32x4*)(Aab + o26 + 24);
                __builtin_amdgcn_sched_barrier(0);
                { const f32x2_t pa = (f32x2_t){r24_0[0], r24_0[1]} * TP[0] + (f32x2_t){r24_1[0], r24_1[1]} * TP[2] + (f32x2_t){r24_2[0], r24_2[1]} * TP[4] + (f32x2_t){r24_3[0], r24_3[1]} * TP[6] + (f32x2_t){r24_4[0], r24_4[1]} * TP[8] + (f32x2_t){r24_5[0], r24_5[1]} * TP[10]; const f32x2_t pb = (f32x2_t){r24_0[2], r24_0[3]} * TP[1] + (f32x2_t){r24_1[2], r24_1[3]} * TP[3] + (f32x2_t){r24_2[2], r24_2[3]} * TP[5] + (f32x2_t){r24_3[2], r24_3[3]} * TP[7] + (f32x2_t){r24_4[2], r24_4[3]} * TP[9] + (f32x2_t){r24_5[2], r24_5[3]} * TP[11]; const f32x2_t ps = pa + pb;
                  Tr[24] = (ps[0] + ps[1]) + (1.0f - fminf(fabsf(cf - 24.0f), 1.0f)); TP[12][0] = Tr[24]; }
                __builtin_amdgcn_sched_barrier(0);
                int o27 = abase_i + 1836; asm volatile("" : "+v"(o27) : "v"(Tr[24]));
                const f32x4 r27_0 = *(const LAS f32x4*)(Aab + o27 + 0); const f32x4 r27_1 = *(const LAS f32x4*)(Aab + o27 + 4); const f32x4 r27_2 = *(const LAS f32x4*)(Aab + o27 + 8); const f32x4 r27_3 = *(const LAS f32x4*)(Aab + o27 + 12); const f32x4 r27_4 = *(const LAS f32x4*)(Aab + o27 + 16); const f32x4 r27_5 = *(const LAS f32x4*)(Aab + o27 + 20); const f32x4 r27_6 = *(const LAS f32x4*)(Aab + o27 + 24);
                __builtin_amdgcn_sched_barrier(0);
                { const f32x2_t pa = (f32x2_t){r25_0[0], r25_0[1]} * TP[0] + (f32x2_t){r25_1[0], r25_1[1]} * TP[2] + (f32x2_t){r25_2[0], r25_2[1]} * TP[4] + (f32x2_t){r25_3[0], r25_3[1]} * TP[6] + (f32x2_t){r25_4[0], r25_4[1]} * TP[8] + (f32x2_t){r25_5[0], r25_5[1]} * TP[10] + (f32x2_t){r25_6[0], r25_6[1]} * TP[12]; const f32x2_t pb = (f32x2_t){r25_0[2], r25_0[3]} * TP[1] + (f32x2_t){r25_1[2], r25_1[3]} * TP[3] + (f32x2_t){r25_2[2], r25_2[3]} * TP[5] + (f32x2_t){r25_3[2], r25_3[3]} * TP[7] + (f32x2_t){r25_4[2], r25_4[3]} * TP[9] + (f32x2_t){r25_5[2], r25_5[3]} * TP[11]; const f32x2_t ps = pa + pb;
                  Tr[25] = (ps[0] + ps[1]) + (1.0f - fminf(fabsf(cf - 25.0f), 1.0f)); TP[12][1] = Tr[25]; }
                __builtin_amdgcn_sched_barrier(0);
                int o28 = abase_i + 1904; asm volatile("" : "+v"(o28) : "v"(Tr[25]));
                const f32x4 r28_0 = *(const LAS f32x4*)(Aab + o28 + 0); const f32x4 r28_1 = *(const LAS f32x4*)(Aab + o28 + 4); const f32x4 r28_2 = *(const LAS f32x4*)(Aab + o28 + 8); const f32x4 r28_3 = *(const LAS f32x4*)(Aab + o28 + 12); const f32x4 r28_4 = *(const LAS f32x4*)(Aab + o28 + 16); const f32x4 r28_5 = *(const LAS f32x4*)(Aab + o28 + 20); const f32x4 r28_6 = *(const LAS f32x4*)(Aab + o28 + 24);
                __builtin_amdgcn_sched_barrier(0);
                { const f32x2_t pa = (f32x2_t){r26_0[0], r26_0[1]} * TP[0] + (f32x2_t){r26_1[0], r26_1[1]} * TP[2] + (f32x2_t){r26_2[0], r26_2[1]} * TP[4] + (f32x2_t){r26_3[0], r26_3[1]} * TP[6] + (f32x2_t){r26_4[0], r26_4[1]} * TP[8] + (f32x2_t){r26_5[0], r26_5[1]} * TP[10] + (f32x2_t){r26_6[0], r26_6[1]} * TP[12]; const f32x2_t pb = (f32x2_t){r26_0[2], r26_0[3]} * TP[1] + (f32x2_t){r26_1[2], r26_1[3]} * TP[3] + (f32x2_t){r26_2[2], r26_2[3]} * TP[5] + (f32x2_t){r26_3[2], r26_3[3]} * TP[7] + (f32x2_t){r26_4[2], r26_4[3]} * TP[9] + (f32x2_t){r26_5[2], r26_5[3]} * TP[11]; const f32x2_t ps = pa + pb;
                  Tr[26] = (ps[0] + ps[1]) + (1.0f - fminf(fabsf(cf - 26.0f), 1.0f)); TP[13][0] = Tr[26]; }
                __builtin_amdgcn_sched_barrier(0);
                int o29 = abase_i + 1972; asm volatile("" : "+v"(o29) : "v"(Tr[26]));
                const f32x4 r29_0 = *(const LAS f32x4*)(Aab + o29 + 0); const f32x4 r29_1 = *(const LAS f32x4*)(Aab + o29 + 4); const f32x4 r29_2 = *(const LAS f32x4*)(Aab + o29 + 8); const f32x4 r29_3 = *(const LAS f32x4*)(Aab + o29 + 12); const f32x4 r29_4 = *(const LAS f32x4*)(Aab + o29 + 16); const f32x4 r29_5 = *(const LAS f32x4*)(Aab + o29 + 20); const f32x4 r29_6 = *(const LAS f32x4*)(Aab + o29 + 24); const f32x4 r29_7 = *(const LAS f32x4*)(Aab + o29 + 28);
                __builtin_amdgcn_sched_barrier(0);
                { const f32x2_t pa = (f32x2_t){r27_0[0], r27_0[1]} * TP[0] + (f32x2_t){r27_1[0], r27_1[1]} * TP[2] + (f32x2_t){r27_2[0], r27_2[1]} * TP[4] + (f32x2_t){r27_3[0], r27_3[1]} * TP[6] + (f32x2_t){r27_4[0], r27_4[1]} * TP[8] + (f32x2_t){r27_5[0], r27_5[1]} * TP[10] + (f32x2_t){r27_6[0], r27_6[1]} * TP[12]; const f32x2_t pb = (f32x2_t){r27_0[2], r27_0[3]} * TP[1] + (f32x2_t){r27_1[2], r27_1[3]} * TP[3] + (f32x2_t){r27_2[2], r27_2[3]} * TP[5] + (f32x2_t){r27_3[2], r27_3[3]} * TP[7] + (f32x2_t){r27_4[2], r27_4[3]} * TP[9] + (f32x2_t){r27_5[2], r27_5[3]} * TP[11] + (f32x2_t){r27_6[2], r27_6[3]} * TP[13]; const f32x2_t ps = pa + pb;
                  Tr[27] = (ps[0] + ps[1]) + (1.0f - fminf(fabsf(cf - 27.0f), 1.0f)); TP[13][1] = Tr[27]; }
                __builtin_amdgcn_sched_barrier(0);
                int o30 = abase_i + 2040; asm volatile("" : "+v"(o30) : "v"(Tr[27]));
                const f32x4 r30_0 = *(const LAS f32x4*)(Aab + o30 + 0); const f32x4 r30_1 = *(const LAS f32x4*)(Aab + o30 + 4); const f32x4 r30_2 = *(const LAS f32x4*)(Aab + o30 + 8); const f32x4 r30_3 = *(const LAS f32x4*)(Aab + o30 + 12); const f32x4 r30_4 = *(const LAS f32x4*)(Aab + o30 + 16); const f32x4 r30_5 = *(const LAS f32x4*)(Aab + o30 + 20); const f32x4 r30_6 = *(const LAS f32x4*)(Aab + o30 + 24); const f32x4 r30_7 = *(const LAS f32x4*)(Aab + o30 + 28);
                __builtin_amdgcn_sched_barrier(0);
                { const f32x2_t pa = (f32x2_t){r28_0[0], r28_0[1]} * TP[0] + (f32x2_t){r28_1[0], r28_1[1]} * TP[2] + (f32x2_t){r28_2[0], r28_2[1]} * TP[4] + (f32x2_t){r28_3[0], r28_3[1]} * TP[6] + (f32x2_t){r28_4[0], r28_4[1]} * TP[8] + (f32x2_t){r28_5[0], r28_5[1]} * TP[10] + (f32x2_t){r28_6[0], r28_6[1]} * TP[12]; const f32x2_t pb = (f32x2_t){r28_0[2], r28_0[3]} * TP[1] + (f32x2_t){r28_1[2], r28_1[3]} * TP[3] + (f32x2_t){r28_2[2], r28_2[3]} * TP[5] + (f32x2_t){r28_3[2], r28_3[3]} * TP[7] + (f32x2_t){r28_4[2], r28_4[3]} * TP[9] + (f32x2_t){r28_5[2], r28_5[3]} * TP[11] + (f32x2_t){r28_6[2], r28_6[3]} * TP[13]; const f32x2_t ps = pa + pb;
                  Tr[28] = (ps[0] + ps[1]) + (1.0f - fminf(fabsf(cf - 28.0f), 1.0f)); TP[14][0] = Tr[28]; }
                __builtin_amdgcn_sched_barrier(0);
                int o31 = abase_i + 2108; asm volatile("" : "+v"(o31) : "v"(Tr[28]));
                const f32x4 r31_0 = *(const LAS f32x4*)(Aab + o31 + 0); const f32x4 r31_1 = *(const LAS f32x4*)(Aab + o31 + 4); const f32x4 r31_2 = *(const LAS f32x4*)(Aab + o31 + 8); const f32x4 r31_3 = *(const LAS f32x4*)(Aab + o31 + 12); const f32x4 r31_4 = *(const LAS f32x4*)(Aab + o31 + 16); const f32x4 r31_5 = *(const LAS f32x4*)(Aab + o31 + 20); const f32x4 r31_6 = *(const LAS f32x4*)(Aab + o31 + 24); const f32x4 r31_7 = *(const LAS f32x4*)(Aab + o31 + 28);
                __builtin_amdgcn_sched_barrier(0);
                { const f32x2_t pa = (f32x2_t){r29_0[0], r29_0[1]} * TP[0] + (f32x2_t){r29_1[0], r29_1[1]} * TP[2] + (f32x2_t){r29_2[0], r29_2[1]} * TP[4] + (f32x2_t){r29_3[0], r29_3[1]} * TP[6] + (f32x2_t){r29_4[0], r29_4[1]} * TP[8] + (f32x2_t){r29_5[0], r29_5[1]} * TP[10] + (f32x2_t){r29_6[0], r29_6[1]} * TP[12] + (f32x2_t){r29_7[0], r29_7[1]} * TP[14]; const f32x2_t pb = (f32x2_t){r29_0[2], r29_0[3]} * TP[1] + (f32x2_t){r29_1[2], r29_1[3]} * TP[3] + (f32x2_t){r29_2[2], r29_2[3]} * TP[5] + (f32x2_t){r29_3[2], r29_3[3]} * TP[7] + (f32x2_t){r29_4[2], r29_4[3]} * TP[9] + (f32x2_t){r29_5[2], r29_5[3]} * TP[11] + (f32x2_t){r29_6[2], r29_6[3]} * TP[13]; const f32x2_t ps = pa + pb;
                  Tr[29] = (ps[0] + ps[1]) + (1.0f - fminf(fabsf(cf - 29.0f), 1.0f)); TP[14][1] = Tr[29]; }
                __builtin_amdgcn_sched_barrier(0);
                __builtin_amdgcn_sched_barrier(0);
                { const f32x2_t pa = (f32x2_t){r30_0[0], r30_0[1]} * TP[0] + (f32x2_t){r30_1[0], r30_1[1]} * TP[2] + (f32x2_t){r30_2[0], r30_2[1]} * TP[4] + (f32x2_t){r30_3[0], r30_3[1]} * TP[6] + (f32x2_t){r30_4[0], r30_4[1]} * TP[8] + (f32x2_t){r30_5[0], r30_5[1]} * TP[10] + (f32x2_t){r30_6[0], r30_6[1]} * TP[12] + (f32x2_t){r30_7[0], r30_7[1]} * TP[14]; const f32x2_t pb = (f32x2_t){r30_0[2], r30_0[3]} * TP[1] + (f32x2_t){r30_1[2], r30_1[3]} * TP[3] + (f32x2_t){r30_2[2], r30_2[3]} * TP[5] + (f32x2_t){r30_3[2], r30_3[3]} * TP[7] + (f32x2_t){r30_4[2], r30_4[3]} * TP[9] + (f32x2_t){r30_5[2], r30_5[3]} * TP[11] + (f32x2_t){r30_6[2], r30_6[3]} * TP[13]; const f32x2_t ps = pa + pb;
                  Tr[30] = (ps[0] + ps[1]) + (1.0f - fminf(fabsf(cf - 30.0f), 1.0f)); TP[15][0] = Tr[30]; }
                __builtin_amdgcn_sched_barrier(0);
                __builtin_amdgcn_sched_barrier(0);
                { const f32x2_t pa = (f32x2_t){r31_0[0], r31_0[1]} * TP[0] + (f32x2_t){r31_1[0], r31_1[1]} * TP[2] + (f32x2_t){r31_2[0], r31_2[1]} * TP[4] + (f32x2_t){r31_3[0], r31_3[1]} * TP[6] + (f32x2_t){r31_4[0], r31_4[1]} * TP[8] + (f32x2_t){r31_5[0], r31_5[1]} * TP[10] + (f32x2_t){r31_6[0], r31_6[1]} * TP[12] + (f32x2_t){r31_7[0], r31_7[1]} * TP[14]; const f32x2_t pb = (f32x2_t){r31_0[2], r31_0[3]} * TP[1] + (f32x2_t){r31_1[2], r31_1[3]} * TP[3] + (f32x2_t){r31_2[2], r31_2[3]} * TP[5] + (f32x2_t){r31_3[2], r31_3[3]} * TP[7] + (f32x2_t){r31_4[2], r31_4[3]} * TP[9] + (f32x2_t){r31_5[2], r31_5[3]} * TP[11] + (f32x2_t){r31_6[2], r31_6[3]} * TP[13] + (f32x2_t){r31_7[2], r31_7[3]} * TP[15]; const f32x2_t ps = pa + pb;
                  Tr[31] = (ps[0] + ps[1]) + (1.0f - fminf(fabsf(cf - 31.0f), 1.0f)); TP[15][1] = Tr[31]; }
                __builtin_amdgcn_sched_barrier(0);
            }
#pragma unroll
            for (int t = 0; t < 32; ++t) {
                Tm[(32 * hb + t) * LDP + 32 * hb + c] = (bf16_t)f2bf(Tr[t]);
            }
            if (hb == 0) {
#pragma unroll
                for (int q = 0; q < 4; ++q) { u32x4 w; w.x = pk2(Tr[8 * q], Tr[8 * q + 1]); w.y = pk2(Tr[8 * q + 2], Tr[8 * q + 3]); w.z = pk2(Tr[8 * q + 4], Tr[8 * q + 5]); w.w = pk2(Tr[8 * q + 6], Tr[8 * q + 7]);
                    *(LAS u32x4*)(TT + c * LDQ + 8 * q) = w; }
            }
            LDS_WAIT();
            f32x4 W[2][2];
#pragma unroll
            for (int mi = 0; mi < 2; ++mi)
#pragma unroll
                for (int ni = 0; ni < 2; ++ni) {
                    W[mi][ni] = (f32x4){0.f, 0.f, 0.f, 0.f};
                    MMA16(*(const LAS bf16x8*)(AbBA + (16 * mi + fr) * LDQ + fq * 8), *(const LAS bf16x8*)(TT + (16 * ni + fr) * LDQ + fq * 8), W[mi][ni]);
                    st4lds(WsT + (16 * ni + fr) * LDQ + 16 * mi + 4 * fq, W[mi][ni]);
                }
            LDS_WAIT();
#pragma unroll
            for (int mi = 0; mi < 2; ++mi)
#pragma unroll
                for (int ni = 0; ni < 2; ++ni) {
                    f32x4 r4 = (f32x4){0.f, 0.f, 0.f, 0.f};
                    MMA16(*(const LAS bf16x8*)(WsT + (16 * mi + fr) * LDQ + fq * 8), *(const LAS bf16x8*)(Tm + (32 + 16 * ni + fr) * LDP + 32 + fq * 8), r4);
                    st4lds(Tm + (32 + 16 * ni + fr) * LDP + 16 * mi + 4 * fq, r4);
                }
        }
        SBAR();
        {
            const int i0 = 16 * nio + fr;
            const bf16x8 s0 = ldfrag(Sb, i0, 0, fq), s1 = ldfrag(Sb, i0, 1, fq), v0 = ldfragT(VT, i0, 0, fq), v1 = ldfragT(VT, i0, 1, fq);
            bf16x8 fa[2][2], fk[2][2], fh[2][2]; f32x4 eg[2];
#pragma unroll
            for (int mm = 0; mm < 2; ++mm) {
                const int m0 = 16 * (mo0 + mm) + fr;
                fa[mm][0] = ldfrag(At, m0, 0, fq); fa[mm][1] = ldfrag(At, m0, 1, fq);
                fk[mm][0] = ldfrag(Aak, m0, 0, fq); fk[mm][1] = ldfrag(Aak, m0, 1, fq);
                fh[mm][0] = ldfragT(KhT, m0, 0, fq); fh[mm][1] = ldfragT(KhT, m0, 1, fq);
                eg[mm] = *(const LAS f32x4*)(EGL + 16 * (mo0 + mm) + 4 * fq);
            }
            __builtin_amdgcn_sched_barrier(0);
            f32x4 Pacc[2];
#pragma unroll
            for (int mm = 0; mm < 2; ++mm) {
                Pacc[mm] = (f32x4){0.f, 0.f, 0.f, 0.f};
                MMA16(fa[mm][0], s0, Pacc[mm]); MMA16(fa[mm][1], s1, Pacc[mm]);
                MMA16(fk[mm][0], v0, Pacc[mm]); MMA16(fk[mm][1], v1, Pacc[mm]);
                Sacc[mm] = Sacc[mm] * eg[mm];
                MMA16(fh[mm][0], v0, Sacc[mm]); MMA16(fh[mm][1], v1, Sacc[mm]);
            }
            __builtin_amdgcn_sched_barrier(0);
#pragma unroll
            for (int mm = 0; mm < 2; ++mm) st4lds(PT + i0 * LDP + 16 * (mo0 + mm) + 4 * fq, Pacc[mm]);
        }
        SBAR();
        { const int nc_ = chunk + 1 < nch ? chunk + 1 : chunk; SCAN_ISSUE(nc_); }
        {
            const int i0 = 16 * nio + fr;
            const bf16x8 p0 = ldfrag(PT, i0, 0, fq), p1 = ldfrag(PT, i0, 1, fq);
            bf16x8 ft[2][2];
#pragma unroll
            for (int mm = 0; mm < 2; ++mm) { ft[mm][0] = ldfrag(Tm, 16 * (mo0 + mm) + fr, 0, fq); ft[mm][1] = ldfrag(Tm, 16 * (mo0 + mm) + fr, 1, fq); }
            __builtin_amdgcn_sched_barrier(0);
            f32x4 Uacc[2];
#pragma unroll
            for (int mm = 0; mm < 2; ++mm) {
                Uacc[mm] = (f32x4){0.f, 0.f, 0.f, 0.f};
                MMA16(ft[mm][0], p0, Uacc[mm]); MMA16(ft[mm][1], p1, Uacc[mm]);
            }
            __builtin_amdgcn_sched_barrier(0);
#pragma unroll
            for (int mm = 0; mm < 2; ++mm) st4lds(UT + i0 * LDP + 16 * (mo0 + mm) + 4 * fq, Uacc[mm]);
        }
        SBAR();
        {
            const int i0 = 16 * nio + fr;
            const bf16x8 u0 = ldfrag(UT, i0, 0, fq), u1 = ldfrag(UT, i0, 1, fq);
            const int tl = 16 * nio + fr;
            const bf16x8 rt0 = ldfrag(Rt, tl, 0, fq), rt1 = ldfrag(Rt, tl, 1, fq), ak0 = ldfrag(Ark, tl, 0, fq), ak1 = ldfrag(Ark, tl, 1, fq), ab0 = ldfrag(Arb, tl, 0, fq), ab1 = ldfrag(Arb, tl, 1, fq);
            bf16x8 fb[2][2], fs[2][2], fv[2][2], fu[2][2];
#pragma unroll
            for (int mm = 0; mm < 2; ++mm) {
                const int m0 = 16 * (mo0 + mm) + fr;
                fb[mm][0] = ldfragT(BhT, m0, 0, fq); fb[mm][1] = ldfragT(BhT, m0, 1, fq);
                fs[mm][0] = ldfrag(Sb, m0, 0, fq); fs[mm][1] = ldfrag(Sb, m0, 1, fq);
                fv[mm][0] = ldfragT(VT, m0, 0, fq); fv[mm][1] = ldfragT(VT, m0, 1, fq);
                fu[mm][0] = ldfrag(UT, m0, 0, fq); fu[mm][1] = ldfrag(UT, m0, 1, fq);
            }
            __builtin_amdgcn_sched_barrier(0);
            f32x4 Yacc[2];
#pragma unroll
            for (int mm = 0; mm < 2; ++mm) {
                MMA16(fb[mm][0], u0, Sacc[mm]); MMA16(fb[mm][1], u1, Sacc[mm]);
                Yacc[mm] = (f32x4){0.f, 0.f, 0.f, 0.f};
                MMA16(fs[mm][0], rt0, Yacc[mm]); MMA16(fs[mm][1], rt1, Yacc[mm]);
                MMA16(fv[mm][0], ak0, Yacc[mm]); MMA16(fv[mm][1], ak1, Yacc[mm]);
                MMA16(fu[mm][0], ab0, Yacc[mm]); MMA16(fu[mm][1], ab1, Yacc[mm]);
            }
            __builtin_amdgcn_sched_barrier(0);
            SBAR();
            const int ypos = chunk * 64 + tl, yt = dir ? T - 1 - ypos : ypos;
            const size_t yoff = (size_t)(row_base + yt) * DM + h * 64;
#pragma unroll
            for (int mm = 0; mm < 2; ++mm) {
                st4lds(Sb + i0 * LDP + 16 * (mo0 + mm) + 4 * fq, Sacc[mm]);
                const int ic = 16 * (mo0 + mm) + 4 * fq;
                if (mode == 2) {
                    const int tloc = dir ? yt : yt - 2048;
                    st4bf((bf16_t*)(a.ws + WS_ZB) + ((size_t)((b * 16 + h) * 2 + dir) * 2048 + tloc) * 64 + ic, Yacc[mm]);
                } else if (ysc != 0.f) {
                    st4bf((dir == 0 ? (bf16_t*)a.out + YF_OFF : (bf16_t*)(a.ws + WS_H)) + yoff + ic, Yacc[mm]);
                }
            }
        }
    }
    if (!lat) {
        const int i = 16 * nio + fr;
#pragma unroll
        for (int mm = 0; mm < 2; ++mm)
            *(f32x4*)(a.out + (size_t)NTOK * DM + ((((size_t)b * 2 + dir) * 16 + h) * 64 + i) * 64 + 16 * (mo0 + mm) + 4 * fq) = Sacc[mm];
    } else if (mode == 0 && cend < T / 64) {
        const int i = 16 * nio + fr;
#pragma unroll
        for (int mm = 0; mm < 2; ++mm)
            st4bf((bf16_t*)(a.ws + WS_SAB) + ((size_t)((b * 16 + h) * 2 + dir) * 64 + i) * 64 + 16 * (mo0 + mm) + 4 * fq, Sacc[mm]);
    }
    __syncthreads();
}
__device__ __forceinline__ void phase_scan(const Args& a, LAS unsigned char* lds) {
    const int nb = gridDim.x, bx = blockIdx.x;
    for (int it = 0;; ++it) {
        int lat, c, cbeg = 0, cend, mode = 0;
        if (nb >= 256) {
            if (bx < 192) { if (it) break; lat = 1; c = bx & 63; const int role = bx >> 6; cbeg = role ? 32 : 0; cend = role ? 64 : 32; mode = role; }
            else { c = (bx - 192) + it * (nb - 192); if (c >= 512) break; lat = 0; cend = 4; }
        } else if (nb >= 128) {
            if (bx < 64) { if (it) break; lat = 1; c = bx; cend = 64; }
            else { c = (bx - 64) + it * (nb - 64); if (c >= 512) break; lat = 0; cend = 4; }
        } else {
            const int task = bx + it * nb; if (task >= 64 + 512) break;
            lat = task < 64; c = lat ? task : task - 64; cend = lat ? 64 : 4;
        }
        scan_chain(a, lds, lat, c >> 5, (c >> 1) & 15, c & 1, 1.0f, cbeg, cend, mode);
    }
}
__device__ __forceinline__ void phase_fixup(const Args& a) {
    const int tid = threadIdx.x, lane = tid & 63, wv = tid >> 6, gw = blockIdx.x * 8 + wv, ngw = gridDim.x * 8, fr = lane & 15, fq = lane >> 4;
    const bf16_t* SAB = (const bf16_t*)(a.ws + WS_SAB); const bf16_t* ZB = (const bf16_t*)(a.ws + WS_ZB);
    for (int wt = gw; wt < 64 * 32; wt += ngw) {
        const int chain = wt >> 5, blk = wt & 31, dir = chain & 1, h = (chain >> 1) & 15, b = chain >> 5;
        const bf16_t* ap[4]; const bf16_t* bp[4]; f32x4 acc[4][4];
#pragma unroll
        for (int mi = 0; mi < 4; ++mi)
#pragma unroll
            for (int ni = 0; ni < 4; ++ni) acc[mi][ni] = (f32x4){0.f, 0.f, 0.f, 0.f};
#pragma unroll
        for (int mi = 0; mi < 4; ++mi) ap[mi] = SAB + ((size_t)chain * 64 + 16 * mi + fr) * 64;
#pragma unroll
        for (int ni = 0; ni < 4; ++ni) bp[ni] = ZB + ((size_t)chain * 2048 + blk * 64 + 16 * ni + fr) * 64;
        wave_mma<4, 4, 2, 2>(ap, bp, acc, fq);
#pragma unroll
        for (int ni = 0; ni < 4; ++ni) {
            const int tloc = blk * 64 + 16 * ni + fr, t = dir ? tloc : 2048 + tloc;
            const size_t yoff = (size_t)(NTOK_C + b * 4096 + t) * DM + h * 64;
#pragma unroll
            for (int mi = 0; mi < 4; ++mi) {
                const int ic = 16 * mi + 4 * fq;
                bf16_t* p = (dir == 0 ? (bf16_t*)a.out + YF_OFF : (bf16_t*)(a.ws + WS_H)) + yoff + ic; const u32x2 w = *(const u32x2*)p;
                f32x4 o; o[0] = bflo(w.x) + acc[mi][ni][0]; o[1] = bfhi(w.x) + acc[mi][ni][1]; o[2] = bflo(w.y) + acc[mi][ni][2]; o[3] = bfhi(w.y) + acc[mi][ni][3];
                st4bf(p, o);
            }
        }
    }
}

__device__ __forceinline__ void phase_gn(const Args& a) {
    const int tid = threadIdx.x;
    bf16_t* U = (bf16_t*)(a.ws + WS_U);
    const bf16_t* YB = (const bf16_t*)(a.ws + WS_H);
    const bf16_t* YF = (const bf16_t*)a.out + YF_OFF;
    const bf16_t* BON = (const bf16_t*)a.out + BON_OFF;
    for (int idx = blockIdx.x * 512 + tid; idx < NTOK * 128; idx += gridDim.x * 512) {
        const int row = idx >> 7, c0 = (idx & 127) * 8;
        const u32x4 yfw = __builtin_nontemporal_load((const u32x4*)(YF + (size_t)row * DM + c0)), ybw = __builtin_nontemporal_load((const u32x4*)(YB + (size_t)row * DM + c0));
        const u32x4 bw = __builtin_nontemporal_load((const u32x4*)(BON + (size_t)row * DM + c0)), gw = __builtin_nontemporal_load((const u32x4*)(U + (size_t)row * LDU + C_GR + c0));
        const f32x4 lg0 = *(const f32x4*)(a.in[17] + c0), lg1 = *(const f32x4*)(a.in[17] + c0 + 4);
        const f32x4 lb0 = *(const f32x4*)(a.in[18] + c0), lb1 = *(const f32x4*)(a.in[18] + c0 + 4);
        float y[8], sm = 0.f;
#pragma unroll
        for (int e = 0; e < 8; ++e) { y[e] = bfel(yfw, e) + bfel(ybw, e); sm += y[e]; }
        sm += __shfl_xor(sm, 1); sm += __shfl_xor(sm, 2); sm += __shfl_xor(sm, 4);
        const float mean = sm * (1.0f / 64.0f);
        float vs = 0.f;
#pragma unroll
        for (int e = 0; e < 8; ++e) { y[e] -= mean; vs += y[e] * y[e]; }
        vs += __shfl_xor(vs, 1); vs += __shfl_xor(vs, 2); vs += __shfl_xor(vs, 4);
        const float rstd = rsqrtf(vs * (1.0f / 64.0f) + GN_EPS);
        float o[8];
#pragma unroll
        for (int e = 0; e < 8; ++e) { const float yn = y[e] * rstd * (e < 4 ? lg0[e] : lg1[e - 4]) + (e < 4 ? lb0[e] : lb1[e - 4]); o[e] = (yn + bfel(bw, e)) * bfel(gw, e); }
        *(u32x4*)(U + (size_t)row * LDU + C_GR + c0) = pack8(o);
    }
}

__device__ __forceinline__ void phase_final(const Args& a) {
    const int tid = threadIdx.x, lane = tid & 63, wv = tid >> 6, gw = blockIdx.x * 8 + wv, ngw = gridDim.x * 8;
    const float* fg = a.in[22];
    for (int row = gw; row < NTOK; row += ngw) {
        float* xr = a.out + (size_t)row * DM;
        f32x4 v[4]; float ss = 0.f;
#pragma unroll
        for (int j = 0; j < 4; ++j) { v[j] = *(const f32x4*)(xr + lane * 4 + 256 * j); ss += (v[j][0] * v[j][0] + v[j][1] * v[j][1]) + (v[j][2] * v[j][2] + v[j][3] * v[j][3]); }
        const float rstd = rsqrtf(wave_sum(ss) * (1.0f / DM) + RMS_EPS);
#pragma unroll
        for (int j = 0; j < 4; ++j) { const f32x4 g4 = *(const f32x4*)(fg + lane * 4 + 256 * j); *(f32x4*)(xr + lane * 4 + 256 * j) = v[j] * rstd * g4; }
    }
}

#define XB_TMO      128
#define XB_XCNT(j)  (256  + 64 * (j))
#define XB_XSUB(j)  (1280 + 64 * (j))
#define XB_XGEN(j)  (2304 + 64 * (j))
#define XB_TOP      3328
#define XB_TOPGEN   3392
#define XCD_BAR_WORDS 3456
#define XB_SPIN_CAP (1u << 18)
__device__ __forceinline__ unsigned xb_ld(unsigned* p)              { return __hip_atomic_load(p, __ATOMIC_RELAXED, __HIP_MEMORY_SCOPE_AGENT); }
__device__ __forceinline__ unsigned xb_add(unsigned* p, unsigned v) { return __hip_atomic_fetch_add(p, v, __ATOMIC_RELAXED, __HIP_MEMORY_SCOPE_AGENT); }
__device__ __forceinline__ unsigned xb_xcc_id() { return (unsigned)__builtin_amdgcn_s_getreg((3 << 11) | 20) & 0xFu; }
#define XB_SPIN(cond, bar) do { unsigned _sp = 0; while (cond) { __builtin_amdgcn_s_sleep(1); \
    if ((++_sp & 255u) == 0u) { if (xb_ld(&(bar)[XB_TMO])) break; if (_sp > XB_SPIN_CAP) { atomicAdd(&(bar)[XB_TMO], 1u); break; } } } } while (0)
struct XcdBarrier { unsigned* bar; unsigned x; volatile LAS unsigned* st; };
__device__ __forceinline__ XcdBarrier xcd_barrier_post(unsigned* bar, volatile LAS unsigned* st) {
    XcdBarrier b; b.bar = bar; b.x = xb_xcc_id(); b.st = st;
    if (threadIdx.x == 0) (void)xb_add(&bar[XB_XCNT(b.x)], 1u);
    return b;
}
__device__ __forceinline__ void xcd_barrier_complete(unsigned* bar, unsigned x, unsigned& nloc, unsigned& nx) {
    const unsigned G = gridDim.x * gridDim.y * gridDim.z;
    unsigned sum, cnt, mine, sp = 0u;
    for (;;) {
        sum = 0u; cnt = 0u; mine = 0u;
#pragma unroll
        for (unsigned j = 0; j < 16; ++j) { const unsigned c = xb_ld(&bar[XB_XCNT(j)]); sum += c; cnt += (c > 0u) ? 1u : 0u; mine = (j == x) ? c : mine; }
        if (sum == G) break;
        __builtin_amdgcn_s_sleep(1);
        if ((++sp & 255u) == 0u) { if (xb_ld(&bar[XB_TMO])) break; if (sp > XB_SPIN_CAP) { atomicAdd(&bar[XB_TMO], 1u); break; } }
    }
    nloc = mine > 0u ? mine : 1u; nx = cnt > 0u ? cnt : 1u;
}
__device__ __forceinline__ void xcd_barrier(const XcdBarrier& b) {
    asm volatile("s_waitcnt vmcnt(0)" ::: "memory");
    __syncthreads();
    if (threadIdx.x == 0) {
        unsigned* bar = b.bar;
        __builtin_amdgcn_s_waitcnt(0);
        unsigned nloc = b.st[0], nx = b.st[1];
        if (nloc == 0u) { xcd_barrier_complete(bar, b.x, nloc, nx); b.st[0] = nloc; b.st[1] = nx; }
        const unsigned old = xb_add(&bar[XB_XSUB(b.x)], 1u);
        const unsigned gen = old / nloc;
        if (old + 1u == (gen + 1u) * nloc) {
            __builtin_amdgcn_fence(__ATOMIC_RELEASE, "agent");
            asm volatile("s_waitcnt vmcnt(0)" ::: "memory");
            const unsigned og = xb_add(&bar[XB_TOP], 1u);
            const unsigned tg = og / nx;
            if (og + 1u == (tg + 1u) * nx) xb_add(&bar[XB_TOPGEN], 1u);
            else XB_SPIN(xb_ld(&bar[XB_TOPGEN]) == tg, bar);
            __builtin_amdgcn_fence(__ATOMIC_ACQUIRE, "agent");
            xb_add(&bar[XB_XGEN(b.x)], 1u);
            asm volatile("s_waitcnt vmcnt(0)" ::: "memory");
        } else {
            XB_SPIN(xb_ld(&bar[XB_XGEN(b.x)]) == gen, bar);
            __builtin_amdgcn_fence(__ATOMIC_ACQUIRE, "agent");
            asm volatile("s_waitcnt vmcnt(0)" ::: "memory");
        }
    }
    __syncthreads();
}

__global__ void __launch_bounds__(512) mega(Args a) {
    extern __shared__ __attribute__((aligned(16))) unsigned char lds_raw[];
    LAS unsigned char* lds = (LAS unsigned char*)lds_raw;
    unsigned char* ws = a.ws;
    bf16_t* U = (bf16_t*)(ws + WS_U);
    if (threadIdx.x < 4) ((LAS unsigned*)(lds + LDS_XB))[threadIdx.x] = 0u;
    __syncthreads();
    XcdBarrier xbar; xbar.bar = (unsigned*)(ws + WS_BAR); xbar.x = 0; xbar.st = (volatile LAS unsigned*)(lds + LDS_XB);
    if (a.ph_hi - a.ph_lo > 1) xbar = xcd_barrier_post((unsigned*)(ws + WS_BAR), (volatile LAS unsigned*)(lds + LDS_XB));
#define PH_BEGIN(k) if (a.ph_lo <= (k) && (k) < a.ph_hi) { if (a.ph_lo < (k)) { if (a.ph_lo == 0x7fff0000) cg::this_grid().sync(); else xcd_barrier(xbar); }
#define PH_END }
#ifndef REPMASK
#define REPMASK 0
#endif
#define NREP(k) (((REPMASK >> (k)) & 1) ? 2 : 1)
    PH_BEGIN(0) for (int r_ = 0; r_ < NREP(0); ++r_) { __syncthreads(); phase0(a, lds); } PH_END
    PH_BEGIN(1) for (int r_ = 0; r_ < NREP(1); ++r_) { __syncthreads(); phase0_conv(a, lds); __syncthreads(); phase1(a, lds); } PH_END
    PH_BEGIN(2)
        pg8::StaticOrder S; S.init(NTOK, LDU, gridDim.x, blockIdx.x);
        pg8::Gemm g{(const bf16_t*)(ws + WS_H), (const bf16_t*)(ws + WS_WINT), NTOK, LDU, 1024, 1024, 1024};
        Epi1 E{U};
#ifndef REP_PH2
#define REP_PH2 1
#endif
#pragma unroll 1
        for (int rep_ = 0; rep_ < REP_PH2; ++rep_) { if (rep_) __syncthreads(); pg8::gemm_phase(lds, g, S, E); }
        __syncthreads();
        if (gridDim.x == 256) { if (blockIdx.x >= 112) conv_rest(a, lds, blockIdx.x - 112, 144); } else conv_rest(a, lds, blockIdx.x, gridDim.x);
    PH_END
    PH_BEGIN(3) for (int r_ = 0; r_ < NREP(3); ++r_) fourier_l1(a, lds); PH_END
    PH_BEGIN(4) for (int r_ = 0; r_ < NREP(4); ++r_) fourier_l2(a, lds); phase_premix(a); PH_END
    PH_BEGIN(5) for (int r_ = 0; r_ < NREP(5); ++r_) fourier_l3(a, lds); __syncthreads(); PH_END
    if (a.ph_lo <= 6 && 6 < a.ph_hi) { if (a.ph_lo == 6) {} else if (!(a.ph_lo <= 5)) xcd_barrier(xbar);
#ifndef SCAN_REPS
#define SCAN_REPS 1
#endif
        for (int rep = 0; rep < SCAN_REPS; ++rep) {
            if (rep) {
                cg::this_grid().sync();
                { f32x4* yo = (f32x4*)a.out; for (int i = blockIdx.x * 512 + threadIdx.x; i < NTOK * DM / 4; i += gridDim.x * 512) yo[i] = (f32x4){0.f, 0.f, 0.f, 0.f}; }
                cg::this_grid().sync();
            }
            phase_scan(a, lds);
        }
    PH_END
    PH_BEGIN(7) if (gridDim.x >= 256 && a.ph_hi - a.ph_lo > 1) { phase_fixup(a); xcd_barrier(xbar); } phase_gn(a); PH_END
    PH_BEGIN(8)
        pg8::StaticOrder S; S.init(NTOK, 1024, gridDim.x, blockIdx.x);
#pragma unroll 1
        for (int r_ = 0; r_ < NREP(8); ++r_) {
        __syncthreads();
        {
            pg8::Gemm g{U + C_XF, (const bf16_t*)(ws + WS_WPF), NTOK, 1024, 512, LDU, 512};
            Epi2<0> E{U};
            pg8::gemm_phase(lds, g, S, E);
        }
        {
            pg8::Gemm g{U + C_GR, (const bf16_t*)(ws + WS_WPR), NTOK, 1024, 1024, LDU, 1024};
            Epi2<1> E{U};
            pg8::gemm_phase(lds, g, S, E);
        }
        }
    PH_END
    PH_BEGIN(9)
        pg8::StaticOrder S; S.init(NTOK, 1024, gridDim.x, blockIdx.x);
        pg8::Gemm g{U + C_MERGED, (const bf16_t*)(ws + WS_WOUT), NTOK, 1024, 1024, LDU, 1024};
        Epi3 E{a.in[0], a.in[1], (const float*)(ws + WS_MODF), a.out};
#pragma unroll 1
        for (int r_ = 0; r_ < NREP(9); ++r_) { __syncthreads(); pg8::gemm_phase(lds, g, S, E); }
#ifdef SYNC_EXTRA
        for (int r_ = 0; r_ < SYNC_EXTRA; ++r_) cg::this_grid().sync();
#endif
    PH_END
    PH_BEGIN(10) phase_final(a); PH_END
}

extern "C" void kernel_launch(void* const* d_in, const int* in_sizes, int n_in, void* d_out, int out_size, void* d_ws, size_t ws_size, hipStream_t stream) {
    static int grid = 0;
    if (grid == 0) {
        if (n_in != 23 || ws_size < WS_END) { fprintf(stderr, "kernel_launch: unexpected n_in %d / ws_size %zu (need %zu)\n", n_in, ws_size, (size_t)WS_END); grid = -1; return; }
        int dev = 0, cus = 0, per_cu = 0;
        hipGetDevice(&dev);
        hipDeviceGetAttribute(&cus, hipDeviceAttributeMultiprocessorCount, dev);
        if (hipFuncSetAttribute((const void*)mega, hipFuncAttributeMaxDynamicSharedMemorySize, LDS_BYTES) != hipSuccess) { fprintf(stderr, "kernel_launch: hipFuncSetAttribute failed\n"); grid = -1; return; }
        if (hipOccupancyMaxActiveBlocksPerMultiprocessor(&per_cu, (const void*)mega, 512, LDS_BYTES) != hipSuccess || per_cu < 1) { fprintf(stderr, "kernel_launch: occupancy query says %d\n", per_cu); per_cu = 1; }
        (void)hipGetLastError();
        grid = cus;
    }
    if (grid < 0) return;
    Args a{};
    for (int i = 0; i < 23; ++i) a.in[i] = (const float*)d_in[i];
    a.out = (float*)d_out; a.ws = (unsigned char*)d_ws;
    (void)hipMemsetAsync((unsigned char*)d_ws + WS_BAR, 0, 16384, stream);
#if MULTI_LAUNCH
    for (int ph = 0; ph < NPH; ++ph) {
        a.ph_lo = ph; a.ph_hi = ph + 1;
        hipLaunchKernelGGL(mega, dim3(grid), dim3(512), LDS_BYTES, stream, a);
    }
#else
    a.ph_lo = 0; a.ph_hi = NPH;
    void* args[] = {&a};
    hipError_t e = hipLaunchCooperativeKernel((void*)mega, dim3(grid), dim3(512), args, LDS_BYTES, stream);
    if (e != hipSuccess) fprintf(stderr, "cooperative launch failed: %s (grid %d)\n", hipGetErrorString(e), grid);
#endif
}
```

```cpp
#include <hip/hip_runtime.h>
#include <hip/hip_cooperative_groups.h>
#include <cstdio>
namespace cg = cooperative_groups;

#ifndef MULTI_LAUNCH
#define MULTI_LAUNCH 0
#endif

#define LAS __attribute__((address_space(3)))
typedef unsigned short bf16_t;
typedef short bf16x8 __attribute__((ext_vector_type(8)));
typedef float f32x4 __attribute__((ext_vector_type(4)));
typedef unsigned u32x4 __attribute__((ext_vector_type(4)));
typedef unsigned u32x2 __attribute__((ext_vector_type(2)));

constexpr int DM = 1024, NTOK_C = 4096, NTOK_L = 8192, NTOK = 12288;
constexpr int LDU = 7424;
constexpr int C_XF = 0, C_GF = 512, C_SH = 1024, C_GR = 4224, C_MG = 5248;
constexpr int C_MERGED = 1024;
constexpr float RMS_EPS = 1e-6f, GN_EPS = 64e-5f;
constexpr int NPH = 11;
constexpr int LDS_BYTES = 152064;

constexpr size_t WS_WINT = 0;
constexpr size_t WS_WPF  = WS_WINT + (size_t)7424 * 1024 * 2;
constexpr size_t WS_WPR  = WS_WPF + (size_t)1024 * 512 * 2;
constexpr size_t WS_WOUT = WS_WPR + (size_t)1024 * 1024 * 2;
constexpr size_t WS_MODP = WS_WOUT + (size_t)1024 * 1024 * 2;
constexpr size_t WS_MODF = WS_MODP + (size_t)16 * 3 * 3072 * 4;
constexpr size_t WS_TAB  = WS_MODF + (size_t)3 * 3072 * 4;
constexpr size_t WS_WUPT = WS_TAB + 131072;
constexpr size_t WS_AUPT = WS_WUPT + 262144;
constexpr size_t WS_H    = WS_AUPT + 262144;
constexpr size_t WS_U    = WS_H + (size_t)NTOK * 1024 * 2;
constexpr size_t WS_RLAT = WS_U + (size_t)NTOK * LDU * 2;
constexpr size_t WS_BAR  = WS_RLAT + (size_t)1024 * 64 * 128 * 2;
constexpr size_t WS_MIX  = WS_BAR + 16384;
constexpr size_t WS_ZB   = WS_MIX + (size_t)NTOK * 128 * 2;
constexpr size_t WS_SAB  = WS_ZB + (size_t)64 * 2048 * 64 * 2;
constexpr size_t WS_END  = WS_SAB + (size_t)64 * 64 * 64 * 2;
static_assert(WS_END <= (size_t)256 * 1024 * 1024, "workspace map exceeds the guaranteed 256 MiB");
constexpr int LDS_XB = 151552;
constexpr int T_W128 = 0, T_WB64 = 32768, T_WC64 = 49152, T_WB16 = 57344, T_WC16 = 58368, T_END = 58880;
constexpr size_t YF_OFF = 0, BON_OFF = (size_t)NTOK * DM;
constexpr size_t QLAT_ELEMS = (size_t)1024 * 64 * 128;

struct Args { const float* in[23]; float* out; unsigned char* ws; int ph_lo, ph_hi; };

__device__ __forceinline__ unsigned f2bf(float f) { unsigned u = __float_as_uint(f); u += 0x7FFFu + ((u >> 16) & 1u); return u >> 16; }
typedef __bf16 bf16x2_t __attribute__((ext_vector_type(2)));
typedef float f32x2_t __attribute__((ext_vector_type(2)));
__device__ __forceinline__ unsigned pk2(float lo, float hi) { f32x2_t v = {lo, hi}; bf16x2_t b = __builtin_convertvector(v, bf16x2_t); return __builtin_bit_cast(unsigned, b); }
__device__ __forceinline__ float bf2f(unsigned b) { return __uint_as_float(b << 16); }
__device__ __forceinline__ float bflo(unsigned w) { return __uint_as_float(w << 16); }
__device__ __forceinline__ float bfhi(unsigned w) { return __uint_as_float(w & 0xffff0000u); }
__device__ __forceinline__ float wave_sum(float v) {
#pragma unroll
    for (int o = 1; o < 64; o <<= 1) v += __shfl_xor(v, o);
    return v;
}
__device__ __forceinline__ float sigmoidf_(float x) { return __builtin_amdgcn_rcpf(1.0f + __expf(-x)); }
__device__ __forceinline__ float siluf_(float x) { return x * __builtin_amdgcn_rcpf(1.0f + __expf(-x)); }
#define LDS_WAIT() asm volatile("s_waitcnt lgkmcnt(0)" ::: "memory")

namespace pg8 {
constexpr int BM = 256, BK = 64, HALF = 128, HTB = HALF * BK * 2, STAGE_BYTES = 8 * HTB, NXCD = 8, WGM = 8;
__device__ __forceinline__ int lds_byte(int r, int c) { const int st = (r >> 4) * 2 + (c >> 5), rr = r & 15, cc = c & 31, ob = rr * 64 + cc * 2; return st * 1024 + (ob ^ (((ob >> 9) & 1) << 5)); }
__device__ __forceinline__ void stage_rc(int b, int& R, int& C) { const int st = b / 1024, sb = b % 1024, swz = sb ^ (((sb >> 9) & 1) << 5); R = (st >> 1) * 16 + swz / 64; C = (st & 1) * 32 + (swz % 64) / 2; }
__device__ __forceinline__ int perm32(int rho) { const int n = rho >> 4, i = rho & 15; return 8 * (i >> 2) + 4 * n + (i & 3); }
struct Unit { int pm, pn; };
struct Gemm { const bf16_t* A; const bf16_t* Bt; int M, N, K, lda, ldb; };
struct StaticOrder {
    int nM, nN, nwg, G, c;
    __device__ __forceinline__ void init(int M, int N, int G_, int c_) { nM = M / BM; nN = N / BM; nwg = nM * nN; G = G_; c = c_; }
    __device__ __forceinline__ bool next(int i, Unit& u) const {
        const long L = (long)i * G + c; if (L >= nwg) return false;
        int wgid = (int)L; { const int q = nwg / NXCD, r = nwg % NXCD, xcd = wgid % NXCD, off = wgid / NXCD; wgid = (xcd < r ? xcd * (q + 1) : r * (q + 1) + (xcd - r) * q) + off; }
        const int nig = WGM * nN, gid = wgid / nig, fm = gid * WGM, gsz = (nM - fm) < WGM ? (nM - fm) : WGM;
        u.pm = fm + ((wgid % nig) % gsz); u.pn = (wgid % nig) / gsz; return true;
    }
};

template <class Epi>
__device__ __forceinline__ void gemm_phase(LAS unsigned char* lds, const Gemm g, const StaticOrder& S, const Epi& E) {
    int tid_ = threadIdx.x; asm volatile("" : "+v"(tid_));
    const int tid = tid_, wid = __builtin_amdgcn_readfirstlane(tid >> 6), lane = tid & 63, wr = wid >> 2, wc = wid & 3, fr = lane & 15, fq = lane >> 4;
    const int K = g.K, nt = K / BK;
    unsigned voffA[2], voffB[2];
#pragma unroll
    for (int i = 0; i < 2; ++i) { int R, C; stage_rc(tid * 16 + i * 8192, R, C); const int Rb = Epi::PERM ? ((R & ~31) + perm32(R & 31)) : R;
        voffA[i] = (unsigned)(R * g.lda + C) * 2u; voffB[i] = (unsigned)(Rb * g.ldb + C) * 2u; }
    const size_t kstep = (size_t)(BK * 2);
    const size_t hstepA = (size_t)HALF * g.lda * 2, hstepB = (size_t)HALF * g.ldb * 2;
    const size_t tstepA = 2 * hstepA, tstepB = 2 * hstepB;
    const unsigned ldsw = (unsigned)wid * 1024u;
    const int aoff = lds_byte(wr * 64 + fr, fq * 8), boff = lds_byte(wc * 32 + fr, fq * 8);
#define PG8_SA(b, h) (((b) * 2 + (h)) * HTB)
#define PG8_SB(b, h) ((4 + (b) * 2 + (h)) * HTB)
#define PG8_STAGE(bufoff, gbase, voff) do { _Pragma("unroll") for (int _i = 0; _i < 2; ++_i) \
        __builtin_amdgcn_global_load_lds((const unsigned*)((const char*)(gbase) + (voff)[_i]), (LAS unsigned*)(lds + (bufoff) + ldsw + _i * 8192), 16, 0, 0); } while (0)
#define PG8_LDA(dst, b, h) do { _Pragma("unroll") for (int m = 0; m < 4; ++m) _Pragma("unroll") for (int k = 0; k < 2; ++k) dst[m][k] = *(const LAS bf16x8*)(lds + PG8_SA(b, h) + aoff + m * 2048 + k * 1024); } while (0)
#define PG8_LDB(dst, b, h) do { _Pragma("unroll") for (int n = 0; n < 2; ++n) _Pragma("unroll") for (int k = 0; k < 2; ++k) dst[n][k] = *(const LAS bf16x8*)(lds + PG8_SB(b, h) + boff + n * 2048 + k * 1024); } while (0)
#define PG8_MMA(ai, bj, At, Bt) do { __builtin_amdgcn_s_setprio(1); _Pragma("unroll") for (int m = 0; m < 4; ++m) _Pragma("unroll") for (int n = 0; n < 2; ++n) _Pragma("unroll") for (int k = 0; k < 2; ++k) \
        acc[ai][bj][m][n] = __builtin_amdgcn_mfma_f32_16x16x32_bf16(Bt[n][k], At[m][k], acc[ai][bj][m][n], 0, 0, 0); __builtin_amdgcn_s_setprio(0); } while (0)
#define PG8_WAIT_V(n) asm volatile("s_waitcnt vmcnt(" #n ")" ::: "memory")
#define PG8_WAIT_L(n) asm volatile("s_waitcnt lgkmcnt(" #n ")" ::: "memory")
#define PG8_BAR __builtin_amdgcn_s_barrier()
#define PG8_SCHED __builtin_amdgcn_sched_barrier(0)
    Unit cur, nxt; int ui = 0;
    if (!S.next(0, cur)) return;
    f32x4 acc[2][2][4][2];
#pragma unroll
    for (int a = 0; a < 2; ++a)
#pragma unroll
        for (int b = 0; b < 2; ++b)
#pragma unroll
            for (int m = 0; m < 4; ++m)
#pragma unroll
                for (int n = 0; n < 2; ++n) acc[a][b][m][n] = (f32x4){0.f, 0.f, 0.f, 0.f};
    bf16x8 At[4][2], B0[2][2], B1[2][2];
    const char* cA = (const char*)g.A + (size_t)cur.pm * tstepA; const char* cB = (const char*)g.Bt + (size_t)cur.pn * tstepB;
    PG8_STAGE(PG8_SB(0, 0), cB, voffB); PG8_STAGE(PG8_SA(0, 0), cA, voffA); PG8_STAGE(PG8_SB(0, 1), cB + hstepB, voffB); PG8_STAGE(PG8_SA(0, 1), cA + hstepA, voffA);
    if (wr == 1) PG8_BAR;
    PG8_WAIT_V(4); PG8_BAR;
    PG8_STAGE(PG8_SB(1, 0), cB + kstep, voffB); PG8_STAGE(PG8_SA(1, 0), cA + kstep, voffA); PG8_STAGE(PG8_SB(1, 1), cB + hstepB + kstep, voffB);
    PG8_WAIT_V(6); PG8_BAR;
    for (;;) {
        const bool has_next = S.next(ui + 1, nxt);
        const char* nA = has_next ? (const char*)g.A + (size_t)nxt.pm * tstepA : cA; const char* nB = has_next ? (const char*)g.Bt + (size_t)nxt.pn * tstepB : cB;
        for (int t = 0; t < nt; t += 2) {
            const bool last = (t == nt - 2);
            const char* a1 = cA + (size_t)(t + 1) * kstep;
            const char* a2 = last ? nA : cA + (size_t)(t + 2) * kstep; const char* b2 = last ? nB : cB + (size_t)(t + 2) * kstep;
            const char* a3 = a2 + kstep; const char* b3 = b2 + kstep;
            PG8_LDB(B0, 0, 0); PG8_SCHED; PG8_LDA(At, 0, 0); PG8_STAGE(PG8_SA(1, 1), a1 + hstepA, voffA);
            PG8_WAIT_L(8); PG8_BAR; PG8_WAIT_L(0); PG8_MMA(0, 0, At, B0); PG8_BAR; PG8_SCHED;
            PG8_LDB(B1, 0, 1); PG8_STAGE(PG8_SB(0, 0), b2, voffB);
            PG8_BAR; PG8_WAIT_L(0); PG8_MMA(0, 1, At, B1); PG8_BAR;
            PG8_LDA(At, 0, 1); PG8_STAGE(PG8_SA(0, 0), a2, voffA);
            PG8_BAR; PG8_WAIT_L(0); PG8_MMA(1, 0, At, B0); PG8_BAR; PG8_SCHED;
            PG8_STAGE(PG8_SB(0, 1), b2 + hstepB, voffB);
            PG8_WAIT_V(6); PG8_BAR; PG8_MMA(1, 1, At, B1); PG8_BAR;
            PG8_LDB(B0, 1, 0); PG8_SCHED; PG8_LDA(At, 1, 0); PG8_STAGE(PG8_SA(0, 1), a2 + hstepA, voffA);
            PG8_WAIT_L(8); PG8_BAR; PG8_WAIT_L(0); PG8_MMA(0, 0, At, B0); PG8_BAR; PG8_SCHED;
            PG8_LDB(B1, 1, 1); PG8_STAGE(PG8_SB(1, 0), b3, voffB);
            PG8_BAR; PG8_WAIT_L(0); PG8_MMA(0, 1, At, B1); PG8_BAR;
            PG8_LDA(At, 1, 1); PG8_STAGE(PG8_SA(1, 0), a3, voffA);
            PG8_BAR; PG8_WAIT_L(0); PG8_MMA(1, 0, At, B0); PG8_BAR; PG8_SCHED;
            PG8_STAGE(PG8_SB(1, 1), b3 + hstepB, voffB);
            PG8_WAIT_V(6); PG8_BAR; PG8_MMA(1, 1, At, B1); PG8_BAR;
        }
        E(acc, cur, wr, wc, fr, fq);
        if (!has_next) break;
#pragma unroll
        for (int a = 0; a < 2; ++a)
#pragma unroll
            for (int b = 0; b < 2; ++b)
#pragma unroll
                for (int m = 0; m < 4; ++m)
#pragma unroll
                    for (int n = 0; n < 2; ++n) acc[a][b][m][n] = (f32x4){0.f, 0.f, 0.f, 0.f};
        cur = nxt; cA = nA; cB = nB; ++ui;
    }
    PG8_WAIT_V(0);
    if (wr == 0) PG8_BAR;
    PG8_BAR;
#undef PG8_SA
#undef PG8_SB
#undef PG8_STAGE
#undef PG8_LDA
#undef PG8_LDB
#undef PG8_MMA
#undef PG8_WAIT_V
#undef PG8_WAIT_L
#undef PG8_BAR
#undef PG8_SCHED
}
}
using pg8::Unit;

struct Epi1 {
    static constexpr bool PERM = true;
    bf16_t* U;
    __device__ __forceinline__ void operator()(const f32x4 (&acc)[2][2][4][2], const Unit& u, int wr, int wc, int fr, int fq) const {
        const int row0 = u.pm * 256 + wr * 64 + fr, col0 = u.pn * 256 + wc * 32 + 8 * fq;
#pragma unroll
        for (int bj = 0; bj < 2; ++bj) {
            const int c = col0 + bj * 128;
            const int act = (c < C_GF) ? 0 : (c < C_SH) ? 1 : (c < C_GR) ? 0 : (c < C_MG) ? 1 : 2;
#pragma unroll
            for (int ai = 0; ai < 2; ++ai)
#pragma unroll
                for (int m = 0; m < 4; ++m) {
                    f32x4 v0 = acc[ai][bj][m][0], v1 = acc[ai][bj][m][1];
                    if (act == 1) {
#pragma unroll
                        for (int j = 0; j < 4; ++j) { v0[j] = siluf_(v0[j]); v1[j] = siluf_(v1[j]); }
                    } else if (act == 2) {
#pragma unroll
                        for (int j = 0; j < 4; ++j) { v0[j] = sigmoidf_(v0[j]); v1[j] = sigmoidf_(v1[j]); }
                    }
                    u32x4 w; w.x = pk2(v0[0], v0[1]); w.y = pk2(v0[2], v0[3]); w.z = pk2(v1[0], v1[1]); w.w = pk2(v1[2], v1[3]);
                    *(u32x4*)(U + (size_t)(row0 + ai * 128 + m * 16) * LDU + c) = w;
                }
        }
    }
};
template <int second> struct Epi2 {
    static constexpr bool PERM = true;
    bf16_t* U;
    __device__ __forceinline__ void operator()(const f32x4 (&acc)[2][2][4][2], const Unit& u, int wr, int wc, int fr, int fq) const {
        const int row0 = u.pm * 256 + wr * 64 + fr, col0 = u.pn * 256 + wc * 32 + 8 * fq;
#pragma unroll
        for (int bj = 0; bj < 2; ++bj) {
            const int c = col0 + bj * 128;
#pragma unroll
            for (int ai = 0; ai < 2; ++ai)
#pragma unroll
                for (int m = 0; m < 4; ++m) {
                    bf16_t* rowp = U + (size_t)(row0 + ai * 128 + m * 16) * LDU;
                    const u32x4 gw = *(const u32x4*)(rowp + C_MG + (second ? 1024 : 0) + c);
                    const f32x4 v0 = acc[ai][bj][m][0], v1 = acc[ai][bj][m][1];
                    float o[8];
                    o[0] = v0[0] * bflo(gw.x); o[1] = v0[1] * bfhi(gw.x); o[2] = v0[2] * bflo(gw.y); o[3] = v0[3] * bfhi(gw.y);
                    o[4] = v1[0] * bflo(gw.z); o[5] = v1[1] * bfhi(gw.z); o[6] = v1[2] * bflo(gw.w); o[7] = v1[3] * bfhi(gw.w);
                    if (second) {
                        const u32x4 pw = *(const u32x4*)(rowp + C_MERGED + c);
                        o[0] += bflo(pw.x); o[1] += bfhi(pw.x); o[2] += bflo(pw.y); o[3] += bfhi(pw.y);
                        o[4] += bflo(pw.z); o[5] += bfhi(pw.z); o[6] += bflo(pw.w); o[7] += bfhi(pw.w);
                    }
                    u32x4 w; w.x = pk2(o[0], o[1]); w.y = pk2(o[2], o[3]); w.z = pk2(o[4], o[5]); w.w = pk2(o[6], o[7]);
                    *(u32x4*)(rowp + C_MERGED + c) = w;
                    asm volatile("" ::: "memory");
                }
        }
    }
};
struct Epi3 {
    static constexpr bool PERM = false;
    const float* xp; const float* xs; const float* modf; float* out;
    __device__ __forceinline__ void operator()(const f32x4 (&acc)[2][2][4][2], const Unit& u, int wr, int wc, int fr, int fq) const {
        const int row0 = u.pm * 256 + wr * 64 + fr, col0 = u.pn * 256 + wc * 32 + 4 * fq;
#pragma unroll
        for (int ai = 0; ai < 2; ++ai)
#pragma unroll
            for (int m = 0; m < 4; ++m) {
                const int row = row0 + ai * 128 + m * 16;
                const int set = row < NTOK_C ? 0 : 1 + ((row - NTOK_C) >> 12);
                const float* xr = row < NTOK_C ? xp + (size_t)row * DM : xs + (size_t)(row - NTOK_C) * DM;
                const float* gt = modf + set * 3072 + 2048;
#pragma unroll
                for (int bj = 0; bj < 2; ++bj)
#pragma unroll
                    for (int n = 0; n < 2; ++n) {
                        const int c = col0 + bj * 128 + n * 16;
                        const f32x4 xv = *(const f32x4*)(xr + c), gv = *(const f32x4*)(gt + c);
                        *(f32x4*)(out + (size_t)row * DM + c) = xv + gv * acc[ai][bj][m][n];
                    }
            }
    }
};

template <int MT, int NT, int KS, int UNR = 1>
__device__ __forceinline__ void wave_mma(const bf16_t* const (&ap)[MT], const bf16_t* const (&bp)[NT], f32x4 (&acc)[MT][NT], int fq) {
#pragma unroll UNR
    for (int ks = 0; ks < KS; ++ks) {
        bf16x8 av[MT], bv[NT];
#pragma unroll
        for (int mi = 0; mi < MT; ++mi) av[mi] = *(const bf16x8*)(ap[mi] + ks * 32 + fq * 8);
#pragma unroll
        for (int ni = 0; ni < NT; ++ni) bv[ni] = *(const bf16x8*)(bp[ni] + ks * 32 + fq * 8);
#pragma unroll
        for (int mi = 0; mi < MT; ++mi)
#pragma unroll
            for (int ni = 0; ni < NT; ++ni) acc[mi][ni] = __builtin_amdgcn_mfma_f32_16x16x32_bf16(av[mi], bv[ni], acc[mi][ni], 0, 0, 0);
    }
}
template <int MT, int NT, int KS, int LDB, int UNR = 1>
__device__ __forceinline__ void wave_mma_lb(const bf16_t* const (&ap)[MT], const LAS bf16_t* bl, f32x4 (&acc)[MT][NT], int fr, int fq) {
#pragma unroll UNR
    for (int ks = 0; ks < KS; ++ks) {
        bf16x8 av[MT], bv[NT];
#pragma unroll
        for (int mi = 0; mi < MT; ++mi) av[mi] = *(const bf16x8*)(ap[mi] + ks * 32 + fq * 8);
#pragma unroll
        for (int ni = 0; ni < NT; ++ni) bv[ni] = *(const LAS bf16x8*)(bl + (16 * ni + fr) * LDB + ks * 32 + fq * 8);
#pragma unroll
        for (int mi = 0; mi < MT; ++mi)
#pragma unroll
            for (int ni = 0; ni < NT; ++ni) acc[mi][ni] = __builtin_amdgcn_mfma_f32_16x16x32_bf16(av[mi], bv[ni], acc[mi][ni], 0, 0, 0);
    }
}
template <int LDB>
__device__ __forceinline__ void stage_table(LAS bf16_t* dst, const bf16_t* src, int rows, int cols) {
    const int per = cols / 8;
    for (int i = threadIdx.x; i < rows * per; i += 512) { const int r = i / per, c8 = i % per; *(LAS u32x4*)(dst + r * LDB + c8 * 8) = *(const u32x4*)(src + (size_t)r * cols + c8 * 8); }
}
__device__ __forceinline__ void st4bf(bf16_t* p, const f32x4 v) { u32x2 w; w.x = pk2(v[0], v[1]); w.y = pk2(v[2], v[3]); *(u32x2*)p = w; }

struct Ctx {
    const Args& a; LAS unsigned char* lds; int tid, lane, wv, gw, ngw;
};

__device__ __forceinline__ void transpose_item(const float* W, int K, int N, bf16_t* WT, LAS float* scr, int item, int lane) {
    const int nblk = N / 32, kb = item / nblk, nb = item % nblk, k0 = 64 * kb, n0 = 32 * nb;
#pragma unroll 8
    for (int i = 0; i < 32; ++i) { const int kk = 2 * i + (lane >> 5); scr[kk * 33 + (lane & 31)] = __builtin_nontemporal_load(W + (size_t)(k0 + kk) * N + n0 + (lane & 31)); }
    LDS_WAIT();
    const int c = lane & 7;
#pragma unroll
    for (int j = 0; j < 4; ++j) { const int n = (lane >> 3) + 8 * j; const LAS float* s = scr + (8 * c) * 33 + n;
        u32x4 o; o.x = pk2(s[0 * 33], s[1 * 33]); o.y = pk2(s[2 * 33], s[3 * 33]); o.z = pk2(s[4 * 33], s[5 * 33]); o.w = pk2(s[6 * 33], s[7 * 33]);
        *(u32x4*)(WT + (size_t)(n0 + n) * K + k0 + 8 * c) = o; }
    LDS_WAIT();
}
__device__ __forceinline__ void phase0(const Args& a, LAS unsigned char* lds) {
    const int tid = threadIdx.x, lane = tid & 63, wv = tid >> 6, gw = blockIdx.x * 8 + wv, ngw = gridDim.x * 8;
    unsigned char* ws = a.ws;
    for (int cb = blockIdx.x; cb < 256; cb += gridDim.x) {
        LAS float* sv = (LAS float*)(lds + 8 * 8448);
        LAS float* pr = sv + 3072;
        __syncthreads();
        for (int i = tid; i < 3072; i += 512) { const int v = i >> 10, k = i & 1023; sv[i] = siluf_((v == 0) ? a.in[4][k] : a.in[3][(v - 1) * 1024 + k]); }
        __syncthreads();
        const int kk = tid >> 2, cq = tid & 3, col = cb * 12 + 3 * cq;
        float acc[3][3];
#pragma unroll
        for (int v = 0; v < 3; ++v)
#pragma unroll
            for (int j = 0; j < 3; ++j) acc[v][j] = 0.f;
#pragma unroll
        for (int i = 0; i < 8; ++i) {
            const int k = kk + 128 * i;
            const float* w = a.in[6] + (size_t)k * 3072 + col;
            const float w0 = w[0], w1 = w[1], w2 = w[2];
#pragma unroll
            for (int v = 0; v < 3; ++v) { const float sk = sv[v * 1024 + k]; acc[v][0] += sk * w0; acc[v][1] += sk * w1; acc[v][2] += sk * w2; }
        }
#pragma unroll
        for (int v = 0; v < 3; ++v)
#pragma unroll
            for (int j = 0; j < 3; ++j) { float x = acc[v][j]; x += __shfl_xor(x, 4); x += __shfl_xor(x, 8); x += __shfl_xor(x, 16); x += __shfl_xor(x, 32); acc[v][j] = x; }
        if (lane < 4) {
#pragma unroll
            for (int v = 0; v < 3; ++v)
#pragma unroll
                for (int j = 0; j < 3; ++j) pr[(wv * 4 + lane) * 9 + v * 3 + j] = acc[v][j];
        }
        __syncthreads();
        if (tid < 36) {
            const int q = tid / 9, r = tid % 9, v = r / 3, j = r % 3;
            float sum = 0.f;
#pragma unroll
            for (int w8 = 0; w8 < 8; ++w8) sum += pr[(w8 * 4 + q) * 9 + r];
            const int c = cb * 12 + 3 * q + j;
            ((float*)(ws + WS_MODF))[v * 3072 + c] = sum + a.in[7][c];
        }
    }
    __syncthreads();
}
__device__ __forceinline__ void phase0_conv(const Args& a, LAS unsigned char* lds) {
    const int tid = threadIdx.x, lane = tid & 63, wv = tid >> 6, gw = blockIdx.x * 8 + wv, ngw = gridDim.x * 8;
    unsigned char* ws = a.ws;
    LAS float* scr = (LAS float*)(lds + wv * 8448);
    for (int it = gw; it < 16 * 228; it += ngw) transpose_item(a.in[8], 1024, 7296, (bf16_t*)(ws + WS_WINT), scr, it, lane);
    u32x4* padp = (u32x4*)((bf16_t*)(ws + WS_WINT) + (size_t)7296 * 1024);
    for (int i = blockIdx.x * 512 + tid; i < 128 * 1024 / 8; i += gridDim.x * 512) padp[i] = (u32x4){0u, 0u, 0u, 0u};
}
__device__ __forceinline__ void conv_rest(const Args& a, LAS unsigned char* lds, int wb, int nwb) {
    const int tid = threadIdx.x, lane = tid & 63, wv = tid >> 6, gw = wb * 8 + wv, ngw = nwb * 8;
    unsigned char* ws = a.ws;
    {
        LAS float* scr = (LAS float*)(lds + wv * 8448);
        constexpr int I_PF = 8 * 32, I_PR = 16 * 32, I_OUT = 16 * 32;
        for (int it = gw; it < I_PF + I_PR + I_OUT; it += ngw) {
            int r = it;
            if (r < I_PF) { transpose_item(a.in[19], 512, 1024, (bf16_t*)(ws + WS_WPF), scr, r, lane); continue; } r -= I_PF;
            if (r < I_PR) { transpose_item(a.in[20], 1024, 1024, (bf16_t*)(ws + WS_WPR), scr, r, lane); continue; } r -= I_PR;
            transpose_item(a.in[21], 1024, 1024, (bf16_t*)(ws + WS_WOUT), scr, r, lane);
        }
    }
    {
        bf16_t* wt = (bf16_t*)(ws + WS_WUPT); bf16_t* at = (bf16_t*)(ws + WS_AUPT);
        for (int i = wb * 512 + tid; i < 2 * 1024 * 64; i += nwb * 512) {
            const int rk = i & 63, C = (i >> 6) & 1023, d = i >> 16;
            wt[i] = (bf16_t)f2bf(a.in[11][(size_t)(d * 64 + rk) * 1024 + C]);
            at[i] = (bf16_t)f2bf(a.in[13][(size_t)(d * 64 + rk) * 1024 + C]);
        }
    }
    {
        bf16_t* tab = (bf16_t*)(ws + WS_TAB);
        for (int i = wb * 512 + tid; i < T_END; i += nwb * 512) {
            float val;
            if (i < T_WB64) {
                const int n = i >> 7, c = i & 127, part = n >> 7, kc = n & 127, m = (kc * c) & 127;
                const float x = (float)m * (1.0f / 64.0f);
                val = part ? -sinpif(x) : cospif(x);
            } else if (i < T_WC64) {
                const int j = i - T_WB64, n = j >> 7, k = j & 127, pp = n >> 6, k1 = n & 63, p = k >> 6, t1 = k & 63, m = (k1 * t1) & 63;
                const float x = (float)m * (1.0f / 32.0f), cs = cospif(x), sn = sinpif(x);
                val = (pp == p) ? cs : (pp == 0 ? sn : -sn);
            } else if (i < T_WB16) {
                const int j = i - T_WC64, k2 = j >> 7, k = j & 127, p = k >> 6, t2 = k & 63, m = (k2 * t2) & 63;
                const float x = (float)m * (1.0f / 32.0f);
                val = p ? sinpif(x) : cospif(x);
            } else if (i < T_WC16) {
                const int j = i - T_WB16, n = j >> 5, k = j & 31, pp = n >> 4, k1 = n & 15, p = k >> 4, t1 = k & 15, m = (k1 * t1) & 15;
                const float x = (float)m * (1.0f / 8.0f), cs = cospif(x), sn = sinpif(x);
                val = (pp == p) ? cs : (pp == 0 ? sn : -sn);
            } else {
                const int j = i - T_WC16, k2 = j >> 5, k = j & 31, p = k >> 4, t2 = k & 15, m = (k2 * t2) & 15;
                const float x = (float)m * (1.0f / 8.0f);
                val = p ? sinpif(x) : cospif(x);
            }
            tab[i] = (bf16_t)f2bf(val);
        }
    }
}

__device__ __forceinline__ void phase1(const Args& a, LAS unsigned char* lds) {
    const int tid = threadIdx.x, lane = tid & 63, wv = tid >> 6, gw = blockIdx.x * 8 + wv, ngw = gridDim.x * 8;
    unsigned char* ws = a.ws;
    LAS float* ml = (LAS float*)lds;
    const float* mf = (const float*)(ws + WS_MODF);
    for (int i = tid; i < 9216; i += 512) ml[i] = mf[i];
    __syncthreads();
    bf16_t* H = (bf16_t*)(ws + WS_H);
    const float* ng = a.in[5];
    for (int row0 = gw; row0 < NTOK; row0 += 3 * ngw) {
        f32x4 v[3][4];
#pragma unroll
        for (int u = 0; u < 3; ++u) {
            const int row = row0 + u * ngw < NTOK ? row0 + u * ngw : row0;
            const float* xr = row < NTOK_C ? a.in[0] + (size_t)row * DM : a.in[1] + (size_t)(row - NTOK_C) * DM;
#pragma unroll
            for (int j = 0; j < 4; ++j) v[u][j] = __builtin_nontemporal_load((const f32x4*)(xr + lane * 4 + 256 * j));
        }
#pragma unroll
        for (int u = 0; u < 3; ++u) {
            const int row = row0 + u * ngw;
            if (row < NTOK) {
                const int set = row < NTOK_C ? 0 : 1 + ((row - NTOK_C) >> 12);
                float ss = 0.f;
#pragma unroll
                for (int j = 0; j < 4; ++j) ss += (v[u][j][0] * v[u][j][0] + v[u][j][1] * v[u][j][1]) + (v[u][j][2] * v[u][j][2] + v[u][j][3] * v[u][j][3]);
                const float rstd = rsqrtf(wave_sum(ss) * (1.0f / DM) + RMS_EPS);
#pragma unroll
                for (int j = 0; j < 4; ++j) {
                    const int c = lane * 4 + 256 * j;
                    const f32x4 g4 = *(const f32x4*)(ng + c);
                    float o[4];
#pragma unroll
                    for (int e = 0; e < 4; ++e) o[e] = (v[u][j][e] * rstd * g4[e]) * (1.0f + ml[set * 3072 + 1024 + c + e]) + ml[set * 3072 + c + e];
                    u32x2 w; w.x = pk2(o[0], o[1]); w.y = pk2(o[2], o[3]);
                    *(u32x2*)(H + (size_t)row * DM + c) = w;
                }
            }
        }
    }
}

__device__ __forceinline__ void fourier_l1(const Args& a, LAS unsigned char* lds) {
    const int tid = threadIdx.x, lane = tid & 63, wv = tid >> 6, gw = blockIdx.x * 8 + wv, ngw = gridDim.x * 8, fr = lane & 15, fq = lane >> 4;
    unsigned char* ws = a.ws;
    const bf16_t* U = (const bf16_t*)(ws + WS_U);
    const bf16_t* W128 = (const bf16_t*)(ws + WS_TAB) + T_W128;
    bf16_t* Qlat = (bf16_t*)(ws + WS_H);
    bf16_t* Qctx = Qlat + QLAT_ELEMS;
    LAS bf16_t* Wl = (LAS bf16_t*)lds;
    __syncthreads(); stage_table<136>(Wl, W128, 256, 128); __syncthreads();
    for (int wt = gw; wt < 2048 + 1024; wt += ngw) {
        const bf16_t* ap[4]; f32x4 acc[4][4];
#pragma unroll
        for (int mi = 0; mi < 4; ++mi)
#pragma unroll
            for (int ni = 0; ni < 4; ++ni) acc[mi][ni] = (f32x4){0.f, 0.f, 0.f, 0.f};
        if (wt < 2048) {
            const int nb = wt & 3, t2 = (wt >> 2) & 63, bg = wt >> 8, b = bg >> 2, g = bg & 3;
#pragma unroll
            for (int mi = 0; mi < 4; ++mi) ap[mi] = U + (size_t)(NTOK_C + b * 4096 + 64 * (16 * mi + fr) + t2) * LDU + C_XF + g * 128;
            wave_mma_lb<4, 4, 4, 136, 2>(ap, Wl + (nb * 64) * 136, acc, fr, fq);
#pragma unroll
            for (int mi = 0; mi < 4; ++mi)
#pragma unroll
                for (int ni = 0; ni < 4; ++ni) {
                    const int cn = nb * 64 + 16 * ni + fr, part = cn >> 7, kc = cn & 127;
                    st4bf(Qlat + ((((size_t)(bg * 128 + kc) * 64 + t2) * 2 + part) * 64 + 16 * mi + 4 * fq), acc[mi][ni]);
                }
        } else {
            const int w2 = wt - 2048, nb = w2 & 3, tg = (w2 >> 2) & 3, bg = w2 >> 4, b = bg >> 2, g = bg & 3;
#pragma unroll
            for (int mi = 0; mi < 4; ++mi) ap[mi] = U + (size_t)(b * 256 + 16 * fr + (tg * 4 + mi)) * LDU + C_XF + g * 128;
            wave_mma_lb<4, 4, 4, 136, 2>(ap, Wl + (nb * 64) * 136, acc, fr, fq);
#pragma unroll
            for (int mi = 0; mi < 4; ++mi)
#pragma unroll
                for (int ni = 0; ni < 4; ++ni) {
                    const int cn = nb * 64 + 16 * ni + fr, part = cn >> 7, kc = cn & 127, t2 = tg * 4 + mi;
                    st4bf(Qctx + ((((size_t)(bg * 128 + kc) * 16 + t2) * 2 + part) * 16 + 4 * fq), acc[mi][ni]);
                }
        }
    }
}
__device__ __forceinline__ void fourier_l2(const Args& a, LAS unsigned char* lds) {
    const int tid = threadIdx.x, lane = tid & 63, wv = tid >> 6, gw = blockIdx.x * 8 + wv, ngw = gridDim.x * 8, fr = lane & 15, fq = lane >> 4;
    unsigned char* ws = a.ws;
    const bf16_t* tab = (const bf16_t*)(ws + WS_TAB);
    const bf16_t* Qlat = (const bf16_t*)(ws + WS_H);
    const bf16_t* Qctx = Qlat + QLAT_ELEMS;
    bf16_t* Rlat = (bf16_t*)(ws + WS_RLAT);
    bf16_t* Rctx = (bf16_t*)(ws + WS_WINT);
    LAS bf16_t* Bl64 = (LAS bf16_t*)lds;
    LAS bf16_t* Bl16 = Bl64 + 128 * 136;
    __syncthreads(); stage_table<136>(Bl64, tab + T_WB64, 128, 128); stage_table<40>(Bl16, tab + T_WB16, 32, 32); __syncthreads();
    for (int wt = gw; wt < 2048 + 2048; wt += ngw) {
        if (wt < 2048) {
            const int bgkc = wt >> 1, mh = wt & 1;
            const bf16_t* ap[2]; f32x4 acc[2][8];
#pragma unroll
            for (int mi = 0; mi < 2; ++mi)
#pragma unroll
                for (int ni = 0; ni < 8; ++ni) acc[mi][ni] = (f32x4){0.f, 0.f, 0.f, 0.f};
#pragma unroll
            for (int mi = 0; mi < 2; ++mi) ap[mi] = Qlat + ((size_t)bgkc * 64 + 32 * mh + 16 * mi + fr) * 128;
            wave_mma_lb<2, 8, 4, 136>(ap, Bl64, acc, fr, fq);
#pragma unroll
            for (int mi = 0; mi < 2; ++mi)
#pragma unroll
                for (int ni = 0; ni < 4; ++ni) {
                    const int k1 = 16 * ni + fr;
                    f32x4 orr, oi;
#pragma unroll
                    for (int r = 0; r < 4; ++r) {
                        const int t2 = 32 * mh + 16 * mi + 4 * fq + r, m = (t2 * k1) & 4095;
                        const float x = (float)m * (1.0f / 2048.0f), cs = cospif(x), sn = sinpif(x);
                        const float br = acc[mi][ni][r], bi = acc[mi][ni + 4][r];
                        orr[r] = br * cs + bi * sn; oi[r] = bi * cs - br * sn;
                    }
                    bf16_t* dst = Rlat + ((size_t)bgkc * 64 + k1) * 128 + 32 * mh + 16 * mi + 4 * fq;
                    st4bf(dst, orr); st4bf(dst + 64, oi);
                }
        } else {
            const int bgkc0 = (wt - 2048) * 4;
            const bf16_t* ap[4]; f32x4 acc[4][2];
#pragma unroll
            for (int mi = 0; mi < 4; ++mi)
#pragma unroll
                for (int ni = 0; ni < 2; ++ni) acc[mi][ni] = (f32x4){0.f, 0.f, 0.f, 0.f};
#pragma unroll
            for (int mi = 0; mi < 4; ++mi) ap[mi] = Qctx + ((size_t)(bgkc0 + mi) * 16 + fr) * 32;
            wave_mma_lb<4, 2, 1, 40>(ap, Bl16, acc, fr, fq);
#pragma unroll
            for (int mi = 0; mi < 4; ++mi) {
                const int k1 = fr;
                f32x4 orr, oi;
#pragma unroll
                for (int r = 0; r < 4; ++r) {
                    const int t2 = 4 * fq + r, m = (t2 * k1) & 255;
                    const float x = (float)m * (1.0f / 128.0f), cs = cospif(x), sn = sinpif(x);
                    const float br = acc[mi][0][r], bi = acc[mi][1][r];
                    orr[r] = br * cs + bi * sn; oi[r] = bi * cs - br * sn;
                }
                bf16_t* dst = Rctx + ((size_t)(bgkc0 + mi) * 16 + k1) * 32 + 4 * fq;
                st4bf(dst, orr); st4bf(dst + 16, oi);
            }
        }
    }
}
__device__ __forceinline__ void fourier_l3(const Args& a, LAS unsigned char* lds) {
    const int skipb = (gridDim.x >= 128 && gridDim.x < 256) ? 64 : 0;
    if ((int)blockIdx.x < skipb) return;
    const int tid = threadIdx.x, lane = tid & 63, wv = tid >> 6, gw = ((int)blockIdx.x - skipb) * 8 + wv, ngw = ((int)gridDim.x - skipb) * 8, fr = lane & 15, fq = lane >> 4;
    unsigned char* ws = a.ws;
    const bf16_t* tab = (const bf16_t*)(ws + WS_TAB);
    const bf16_t* Rlat = (const bf16_t*)(ws + WS_RLAT);
    const bf16_t* Rctx = (const bf16_t*)(ws + WS_WINT);
    bf16_t* U = (bf16_t*)(ws + WS_U);
    LAS bf16_t* Cl64 = (LAS bf16_t*)lds;
    LAS bf16_t* Cl16 = Cl64 + 64 * 136;
    stage_table<136>(Cl64, tab + T_WC64, 64, 128); stage_table<40>(Cl16, tab + T_WC16, 16, 32); __syncthreads();
    for (int wt = gw; wt < 1024 + 2048; wt += ngw) {
        if (wt < 1024) {
            const int kb = wt & 1, k1 = (wt >> 1) & 63, bg = wt >> 7, b = bg >> 2, g = bg & 3;
            const bf16_t* ap[4]; f32x4 acc[4][4];
#pragma unroll
            for (int mi = 0; mi < 4; ++mi)
#pragma unroll
                for (int ni = 0; ni < 4; ++ni) acc[mi][ni] = (f32x4){0.f, 0.f, 0.f, 0.f};
#pragma unroll
            for (int mi = 0; mi < 4; ++mi) ap[mi] = Rlat + ((size_t)(bg * 128 + kb * 64 + 16 * mi + fr) * 64 + k1) * 128;
            wave_mma_lb<4, 4, 4, 136, 2>(ap, Cl64, acc, fr, fq);
            const float scale = 0.0013810679320049757f;
#pragma unroll
            for (int mi = 0; mi < 4; ++mi)
#pragma unroll
                for (int ni = 0; ni < 4; ++ni) {
                    const int k2 = 16 * ni + fr, kt = k1 + 64 * k2, row = NTOK_C + b * 4096 + kt, col = g * 128 + kb * 64 + 16 * mi + 4 * fq;
                    bf16_t* rp = U + (size_t)row * LDU;
                    const u32x2 gt = *(const u32x2*)(rp + C_GF + col);
                    f32x4 o; o[0] = acc[mi][ni][0] * scale * bflo(gt.x); o[1] = acc[mi][ni][1] * scale * bfhi(gt.x);
                    o[2] = acc[mi][ni][2] * scale * bflo(gt.y); o[3] = acc[mi][ni][3] * scale * bfhi(gt.y);
                    st4bf(rp + C_XF + col, o);
                }
        } else {
            const int w2 = wt - 1024, kb = w2 & 1, k1 = (w2 >> 1) & 15, bg = w2 >> 5, b = bg >> 2, g = bg & 3;
            const bf16_t* ap[4]; f32x4 acc[4][1];
#pragma unroll
            for (int mi = 0; mi < 4; ++mi) acc[mi][0] = (f32x4){0.f, 0.f, 0.f, 0.f};
#pragma unroll
            for (int mi = 0; mi < 4; ++mi) ap[mi] = Rctx + ((size_t)(bg * 128 + kb * 64 + 16 * mi + fr) * 16 + k1) * 32;
            wave_mma_lb<4, 1, 1, 40>(ap, Cl16, acc, fr, fq);
            const float scale = 0.005524271728019903f;
#pragma unroll
            for (int mi = 0; mi < 4; ++mi) {
                const int k2 = fr, kt = k1 + 16 * k2, row = b * 256 + kt, col = g * 128 + kb * 64 + 16 * mi + 4 * fq;
                bf16_t* rp = U + (size_t)row * LDU;
                const u32x2 gt = *(const u32x2*)(rp + C_GF + col);
                f32x4 o; o[0] = acc[mi][0][0] * scale * bflo(gt.x); o[1] = acc[mi][0][1] * scale * bfhi(gt.x);
                o[2] = acc[mi][0][2] * scale * bflo(gt.y); o[3] = acc[mi][0][3] * scale * bfhi(gt.y);
                st4bf(rp + C_XF + col, o);
            }
        }
    }
}

__device__ __forceinline__ float sh_mixed(const bf16_t* U, const float* mu, int row, int cs, int lat, int t) {
    int nb; bool valid;
    if (lat) {
        const int d = cs & 3, cg_ = t & 63, rg = t >> 6;
        if (d == 0) { valid = cg_ > 0; nb = row - 1; } else if (d == 1) { valid = cg_ < 63; nb = row + 1; }
        else if (d == 2) { valid = rg > 0; nb = row - 64; } else { valid = rg < 63; nb = row + 64; }
    } else {
        if (cs & 1) { valid = t < 255; nb = row + 1; } else { valid = t > 0; nb = row - 1; }
    }
    const float x = bf2f(U[(size_t)row * LDU + C_SH + cs]);
    const float s = valid ? bf2f(U[(size_t)nb * LDU + C_SH + cs]) : 0.0f;
    return x + mu[cs] * (s - x);
}

constexpr int LDP = 72;
constexpr int GS = 68;
constexpr int SC_X = 0, SC_AGF = 17408, SC_AAK = 17408, SC_ARK = 26624, SC_ARB = 35840, SC_TM = 45056, SC_TW = 54272, SC_AD = 63488,
              SC_AT = 72704, SC_RT = 81920, SC_BT = 91136, SC_KT = 100352, SC_BH = 109568, SC_KH = 118912, SC_VT = 128256, SC_SB = 137600, SC_EGL = 146816, SC_ABA = 147072, SC_PAR = 149632;
constexpr int LDQ = 40;
__device__ __forceinline__ bf16x8 ldfrag(const LAS bf16_t* arr, int row, int ks, int fq) { return *(const LAS bf16x8*)(arr + row * LDP + ks * 32 + fq * 8); }
__device__ __forceinline__ int tskew(int row) { return row * LDP + 8 * (row >> 3); }
__device__ __forceinline__ bf16x8 ldfragT(const LAS bf16_t* arr, int row, int ks, int fq) { return *(const LAS bf16x8*)(arr + tskew(row) + ks * 32 + fq * 8); }
__device__ __forceinline__ void st4lds(LAS bf16_t* p, const f32x4 v) { u32x2 w; w.x = pk2(v[0], v[1]); w.y = pk2(v[2], v[3]); *(LAS u32x2*)p = w; }
#define SBAR() do { asm volatile("s_waitcnt lgkmcnt(0)" ::: "memory"); __builtin_amdgcn_s_barrier(); asm volatile("" ::: "memory"); } while (0)
#define MMA16(a_, b_, c_) (c_) = __builtin_amdgcn_mfma_f32_16x16x32_bf16((a_), (b_), (c_), 0, 0, 0)

__device__ __forceinline__ float bfel(const u32x4 w, int e) { const unsigned x = w[e >> 1]; return (e & 1) ? bfhi(x) : bflo(x); }
__device__ __forceinline__ void mix8(const u32x4 self, const u32x4 (&nb)[4], const bool (&vl)[4], int lat, const f32x4 mu0, const f32x4 mu1, float (&out)[8]) {
#pragma unroll
    for (int e = 0; e < 8; ++e) {
        const float x = bfel(self, e);
        float s;
        if (lat) { const int d = e & 3; s = vl[d] ? bfel(nb[d], e) : 0.f; }
        else { const int d = e & 1; s = vl[d] ? bfel(nb[d], e) : 0.f; }
        const float m = (e < 4) ? mu0[e] : mu1[e - 4];
        out[e] = x + m * (s - x);
    }
}
__device__ __forceinline__ u32x4 pack8(const float (&v)[8]) { u32x4 w; w.x = pk2(v[0], v[1]); w.y = pk2(v[2], v[3]); w.z = pk2(v[4], v[5]); w.w = pk2(v[6], v[7]); return w; }
__device__ __forceinline__ float tanh_fast(float x) { const float e = __expf(2.0f * x); return 1.0f - 2.0f * __builtin_amdgcn_rcpf(e + 1.0f); }

__device__ __forceinline__ void phase_premix(const Args& a) {
    const bf16_t* U = (const bf16_t*)(a.ws + WS_U);
    bf16_t* MIX = (bf16_t*)(a.ws + WS_MIX);
    const float* mu = a.in[9];
    for (int idx = blockIdx.x * 512 + threadIdx.x; idx < NTOK * 16; idx += gridDim.x * 512) {
        const int row = idx >> 4, c0 = (idx & 15) * 8;
        const int lat = row >= NTOK_C, t = lat ? ((row - NTOK_C) & 4095) : (row & 255);
        bool nv[4]; int nrow[4];
        if (lat) { const int cx = t & 63, rg = t >> 6; nv[0] = cx > 0; nv[1] = cx < 63; nv[2] = rg > 0; nv[3] = rg < 63;
            nrow[0] = nv[0] ? row - 1 : row; nrow[1] = nv[1] ? row + 1 : row; nrow[2] = nv[2] ? row - 64 : row; nrow[3] = nv[3] ? row + 64 : row; }
        else { nv[0] = t > 0; nv[1] = t < 255; nv[2] = false; nv[3] = false; nrow[0] = nv[0] ? row - 1 : row; nrow[1] = nv[1] ? row + 1 : row; nrow[2] = row; nrow[3] = row; }
        const u32x4 Ws = *(const u32x4*)(U + (size_t)row * LDU + C_SH + 3072 + c0);
        u32x4 Wn[4];
#pragma unroll
        for (int d = 0; d < 4; ++d) { if (d < 2 || lat) Wn[d] = *(const u32x4*)(U + (size_t)nrow[d] * LDU + C_SH + 3072 + c0); else Wn[d] = Ws; }
        float o[8];
        mix8(Ws, Wn, nv, lat, *(const f32x4*)(mu + 3072 + c0), *(const f32x4*)(mu + 3072 + c0 + 4), o);
        if (c0 < 64) {
#pragma unroll
            for (int e = 0; e < 8; ++e) o[e] = tanh_fast(o[e]);
        }
        *(u32x4*)(MIX + (size_t)row * 128 + c0) = pack8(o);
    }
}

__device__ __forceinline__ void scan_chain(const Args& a, LAS unsigned char* lds, int lat, int b, int h, int dir, float ysc, int cbeg, int cend, int mode) {
    const int tid = threadIdx.x, lane = tid & 63, wv = __builtin_amdgcn_readfirstlane(tid >> 6), fr = lane & 15, fq = lane >> 4;
    const int T = lat ? 4096 : 256, row_base = lat ? NTOK_C + b * 4096 : b * 256;
    const bf16_t* U = (const bf16_t*)(a.ws + WS_U);
    const float* mu = a.in[9];
    LAS float* Gf = (LAS float*)(lds + SC_X); LAS float* AGf = (LAS float*)(lds + SC_AGF); LAS float* Aab = (LAS float*)(lds + SC_X);
    LAS bf16_t* Aak = (LAS bf16_t*)(lds + SC_AAK); LAS bf16_t* Ark = (LAS bf16_t*)(lds + SC_ARK); LAS bf16_t* Arb = (LAS bf16_t*)(lds + SC_ARB);
    LAS bf16_t* Tm = (LAS bf16_t*)(lds + SC_TM); LAS bf16_t* TW = (LAS bf16_t*)(lds + SC_TW); LAS bf16_t* AD = (LAS bf16_t*)(lds + SC_AD);
    LAS bf16_t* PT = TW; LAS bf16_t* UT = AD;
    LAS bf16_t* At = (LAS bf16_t*)(lds + SC_AT); LAS bf16_t* Rt = (LAS bf16_t*)(lds + SC_RT); LAS bf16_t* Bt = (LAS bf16_t*)(lds + SC_BT);
    LAS bf16_t* Kt = (LAS bf16_t*)(lds + SC_KT); LAS bf16_t* BhT = (LAS bf16_t*)(lds + SC_BH); LAS bf16_t* KhT = (LAS bf16_t*)(lds + SC_KH);
    LAS bf16_t* VT = (LAS bf16_t*)(lds + SC_VT); LAS bf16_t* Sb = (LAS bf16_t*)(lds + SC_SB); LAS float* EGL = (LAS float*)(lds + SC_EGL);
    const int nio = wv & 3, mo0 = 2 * (wv >> 2);
    f32x4 Sacc[2];
    {
        const int i = 16 * nio + fr;
#pragma unroll
        for (int mm = 0; mm < 2; ++mm) {
            const int j0 = 16 * (mo0 + mm) + 4 * fq;
            if (mode == 2) { Sacc[mm] = (f32x4){0.f, 0.f, 0.f, 0.f};
#pragma unroll
                for (int r = 0; r < 4; ++r) if (j0 + r == i) Sacc[mm][r] = 1.0f; }
            else if (lat && mode == 0) Sacc[mm] = *(const f32x4*)(a.in[2] + ((((size_t)b * 2 + dir) * 16 + h) * 64 + i) * 64 + j0);
            else Sacc[mm] = (f32x4){0.f, 0.f, 0.f, 0.f};
            st4lds(Sb + i * LDP + j0, Sacc[mm]);
        }
    }
    const int lr_strip = wv & 3;
    const bool lr_lo = wv < 4;
    const int lr_c = h * 64 + 16 * lr_strip + fr;
    const float lr_w0 = a.in[10][dir * 1024 + lr_c], lr_a0 = a.in[12][dir * 1024 + lr_c];
    const bf16_t* lr_bw = (const bf16_t*)(a.ws + WS_WUPT) + ((size_t)dir * 1024 + lr_c) * 64;
    const bf16_t* lr_ba = (const bf16_t*)(a.ws + WS_AUPT) + ((size_t)dir * 1024 + lr_c) * 64;
    u32x4 Rs, Ks, Vs, Rn[4], Kn[4], Vn[4]; bf16x8 Wf[2][4]; int nvm = 0;
    const bf16_t* MIXp = (const bf16_t*)(a.ws + WS_MIX);
    const int nch = cend;
#define SCAN_ISSUE(cidx) do { \
        const int l2_ = threadIdx.x & 63, p2_ = (l2_ >> 3) + 8 * wv, g2_ = l2_ & 7; \
        const int pos_ = (cidx) * 64 + p2_, t_ = dir ? T - 1 - pos_ : pos_, row_ = row_base + t_; \
        int n0_, n1_, n2_, n3_, m_ = 0; \
        if (lat) { const int cx = t_ & 63, rg = t_ >> 6; m_ = (cx > 0 ? 1 : 0) | (cx < 63 ? 2 : 0) | (rg > 0 ? 4 : 0) | (rg < 63 ? 8 : 0); \
            n0_ = (m_ & 1) ? row_ - 1 : row_; n1_ = (m_ & 2) ? row_ + 1 : row_; n2_ = (m_ & 4) ? row_ - 64 : row_; n3_ = (m_ & 8) ? row_ + 64 : row_; } \
        else { m_ = (t_ > 0 ? 1 : 0) | (t_ < 255 ? 2 : 0); n0_ = (m_ & 1) ? row_ - 1 : row_; n1_ = (m_ & 2) ? row_ + 1 : row_; n2_ = row_; n3_ = row_; } \
        nvm = m_; \
        const int colr_ = h * 64 + 8 * g2_; \
        const bf16_t* sp_ = U + (size_t)row_ * LDU + C_SH + colr_; \
        Rs = *(const u32x4*)(sp_); Ks = *(const u32x4*)(sp_ + 1024); Vs = *(const u32x4*)(sp_ + 2048); \
        { const bf16_t* q_ = U + (size_t)n0_ * LDU + C_SH + colr_; Rn[0] = *(const u32x4*)(q_); Kn[0] = *(const u32x4*)(q_ + 1024); Vn[0] = *(const u32x4*)(q_ + 2048); } \
        { const bf16_t* q_ = U + (size_t)n1_ * LDU + C_SH + colr_; Rn[1] = *(const u32x4*)(q_); Kn[1] = *(const u32x4*)(q_ + 1024); Vn[1] = *(const u32x4*)(q_ + 2048); } \
        if (lat) { \
            { const bf16_t* q_ = U + (size_t)n2_ * LDU + C_SH + colr_; Rn[2] = *(const u32x4*)(q_); Kn[2] = *(const u32x4*)(q_ + 1024); Vn[2] = *(const u32x4*)(q_ + 2048); } \
            { const bf16_t* q_ = U + (size_t)n3_ * LDU + C_SH + colr_; Rn[3] = *(const u32x4*)(q_); Kn[3] = *(const u32x4*)(q_ + 1024); Vn[3] = *(const u32x4*)(q_ + 2048); } \
        } else { Rn[2] = Rs; Kn[2] = Ks; Vn[2] = Vs; Rn[3] = Rs; Kn[3] = Ks; Vn[3] = Vs; } \
        _Pragma("unroll") for (int mi_ = 0; mi_ < 4; ++mi_) { \
            const int pw_ = (cidx) * 64 + 16 * mi_ + (l2_ & 15), tw_ = dir ? T - 1 - pw_ : pw_; \
            const bf16_t* wp_ = MIXp + (size_t)(row_base + tw_) * 128 + (((mi_ < 2) == lr_lo) ? 0 : 64) + (l2_ >> 4) * 8; \
            Wf[0][mi_] = *(const bf16x8*)(wp_); Wf[1][mi_] = *(const bf16x8*)(wp_ + 32); } \
    } while (0)
    {
        LAS float* PAR = (LAS float*)(lds + SC_PAR);
        const int tt = threadIdx.x;
        if (tt < 384) { const int w_ = tt >> 6, cc_ = h * 64 + (tt & 63);
            PAR[tt] = (w_ == 0) ? mu[cc_] : (w_ == 1) ? mu[1024 + cc_] : (w_ == 2) ? mu[2048 + cc_] : (w_ == 3) ? a.in[14][cc_] : (w_ == 4) ? a.in[15][cc_] : a.in[16][cc_]; }
    }
    for (int i_ = threadIdx.x; i_ < 32 * 32; i_ += 512) Tm[(i_ >> 5) * LDP + 32 + (i_ & 31)] = (bf16_t)0;
    SCAN_ISSUE(cbeg);
    for (int chunk = cbeg; chunk < nch; ++chunk) {
        int lv_ = threadIdx.x & 63; asm volatile("" : "+v"(lv_));
        const int lane = lv_, fr = lv_ & 15, fq = lv_ >> 4;
        const int tk_p = (lv_ >> 3) + 8 * wv, tk_cg = lv_ & 7;
        const int colr = h * 64 + 8 * tk_cg;
        {
            const int dmi = lr_lo ? 0 : 2, ami = lr_lo ? 2 : 0;
            f32x4 accd[2], acca[2];
#pragma unroll
            for (int mm = 0; mm < 2; ++mm) { accd[mm] = (f32x4){lr_w0, lr_w0, lr_w0, lr_w0}; acca[mm] = (f32x4){lr_a0, lr_a0, lr_a0, lr_a0}; }
#pragma unroll
            for (int ks = 0; ks < 2; ++ks) {
                const bf16x8 bw = *(const bf16x8*)(lr_bw + ks * 32 + fq * 8), ba = *(const bf16x8*)(lr_ba + ks * 32 + fq * 8);
                if (lr_lo) { MMA16(Wf[ks][0], bw, accd[0]); MMA16(Wf[ks][1], bw, accd[1]); MMA16(Wf[ks][2], ba, acca[0]); MMA16(Wf[ks][3], ba, acca[1]); }
                else       { MMA16(Wf[ks][2], bw, accd[0]); MMA16(Wf[ks][3], bw, accd[1]); MMA16(Wf[ks][0], ba, acca[0]); MMA16(Wf[ks][1], ba, acca[1]); }
            }
            const int ch = 16 * lr_strip + fr;
            float carry = 0.f;
#pragma unroll
            for (int mm = 0; mm < 2; ++mm) {
                float c[4];
#pragma unroll
                for (int r = 0; r < 4; ++r) {
                    const float lw = -0.87503878f * sigmoidf_(accd[mm][r]);
                    c[r] = (r ? c[r - 1] : 0.f) + lw;
                }
                const float t0 = __shfl(c[3], fr), t1 = __shfl(c[3], fr + 16), t2 = __shfl(c[3], fr + 32), t3 = __shfl(c[3], fr + 48);
                const float off = carry + (fq > 0 ? t0 : 0.f) + (fq > 1 ? t1 : 0.f) + (fq > 2 ? t2 : 0.f);
#pragma unroll
                for (int r = 0; r < 4; ++r) Gf[(16 * (dmi + mm) + 4 * fq + r) * GS + ch] = off + c[r];
                carry += (t0 + t1) + (t2 + t3);
            }
#pragma unroll
            for (int mm = 0; mm < 2; ++mm)
#pragma unroll
                for (int r = 0; r < 4; ++r) AGf[(16 * (ami + mm) + 4 * fq + r) * GS + ch] = sigmoidf_(acca[mm][r]);
        }
        SBAR();
        {
            const int c0 = 8 * tk_cg, p = tk_p;
            float rr[8], kx[8], vv[8];
            const bool nv[4] = {(nvm & 1) != 0, (nvm & 2) != 0, (nvm & 4) != 0, (nvm & 8) != 0};
            {
                const LAS float* PAR = (const LAS float*)(lds + SC_PAR) + c0;
                const f32x4 a0 = *(const LAS f32x4*)(PAR), a1 = *(const LAS f32x4*)(PAR + 4);
                mix8(Rs, Rn, nv, lat, a0, a1, rr);
                const f32x4 b0 = *(const LAS f32x4*)(PAR + 64), b1 = *(const LAS f32x4*)(PAR + 68);
                mix8(Ks, Kn, nv, lat, b0, b1, kx);
                const f32x4 d0 = *(const LAS f32x4*)(PAR + 128), d1 = *(const LAS f32x4*)(PAR + 132);
                mix8(Vs, Vn, nv, lat, d0, d1, vv);
                if (mode == 2) {
#pragma unroll
                    for (int e = 0; e < 8; ++e) vv[e] = 0.f; }
            }
            f32x4 g0 = *(const LAS f32x4*)(Gf + p * GS + c0), g1 = *(const LAS f32x4*)(Gf + p * GS + c0 + 4);
            const int pm = p > 0 ? p - 1 : 0;
            f32x4 q0 = *(const LAS f32x4*)(Gf + pm * GS + c0), q1 = *(const LAS f32x4*)(Gf + pm * GS + c0 + 4);
            const f32x4 h0 = *(const LAS f32x4*)(Gf + 31 * GS + c0), h1 = *(const LAS f32x4*)(Gf + 31 * GS + c0 + 4);
            if (p == 0) { q0 = (f32x4){0.f, 0.f, 0.f, 0.f}; q1 = q0; }
            if (p >= 32) { g0 += h0; g1 += h1; }
            if (p >= 33) { q0 += h0; q1 += h1; }
            const f32x4 ag0 = *(const LAS f32x4*)(AGf + p * GS + c0), ag1 = *(const LAS f32x4*)(AGf + p * GS + c0 + 4);
            const f32x4 l0 = *(const LAS f32x4*)(Gf + 63 * GS + c0) + h0, l1 = *(const LAS f32x4*)(Gf + 63 * GS + c0 + 4) + h1;
            const f32x4 kk0 = *(const LAS f32x4*)((const LAS float*)(lds + SC_PAR) + 192 + c0), kk1 = *(const LAS f32x4*)((const LAS float*)(lds + SC_PAR) + 196 + c0);
            const f32x4 ka0 = *(const LAS f32x4*)((const LAS float*)(lds + SC_PAR) + 256 + c0), ka1 = *(const LAS f32x4*)((const LAS float*)(lds + SC_PAR) + 260 + c0);
            float kkv[8], n2 = 0.f;
#pragma unroll
            for (int e = 0; e < 8; ++e) { kkv[e] = kx[e] * (e < 4 ? kk0[e] : kk1[e - 4]); n2 += kkv[e] * kkv[e]; }
            n2 += __shfl_xor(n2, 1); n2 += __shfl_xor(n2, 2); n2 += __shfl_xor(n2, 4);
            if (dir == 0 && mode != 2) {
                const f32x4 rk0 = *(const LAS f32x4*)((const LAS float*)(lds + SC_PAR) + 320 + c0), rk1 = *(const LAS f32x4*)((const LAS float*)(lds + SC_PAR) + 324 + c0);
                float bs = 0.f;
#pragma unroll
                for (int e = 0; e < 8; ++e) bs += rr[e] * kx[e] * (e < 4 ? rk0[e] : rk1[e - 4]);
                bs += __shfl_xor(bs, 1); bs += __shfl_xor(bs, 2); bs += __shfl_xor(bs, 4);
                float bo[8];
#pragma unroll
                for (int e = 0; e < 8; ++e) bo[e] = bs * vv[e];
                const int bpos = chunk * 64 + p, bt = bpos;
                *(u32x4*)((bf16_t*)a.out + BON_OFF + (size_t)(row_base + bt) * DM + h * 64 + c0) = pack8(bo);
            }
            const float inv = __builtin_amdgcn_rcpf(fmaxf(__builtin_amdgcn_sqrtf(n2), 1e-12f));
            float oa[8], orr[8], ob[8], ok[8];
#pragma unroll
            for (int e = 0; e < 8; ++e) {
                const float g = e < 4 ? g0[e] : g1[e - 4], gp = e < 4 ? q0[e] : q1[e - 4], ag = e < 4 ? ag0[e] : ag1[e - 4], gl = e < 4 ? l0[e] : l1[e - 4];
                const float kac = e < 4 ? ka0[e] : ka1[e - 4];
                const float kkn = kkv[e] * inv, kd = kx[e] * (1.0f + (ag - 1.0f) * kac), bb = kkn * ag;
                const float emg = __builtin_amdgcn_exp2f(-g), eh = __builtin_amdgcn_exp2f(gl - g);
                oa[e] = -kkn * __builtin_amdgcn_exp2f(gp); orr[e] = rr[e] * __builtin_amdgcn_exp2f(g); ob[e] = bb * emg; ok[e] = kd * emg;
                BhT[tskew(c0 + e) + p] = (bf16_t)f2bf(bb * eh);
                KhT[tskew(c0 + e) + p] = (bf16_t)f2bf(kd * eh);
                VT[tskew(c0 + e) + p] = (bf16_t)f2bf(vv[e]);
                if (p == 0) EGL[c0 + e] = __builtin_amdgcn_exp2f(gl);
            }
            *(LAS u32x4*)(At + p * LDP + c0) = pack8(oa); *(LAS u32x4*)(Rt + p * LDP + c0) = pack8(orr);
            *(LAS u32x4*)(Bt + p * LDP + c0) = pack8(ob); *(LAS u32x4*)(Kt + p * LDP + c0) = pack8(ok);
        }
        SBAR();
        {
#pragma unroll
            for (int rep = 0; rep < 2; ++rep) {
                const int tix = wv + 8 * rep;
                if (tix < 10) {
                    const int mi = tix < 4 ? 0 : tix < 7 ? 1 : tix < 9 ? 2 : 3, ni = tix < 4 ? tix : tix < 7 ? tix - 3 : tix < 9 ? tix - 5 : 3;
                    const bf16x8 x0 = ldfrag(Bt, 16 * mi + fr, 0, fq), x1 = ldfrag(Bt, 16 * mi + fr, 1, fq), y0 = ldfrag(At, 16 * ni + fr, 0, fq), y1 = ldfrag(At, 16 * ni + fr, 1, fq);
                    f32x4 c = (f32x4){0.f, 0.f, 0.f, 0.f};
                    MMA16(x0, y0, c); MMA16(x1, y1, c);
                    const int t = 16 * ni + fr, tau0 = 16 * mi + 4 * fq;
#pragma unroll
                    for (int r = 0; r < 4; ++r) if (tau0 + r >= t) c[r] = 0.f;
                    *(LAS f32x4*)(Aab + t * GS + tau0) = c;
                    if (mi < 2 && ni >= 2) st4lds((LAS bf16_t*)(lds + SC_ABA) + (t - 32) * LDQ + tau0, c);
                }
            }
        }
        SBAR();
        if (wv != 0) {
#pragma unroll 1
            for (int idx = wv - 1; idx < 48; idx += 7) {
                const int mat = 1 + (idx >> 4), mi = (idx >> 2) & 3, ni = idx & 3;
                const LAS bf16_t* X = (mat == 2) ? Bt : Kt;
                const LAS bf16_t* Y = (mat == 1) ? At : Rt;
                LAS bf16_t* dst = (mat == 1) ? Aak : (mat == 2) ? Arb : Ark;
                f32x4 c = (f32x4){0.f, 0.f, 0.f, 0.f};
                if (mi <= ni) {
                    const bf16x8 x0 = ldfrag(X, 16 * mi + fr, 0, fq), x1 = ldfrag(X, 16 * mi + fr, 1, fq), y0 = ldfrag(Y, 16 * ni + fr, 0, fq), y1 = ldfrag(Y, 16 * ni + fr, 1, fq);
                    MMA16(x0, y0, c); MMA16(x1, y1, c);
                }
                const int t = 16 * ni + fr, tau0 = 16 * mi + 4 * fq;
#pragma unroll
                for (int r = 0; r < 4; ++r) { const int tau = tau0 + r; if ((mat != 1) ? (tau > t) : (tau >= t)) c[r] = 0.f; }
                st4lds(dst + t * LDP + tau0, c);
            }
        }
        if (wv == 0) {
            LAS bf16_t* AbBA = (LAS bf16_t*)(lds + SC_ABA); LAS bf16_t* TT = UT; LAS bf16_t* WsT = UT + 32 * LDQ;
            const int hb = lane >> 5, c = lane & 31;
            const float cf = (float)c;
            float Tr[32];
#pragma unroll
            for (int t = 0; t < 32; ++t) Tr[t] = 0.f;
            {
                const int abase_i = (32 * hb) * GS + 32 * hb;
                f32x2_t TP[16];
#pragma unroll
                for (int q = 0; q < 16; ++q) TP[q] = (f32x2_t){0.f, 0.f};
                Tr[0] = 1.0f - fminf(cf, 1.0f); TP[0][0] = Tr[0];
                const f32x4 r1_0 = *(const LAS f32x4*)(Aab + abase_i + 68);
                const f32x4 r2_0 = *(const LAS f32x4*)(Aab + abase_i + 136);
                int o3 = abase_i + 204; asm volatile("" : "+v"(o3) : "v"(Tr[0]));
                const f32x4 r3_0 = *(const LAS f32x4*)(Aab + o3 + 0);
                __builtin_amdgcn_sched_barrier(0);
                { const f32x2_t pa = (f32x2_t){r1_0[0], r1_0[1]} * TP[0]; const f32x2_t pb = (f32x2_t){0.f, 0.f}; const f32x2_t ps = pa + pb;
                  Tr[1] = (ps[0] + ps[1]) + (1.0f - fminf(fabsf(cf - 1.0f), 1.0f)); TP[0][1] = Tr[1]; }
                __builtin_amdgcn_sched_barrier(0);
                int o4 = abase_i + 272; asm volatile("" : "+v"(o4) : "v"(Tr[1]));
                const f32x4 r4_0 = *(const LAS f32x4*)(Aab + o4 + 0);
                __builtin_amdgcn_sched_barrier(0);
                { const f32x2_t pa = (f32x2_t){r2_0[0], r2_0[1]} * TP[0]; const f32x2_t pb = (f32x2_t){0.f, 0.f}; const f32x2_t ps = pa + pb;
                  Tr[2] = (ps[0] + ps[1]) + (1.0f - fminf(fabsf(cf - 2.0f), 1.0f)); TP[1][0] = Tr[2]; }
                __builtin_amdgcn_sched_barrier(0);
                int o5 = abase_i + 340; asm volatile("" : "+v"(o5) : "v"(Tr[2]));
                const f32x4 r5_0 = *(const LAS f32x4*)(Aab + o5 + 0); const f32x4 r5_1 = *(const LAS f32x4*)(Aab + o5 + 4);
                __builtin_amdgcn_sched_barrier(0);
                { const f32x2_t pa = (f32x2_t){r3_0[0], r3_0[1]} * TP[0]; const f32x2_t pb = (f32x2_t){r3_0[2], r3_0[3]} * TP[1]; const f32x2_t ps = pa + pb;
                  Tr[3] = (ps[0] + ps[1]) + (1.0f - fminf(fabsf(cf - 3.0f), 1.0f)); TP[1][1] = Tr[3]; }
                __builtin_amdgcn_sched_barrier(0);
                int o6 = abase_i + 408; asm volatile("" : "+v"(o6) : "v"(Tr[3]));
                const f32x4 r6_0 = *(const LAS f32x4*)(Aab + o6 + 0); const f32x4 r6_1 = *(const LAS f32x4*)(Aab + o6 + 4);
                __builtin_amdgcn_sched_barrier(0);
                { const f32x2_t pa = (f32x2_t){r4_0[0], r4_0[1]} * TP[0]; const f32x2_t pb = (f32x2_t){r4_0[2], r4_0[3]} * TP[1]; const f32x2_t ps = pa + pb;
                  Tr[4] = (ps[0] + ps[1]) + (1.0f - fminf(fabsf(cf - 4.0f), 1.0f)); TP[2][0] = Tr[4]; }
                __builtin_amdgcn_sched_barrier(0);
                int o7 = abase_i + 476; asm volatile("" : "+v"(o7) : "v"(Tr[4]));
                const f32x4 r7_0 = *(const LAS f32x4*)(Aab + o7 + 0); const f32x4 r7_1 = *(const LAS f32x4*)(Aab + o7 + 4);
                __builtin_amdgcn_sched_barrier(0);
                { const f32x2_t pa = (f32x2_t){r5_0[0], r5_0[1]} * TP[0] + (f32x2_t){r5_1[0], r5_1[1]} * TP[2]; const f32x2_t pb = (f32x2_t){r5_0[2], r5_0[3]} * TP[1]; const f32x2_t ps = pa + pb;
                  Tr[5] = (ps[0] + ps[1]) + (1.0f - fminf(fabsf(cf - 5.0f), 1.0f)); TP[2][1] = Tr[5]; }
                __builtin_amdgcn_sched_barrier(0);
                int o8 = abase_i + 544; asm volatile("" : "+v"(o8) : "v"(Tr[5]));
                const f32x4 r8_0 = *(const LAS f32x4*)(Aab + o8 + 0); const f32x4 r8_1 = *(const LAS f32x4*)(Aab + o8 + 4);
                __builtin_amdgcn_sched_barrier(0);
                { const f32x2_t pa = (f32x2_t){r6_0[0], r6_0[1]} * TP[0] + (f32x2_t){r6_1[0], r6_1[1]} * TP[2]; const f32x2_t pb = (f32x2_t){r6_0[2], r6_0[3]} * TP[1]; const f32x2_t ps = pa + pb;
                  Tr[6] = (ps[0] + ps[1]) + (1.0f - fminf(fabsf(cf - 6.0f), 1.0f)); TP[3][0] = Tr[6]; }
                __builtin_amdgcn_sched_barrier(0);
                int o9 = abase_i + 612; asm volatile("" : "+v"(o9) : "v"(Tr[6]));
                const f32x4 r9_0 = *(const LAS f32x4*)(Aab + o9 + 0); const f32x4 r9_1 = *(const LAS f32x4*)(Aab + o9 + 4); const f32x4 r9_2 = *(const LAS f32x4*)(Aab + o9 + 8);
                __builtin_amdgcn_sched_barrier(0);
                { const f32x2_t pa = (f32x2_t){r7_0[0], r7_0[1]} * TP[0] + (f32x2_t){r7_1[0], r7_1[1]} * TP[2]; const f32x2_t pb = (f32x2_t){r7_0[2], r7_0[3]} * TP[1] + (f32x2_t){r7_1[2], r7_1[3]} * TP[3]; const f32x2_t ps = pa + pb;
                  Tr[7] = (ps[0] + ps[1]) + (1.0f - fminf(fabsf(cf - 7.0f), 1.0f)); TP[3][1] = Tr[7]; }
                __builtin_amdgcn_sched_barrier(0);
                int o10 = abase_i + 680; asm volatile("" : "+v"(o10) : "v"(Tr[7]));
                const f32x4 r10_0 = *(const LAS f32x4*)(Aab + o10 + 0); const f32x4 r10_1 = *(const LAS f32x4*)(Aab + o10 + 4); const f32x4 r10_2 = *(const LAS f32x4*)(Aab + o10 + 8);
                __builtin_amdgcn_sched_barrier(0);
                { const f32x2_t pa = (f32x2_t){r8_0[0], r8_0[1]} * TP[0] + (f32x2_t){r8_1[0], r8_1[1]} * TP[2]; const f32x2_t pb = (f32x2_t){r8_0[2], r8_0[3]} * TP[1] + (f32x2_t){r8_1[2], r8_1[3]} * TP[3]; const f32x2_t ps = pa + pb;
                  Tr[8] = (ps[0] + ps[1]) + (1.0f - fminf(fabsf(cf - 8.0f), 1.0f)); TP[4][0] = Tr[8]; }
                __builtin_amdgcn_sched_barrier(0);
                int o11 = abase_i + 748; asm volatile("" : "+v"(o11) : "v"(Tr[8]));
                const f32x4 r11_0 = *(const LAS f32x4*)(Aab + o11 + 0); const f32x4 r11_1 = *(const LAS f32x4*)(Aab + o11 + 4); const f32x4 r11_2 = *(const LAS f32x4*)(Aab + o11 + 8);
                __builtin_amdgcn_sched_barrier(0);
                { const f32x2_t pa = (f32x2_t){r9_0[0], r9_0[1]} * TP[0] + (f32x2_t){r9_1[0], r9_1[1]} * TP[2] + (f32x2_t){r9_2[0], r9_2[1]} * TP[4]; const f32x2_t pb = (f32x2_t){r9_0[2], r9_0[3]} * TP[1] + (f32x2_t){r9_1[2], r9_1[3]} * TP[3]; const f32x2_t ps = pa + pb;
                  Tr[9] = (ps[0] + ps[1]) + (1.0f - fminf(fabsf(cf - 9.0f), 1.0f)); TP[4][1] = Tr[9]; }
                __builtin_amdgcn_sched_barrier(0);
                int o12 = abase_i + 816; asm volatile("" : "+v"(o12) : "v"(Tr[9]));
                const f32x4 r12_0 = *(const LAS f32x4*)(Aab + o12 + 0); const f32x4 r12_1 = *(const LAS f32x4*)(Aab + o12 + 4); const f32x4 r12_2 = *(const LAS f32x4*)(Aab + o12 + 8);
                __builtin_amdgcn_sched_barrier(0);
                { const f32x2_t pa = (f32x2_t){r10_0[0], r10_0[1]} * TP[0] + (f32x2_t){r10_1[0], r10_1[1]} * TP[2] + (f32x2_t){r10_2[0], r10_2[1]} * TP[4]; const f32x2_t pb = (f32x2_t){r10_0[2], r10_0[3]} * TP[1] + (f32x2_t){r10_1[2], r10_1[3]} * TP[3]; const f32x2_t ps = pa + pb;
                  Tr[10] = (ps[0] + ps[1]) + (1.0f - fminf(fabsf(cf - 10.0f), 1.0f)); TP[5][0] = Tr[10]; }
                __builtin_amdgcn_sched_barrier(0);
                int o13 = abase_i + 884; asm volatile("" : "+v"(o13) : "v"(Tr[10]));
                const f32x4 r13_0 = *(const LAS f32x4*)(Aab + o13 + 0); const f32x4 r13_1 = *(const LAS f32x4*)(Aab + o13 + 4); const f32x4 r13_2 = *(const LAS f32x4*)(Aab + o13 + 8); const f32x4 r13_3 = *(const LAS f32x4*)(Aab + o13 + 12);
                __builtin_amdgcn_sched_barrier(0);
                { const f32x2_t pa = (f32x2_t){r11_0[0], r11_0[1]} * TP[0] + (f32x2_t){r11_1[0], r11_1[1]} * TP[2] + (f32x2_t){r11_2[0], r11_2[1]} * TP[4]; const f32x2_t pb = (f32x2_t){r11_0[2], r11_0[3]} * TP[1] + (f32x2_t){r11_1[2], r11_1[3]} * TP[3] + (f32x2_t){r11_2[2], r11_2[3]} * TP[5]; const f32x2_t ps = pa + pb;
                  Tr[11] = (ps[0] + ps[1]) + (1.0f - fminf(fabsf(cf - 11.0f), 1.0f)); TP[5][1] = Tr[11]; }
                __builtin_amdgcn_sched_barrier(0);
                int o14 = abase_i + 952; asm volatile("" : "+v"(o14) : "v"(Tr[11]));
                const f32x4 r14_0 = *(const LAS f32x4*)(Aab + o14 + 0); const f32x4 r14_1 = *(const LAS f32x4*)(Aab + o14 + 4); const f32x4 r14_2 = *(const LAS f32x4*)(Aab + o14 + 8); const f32x4 r14_3 = *(const LAS f32x4*)(Aab + o14 + 12);
                __builtin_amdgcn_sched_barrier(0);
                { const f32x2_t pa = (f32x2_t){r12_0[0], r12_0[1]} * TP[0] + (f32x2_t){r12_1[0], r12_1[1]} * TP[2] + (f32x2_t){r12_2[0], r12_2[1]} * TP[4]; const f32x2_t pb = (f32x2_t){r12_0[2], r12_0[3]} * TP[1] + (f32x2_t){r12_1[2], r12_1[3]} * TP[3] + (f32x2_t){r12_2[2], r12_2[3]} * TP[5]; const f32x2_t ps = pa + pb;
                  Tr[12] = (ps[0] + ps[1]) + (1.0f - fminf(fabsf(cf - 12.0f), 1.0f)); TP[6][0] = Tr[12]; }
                __builtin_amdgcn_sched_barrier(0);
                int o15 = abase_i + 1020; asm volatile("" : "+v"(o15) : "v"(Tr[12]));
                const f32x4 r15_0 = *(const LAS f32x4*)(Aab + o15 + 0); const f32x4 r15_1 = *(const LAS f32x4*)(Aab + o15 + 4); const f32x4 r15_2 = *(const LAS f32x4*)(Aab + o15 + 8); const f32x4 r15_3 = *(const LAS f32x4*)(Aab + o15 + 12);
                __builtin_amdgcn_sched_barrier(0);
                { const f32x2_t pa = (f32x2_t){r13_0[0], r13_0[1]} * TP[0] + (f32x2_t){r13_1[0], r13_1[1]} * TP[2] + (f32x2_t){r13_2[0], r13_2[1]} * TP[4] + (f32x2_t){r13_3[0], r13_3[1]} * TP[6]; const f32x2_t pb = (f32x2_t){r13_0[2], r13_0[3]} * TP[1] + (f32x2_t){r13_1[2], r13_1[3]} * TP[3] + (f32x2_t){r13_2[2], r13_2[3]} * TP[5]; const f32x2_t ps = pa + pb;
                  Tr[13] = (ps[0] + ps[1]) + (1.0f - fminf(fabsf(cf - 13.0f), 1.0f)); TP[6][1] = Tr[13]; }
                __builtin_amdgcn_sched_barrier(0);
                int o16 = abase_i + 1088; asm volatile("" : "+v"(o16) : "v"(Tr[13]));
                const f32x4 r16_0 = *(const LAS f32x4*)(Aab + o16 + 0); const f32x4 r16_1 = *(const LAS f32x4*)(Aab + o16 + 4); const f32x4 r16_2 = *(const LAS f32x4*)(Aab + o16 + 8); const f32x4 r16_3 = *(const LAS f32x4*)(Aab + o16 + 12);
                __builtin_amdgcn_sched_barrier(0);
                { const f32x2_t pa = (f32x2_t){r14_0[0], r14_0[1]} * TP[0] + (f32x2_t){r14_1[0], r14_1[1]} * TP[2] + (f32x2_t){r14_2[0], r14_2[1]} * TP[4] + (f32x2_t){r14_3[0], r14_3[1]} * TP[6]; const f32x2_t pb = (f32x2_t){r14_0[2], r14_0[3]} * TP[1] + (f32x2_t){r14_1[2], r14_1[3]} * TP[3] + (f32x2_t){r14_2[2], r14_2[3]} * TP[5]; const f32x2_t ps = pa + pb;
                  Tr[14] = (ps[0] + ps[1]) + (1.0f - fminf(fabsf(cf - 14.0f), 1.0f)); TP[7][0] = Tr[14]; }
                __builtin_amdgcn_sched_barrier(0);
                int o17 = abase_i + 1156; asm volatile("" : "+v"(o17) : "v"(Tr[14]));
                const f32x4 r17_0 = *(const LAS f32x4*)(Aab + o17 + 0); const f32x4 r17_1 = *(const LAS f32x4*)(Aab + o17 + 4); const f32x4 r17_2 = *(const LAS f32x4*)(Aab + o17 + 8); const f32x4 r17_3 = *(const LAS f32x4*)(Aab + o17 + 12); const f32x4 r17_4 = *(const LAS f32x4*)(Aab + o17 + 16);
                __builtin_amdgcn_sched_barrier(0);
                { const f32x2_t pa = (f32x2_t){r15_0[0], r15_0[1]} * TP[0] + (f32x2_t){r15_1[0], r15_1[1]} * TP[2] + (f32x2_t){r15_2[0], r15_2[1]} * TP[4] + (f32x2_t){r15_3[0], r15_3[1]} * TP[6]; const f32x2_t pb = (f32x2_t){r15_0[2], r15_0[3]} * TP[1] + (f32x2_t){r15_1[2], r15_1[3]} * TP[3] + (f32x2_t){r15_2[2], r15_2[3]} * TP[5] + (f32x2_t){r15_3[2], r15_3[3]} * TP[7]; const f32x2_t ps = pa + pb;
                  Tr[15] = (ps[0] + ps[1]) + (1.0f - fminf(fabsf(cf - 15.0f), 1.0f)); TP[7][1] = Tr[15]; }
                __builtin_amdgcn_sched_barrier(0);
                int o18 = abase_i + 1224; asm volatile("" : "+v"(o18) : "v"(Tr[15]));
                const f32x4 r18_0 = *(const LAS f32x4*)(Aab + o18 + 0); const f32x4 r18_1 = *(const LAS f32x4*)(Aab + o18 + 4); const f32x4 r18_2 = *(const LAS f32x4*)(Aab + o18 + 8); const f32x4 r18_3 = *(const LAS f32x4*)(Aab + o18 + 12); const f32x4 r18_4 = *(const LAS f32x4*)(Aab + o18 + 16);
                __builtin_amdgcn_sched_barrier(0);
                { const f32x2_t pa = (f32x2_t){r16_0[0], r16_0[1]} * TP[0] + (f32x2_t){r16_1[0], r16_1[1]} * TP[2] + (f32x2_t){r16_2[0], r16_2[1]} * TP[4] + (f32x2_t){r16_3[0], r16_3[1]} * TP[6]; const f32x2_t pb = (f32x2_t){r16_0[2], r16_0[3]} * TP[1] + (f32x2_t){r16_1[2], r16_1[3]} * TP[3] + (f32x2_t){r16_2[2], r16_2[3]} * TP[5] + (f32x2_t){r16_3[2], r16_3[3]} * TP[7]; const f32x2_t ps = pa + pb;
                  Tr[16] = (ps[0] + ps[1]) + (1.0f - fminf(fabsf(cf - 16.0f), 1.0f)); TP[8][0] = Tr[16]; }
                __builtin_amdgcn_sched_barrier(0);
                int o19 = abase_i + 1292; asm volatile("" : "+v"(o19) : "v"(Tr[16]));
                const f32x4 r19_0 = *(const LAS f32x4*)(Aab + o19 + 0); const f32x4 r19_1 = *(const LAS f32x4*)(Aab + o19 + 4); const f32x4 r19_2 = *(const LAS f32x4*)(Aab + o19 + 8); const f32x4 r19_3 = *(const LAS f32x4*)(Aab + o19 + 12); const f32x4 r19_4 = *(const LAS f32x4*)(Aab + o19 + 16);
                __builtin_amdgcn_sched_barrier(0);
                { const f32x2_t pa = (f32x2_t){r17_0[0], r17_0[1]} * TP[0] + (f32x2_t){r17_1[0], r17_1[1]} * TP[2] + (f32x2_t){r17_2[0], r17_2[1]} * TP[4] + (f32x2_t){r17_3[0], r17_3[1]} * TP[6] + (f32x2_t){r17_4[0], r17_4[1]} * TP[8]; const f32x2_t pb = (f32x2_t){r17_0[2], r17_0[3]} * TP[1] + (f32x2_t){r17_1[2], r17_1[3]} * TP[3] + (f32x2_t){r17_2[2], r17_2[3]} * TP[5] + (f32x2_t){r17_3[2], r17_3[3]} * TP[7]; const f32x2_t ps = pa + pb;
                  Tr[17] = (ps[0] + ps[1]) + (1.0f - fminf(fabsf(cf - 17.0f), 1.0f)); TP[8][1] = Tr[17]; }
                __builtin_amdgcn_sched_barrier(0);
                int o20 = abase_i + 1360; asm volatile("" : "+v"(o20) : "v"(Tr[17]));
                const f32x4 r20_0 = *(const LAS f32x4*)(Aab + o20 + 0); const f32x4 r20_1 = *(const LAS f32x4*)(Aab + o20 + 4); const f32x4 r20_2 = *(const LAS f32x4*)(Aab + o20 + 8); const f32x4 r20_3 = *(const LAS f32x4*)(Aab + o20 + 12); const f32x4 r20_4 = *(const LAS f32x4*)(Aab + o20 + 16);
                __builtin_amdgcn_sched_barrier(0);
                { const f32x2_t pa = (f32x2_t){r18_0[0], r18_0[1]} * TP[0] + (f32x2_t){r18_1[0], r18_1[1]} * TP[2] + (f32x2_t){r18_2[0], r18_2[1]} * TP[4] + (f32x2_t){r18_3[0], r18_3[1]} * TP[6] + (f32x2_t){r18_4[0], r18_4[1]} * TP[8]; const f32x2_t pb = (f32x2_t){r18_0[2], r18_0[3]} * TP[1] + (f32x2_t){r18_1[2], r18_1[3]} * TP[3] + (f32x2_t){r18_2[2], r18_2[3]} * TP[5] + (f32x2_t){r18_3[2], r18_3[3]} * TP[7]; const f32x2_t ps = pa + pb;
                  Tr[18] = (ps[0] + ps[1]) + (1.0f - fminf(fabsf(cf - 18.0f), 1.0f)); TP[9][0] = Tr[18]; }
                __builtin_amdgcn_sched_barrier(0);
                int o21 = abase_i + 1428; asm volatile("" : "+v"(o21) : "v"(Tr[18]));
                const f32x4 r21_0 = *(const LAS f32x4*)(Aab + o21 + 0); const f32x4 r21_1 = *(const LAS f32x4*)(Aab + o21 + 4); const f32x4 r21_2 = *(const LAS f32x4*)(Aab + o21 + 8); const f32x4 r21_3 = *(const LAS f32x4*)(Aab + o21 + 12); const f32x4 r21_4 = *(const LAS f32x4*)(Aab + o21 + 16); const f32x4 r21_5 = *(const LAS f32x4*)(Aab + o21 + 20);
                __builtin_amdgcn_sched_barrier(0);
                { const f32x2_t pa = (f32x2_t){r19_0[0], r19_0[1]} * TP[0] + (f32x2_t){r19_1[0], r19_1[1]} * TP[2] + (f32x2_t){r19_2[0], r19_2[1]} * TP[4] + (f32x2_t){r19_3[0], r19_3[1]} * TP[6] + (f32x2_t){r19_4[0], r19_4[1]} * TP[8]; const f32x2_t pb = (f32x2_t){r19_0[2], r19_0[3]} * TP[1] + (f32x2_t){r19_1[2], r19_1[3]} * TP[3] + (f32x2_t){r19_2[2], r19_2[3]} * TP[5] + (f32x2_t){r19_3[2], r19_3[3]} * TP[7] + (f32x2_t){r19_4[2], r19_4[3]} * TP[9]; const f32x2_t ps = pa + pb;
                  Tr[19] = (ps[0] + ps[1]) + (1.0f - fminf(fabsf(cf - 19.0f), 1.0f)); TP[9][1] = Tr[19]; }
                __builtin_amdgcn_sched_barrier(0);
                int o22 = abase_i + 1496; asm volatile("" : "+v"(o22) : "v"(Tr[19]));
                const f32x4 r22_0 = *(const LAS f32x4*)(Aab + o22 + 0); const f32x4 r22_1 = *(const LAS f32x4*)(Aab + o22 + 4); const f32x4 r22_2 = *(const LAS f32x4*)(Aab + o22 + 8); const f32x4 r22_3 = *(const LAS f32x4*)(Aab + o22 + 12); const f32x4 r22_4 = *(const LAS f32x4*)(Aab + o22 + 16); const f32x4 r22_5 = *(const LAS f32x4*)(Aab + o22 + 20);
                __builtin_amdgcn_sched_barrier(0);
                { const f32x2_t pa = (f32x2_t){r20_0[0], r20_0[1]} * TP[0] + (f32x2_t){r20_1[0], r20_1[1]} * TP[2] + (f32x2_t){r20_2[0], r20_2[1]} * TP[4] + (f32x2_t){r20_3[0], r20_3[1]} * TP[6] + (f32x2_t){r20_4[0], r20_4[1]} * TP[8]; const f32x2_t pb = (f32x2_t){r20_0[2], r20_0[3]} * TP[1] + (f32x2_t){r20_1[2], r20_1[3]} * TP[3] + (f32x2_t){r20_2[2], r20_2[3]} * TP[5] + (f32x2_t){r20_3[2], r20_3[3]} * TP[7] + (f32x2_t){r20_4[2], r20_4[3]} * TP[9]; const f32x2_t ps = pa + pb;
                  Tr[20] = (ps[0] + ps[1]) + (1.0f - fminf(fabsf(cf - 20.0f), 1.0f)); TP[10][0] = Tr[20]; }
                __builtin_amdgcn_sched_barrier(0);
                int o23 = abase_i + 1564; asm volatile("" : "+v"(o23) : "v"(Tr[20]));
                const f32x4 r23_0 = *(const LAS f32x4*)(Aab + o23 + 0); const f32x4 r23_1 = *(const LAS f32x4*)(Aab + o23 + 4); const f32x4 r23_2 = *(const LAS f32x4*)(Aab + o23 + 8); const f32x4 r23_3 = *(const LAS f32x4*)(Aab + o23 + 12); const f32x4 r23_4 = *(const LAS f32x4*)(Aab + o23 + 16); const f32x4 r23_5 = *(const LAS f32x4*)(Aab + o23 + 20);
                __builtin_amdgcn_sched_barrier(0);
                { const f32x2_t pa = (f32x2_t){r21_0[0], r21_0[1]} * TP[0] + (f32x2_t){r21_1[0], r21_1[1]} * TP[2] + (f32x2_t){r21_2[0], r21_2[1]} * TP[4] + (f32x2_t){r21_3[0], r21_3[1]} * TP[6] + (f32x2_t){r21_4[0], r21_4[1]} * TP[8] + (f32x2_t){r21_5[0], r21_5[1]} * TP[10]; const f32x2_t pb = (f32x2_t){r21_0[2], r21_0[3]} * TP[1] + (f32x2_t){r21_1[2], r21_1[3]} * TP[3] + (f32x2_t){r21_2[2], r21_2[3]} * TP[5] + (f32x2_t){r21_3[2], r21_3[3]} * TP[7] + (f32x2_t){r21_4[2], r21_4[3]} * TP[9]; const f32x2_t ps = pa + pb;
                  Tr[21] = (ps[0] + ps[1]) + (1.0f - fminf(fabsf(cf - 21.0f), 1.0f)); TP[10][1] = Tr[21]; }
                __builtin_amdgcn_sched_barrier(0);
                int o24 = abase_i + 1632; asm volatile("" : "+v"(o24) : "v"(Tr[21]));
                const f32x4 r24_0 = *(const LAS f32x4*)(Aab + o24 + 0); const f32x4 r24_1 = *(const LAS f32x4*)(Aab + o24 + 4); const f32x4 r24_2 = *(const LAS f32x4*)(Aab + o24 + 8); const f32x4 r24_3 = *(const LAS f32x4*)(Aab + o24 + 12); const f32x4 r24_4 = *(const LAS f32x4*)(Aab + o24 + 16); const f32x4 r24_5 = *(const LAS f32x4*)(Aab + o24 + 20);
                __builtin_amdgcn_sched_barrier(0);
                { const f32x2_t pa = (f32x2_t){r22_0[0], r22_0[1]} * TP[0] + (f32x2_t){r22_1[0], r22_1[1]} * TP[2] + (f32x2_t){r22_2[0], r22_2[1]} * TP[4] + (f32x2_t){r22_3[0], r22_3[1]} * TP[6] + (f32x2_t){r22_4[0], r22_4[1]} * TP[8] + (f32x2_t){r22_5[0], r22_5[1]} * TP[10]; const f32x2_t pb = (f32x2_t){r22_0[2], r22_0[3]} * TP[1] + (f32x2_t){r22_1[2], r22_1[3]} * TP[3] + (f32x2_t){r22_2[2], r22_2[3]} * TP[5] + (f32x2_t){r22_3[2], r22_3[3]} * TP[7] + (f32x2_t){r22_4[2], r22_4[3]} * TP[9]; const f32x2_t ps = pa + pb;
                  Tr[22] = (ps[0] + ps[1]) + (1.0f - fminf(fabsf(cf - 22.0f), 1.0f)); TP[11][0] = Tr[22]; }
                __builtin_amdgcn_sched_barrier(0);
                int o25 = abase_i + 1700; asm volatile("" : "+v"(o25) : "v"(Tr[22]));
                const f32x4 r25_0 = *(const LAS f32x4*)(Aab + o25 + 0); const f32x4 r25_1 = *(const LAS f32x4*)(Aab + o25 + 4); const f32x4 r25_2 = *(const LAS f32x4*)(Aab + o25 + 8); const f32x4 r25_3 = *(const LAS f32x4*)(Aab + o25 + 12); const f32x4 r25_4 = *(const LAS f32x4*)(Aab + o25 + 16); const f32x4 r25_5 = *(const LAS f32x4*)(Aab + o25 + 20); const f32x4 r25_6 = *(const LAS f32x4*)(Aab + o25 + 24);
                __builtin_amdgcn_sched_barrier(0);
                { const f32x2_t pa = (f32x2_t){r23_0[0], r23_0[1]} * TP[0] + (f32x2_t){r23_1[0], r23_1[1]} * TP[2] + (f32x2_t){r23_2[0], r23_2[1]} * TP[4] + (f32x2_t){r23_3[0], r23_3[1]} * TP[6] + (f32x2_t){r23_4[0], r23_4[1]} * TP[8] + (f32x2_t){r23_5[0], r23_5[1]} * TP[10]; const f32x2_t pb = (f32x2_t){r23_0[2], r23_0[3]} * TP[1] + (f32x2_t){r23_1[2], r23_1[3]} * TP[3] + (f32x2_t){r23_2[2], r23_2[3]} * TP[5] + (f32x2_t){r23_3[2], r23_3[3]} * TP[7] + (f32x2_t){r23_4[2], r23_4[3]} * TP[9] + (f32x2_t){r23_5[2], r23_5[3]} * TP[11]; const f32x2_t ps = pa + pb;
                  Tr[23] = (ps[0] + ps[1]) + (1.0f - fminf(fabsf(cf - 23.0f), 1.0f)); TP[11][1] = Tr[23]; }
                __builtin_amdgcn_sched_barrier(0);
                int o26 = abase_i + 1768; asm volatile("" : "+v"(o26) : "v"(Tr[23]));
                const f32x4 r26_0 = *(const LAS f32x4*)(Aab + o26 + 0); const f32x4 r26_1 = *(const LAS f32x4*)(Aab + o26 + 4); const f32x4 r26_2 = *(const LAS f32x4*)(Aab + o26 + 8); const f32x4 r26_3 = *(const LAS f32x4*)(Aab + o26 + 12); const f32x4 r26_4 = *(const LAS f32x4*)(Aab + o26 + 16); const f32x4 r26_5 = *(const LAS f32x4*)(Aab + o26 + 20); const f32x4 r26_6 = *(const LAS f32x4*)(Aab + o26 + 24);
                __builtin_amdgcn_sched_barrier(0);
                { const f32x2_t pa = (f32x2_t){r24_0[0], r24_0[1]} * TP[0] + (f32x2_t){r24_1[0], r24_1[1]} * TP[2] + (f32x2_t){r24_2[0], r24_2[1]} * TP[4] + (f32x2_t){r24_3[0], r24_3[1]} * TP[6] + (f32x2_t){r24_4[0], r24_4[1]} * TP[8] + (f32x2_t){r24_5[0], r24_5[1]} * TP[10]; const f32x2_t pb = (f32x2_t){r24_0[2], r24_0[3]} * TP[1] + (f32x2_t){r24_1[2], r24_1[3]} * TP[3] + (f32x2_t){r24_2[2], r24_2[3]} * TP[5] + (f32x2_t){r24_3[2], r24_3[3]} * TP[7] + (f32x2_t){r24_4[2], r24_4[3]} * TP[9] + (f32x2_t){r24_5[2], r24_5[3]} * TP[11]; const f32x2_t ps = pa + pb;
                  Tr[24] = (ps[0] + ps[1]) + (1.0f - fminf(fabsf(cf - 24.0f), 1.0f)); TP[12][0] = Tr[24]; }
                __builtin_amdgcn_sched_barrier(0);
                int o27 = abase_i + 1836; asm volatile("" : "+v"(o27) : "v"(Tr[24]));
                const f32x4 r27_0 = *(const LAS f32x4*)(Aab + o27 + 0); const f32x4 r27_1 = *(const LAS f32x4*)(Aab + o27 + 4); const f32x4 r27_2 = *(const LAS f32x4*)(Aab + o27 + 8); const f32x4 r27_3 = *(const LAS f32x4*)(Aab + o27 + 12); const f32x4 r27_4 = *(const LAS f32x4*)(Aab + o27 + 16); const f32x4 r27_5 = *(const LAS f32x4*)(Aab + o27 + 20); const f32x4 r27_6 = *(const LAS f32x4*)(Aab + o27 + 24);
                __builtin_amdgcn_sched_barrier(0);
                { const f32x2_t pa = (f32x2_t){r25_0[0], r25_0[1]} * TP[0] + (f32x2_t){r25_1[0], r25_1[1]} * TP[2] + (f32x2_t){r25_2[0], r25_2[1]} * TP[4] + (f32x2_t){r25_3[0], r25_3[1]} * TP[6] + (f32x2_t){r25_4[0], r25_4[1]} * TP[8] + (f32x2_t){r25_5[0], r25_5[1]} * TP[10] + (f32x2_t){r25_6[0], r25_6[1]} * TP[12]; const f32x2_t pb = (f32x2_t){r25_0[2], r25_0[3]} * TP[1] + (f32x2_t){r25_1[2], r25_1[3]} * TP[3] + (f32x2_t){r25_2[2], r25_2[3]} * TP[5] + (f32x2_t){r25_3[2], r25_3[3]} * TP[7] + (f32x2_t){r25_4[2], r25_4[3]} * TP[9] + (f32x2_t){r25_5[2], r25_5[3]} * TP[11]; const f32x2_t ps = pa + pb;
                  Tr[25] = (ps[0] + ps[1]) + (1.0f - fminf(fabsf(cf - 25.0f), 1.0f)); TP[12][1] = Tr[25]; }
                __builtin_amdgcn_sched_barrier(0);
                int o28 = abase_i + 1904; asm volatile("" : "+v"(o28) : "v"(Tr[25]));
                const f32x4 r28_0 = *(const LAS f32x4*)(Aab + o28 + 0); const f32x4 r28_1 = *(const LAS f32x4*)(Aab + o28 + 4); const f32x4 r28_2 = *(const LAS f32x4*)(Aab + o28 + 8); const f32x4 r28_3 = *(const LAS f32x4*)(Aab + o28 + 12); const f32x4 r28_4 = *(const LAS f32x4*)(Aab + o28 + 16); const f32x4 r28_5 = *(const LAS f32x4*)(Aab + o28 + 20); const f32x4 r28_6 = *(const LAS f32x4*)(Aab + o28 + 24);
                __builtin_amdgcn_sched_barrier(0);
                { const f32x2_t pa = (f32x2_t){r26_0[0], r26_0[1]} * TP[0] + (f32x2_t){r26_1[0], r26_1[1]} * TP[2] + (f32x2_t){r26_2[0], r26_2[1]} * TP[4] + (f32x2_t){r26_3[0], r26_3[1]} * TP[6] + (f32x2_t){r26_4[0], r26_4[1]} * TP[8] + (f32x2_t){r26_5[0], r26_5[1]} * TP[10] + (f32x2_t){r26_6[0], r26_6[1]} * TP[12]; const f32x2_t pb = (f32x2_t){r26_0[2], r26_0[3]} * TP[1] + (f32x2_t){r26_1[2], r26_1[3]} * TP[3] + (f32x2_t){r26_2[2], r26_2[3]} * TP[5] + (f32x2_t){r26_3[2], r26_3[3]} * TP[7] + (f32x2_t){r26_4[2], r26_4[3]} * TP[9] + (f32x2_t){r26_5[2], r26_5[3]} * TP[11]; const f32x2_t ps = pa + pb;
                  Tr[26] = (ps[0] + ps[1]) + (1.0f - fminf(fabsf(cf - 26.0f), 1.0f)); TP[13][0] = Tr[26]; }
                __builtin_amdgcn_sched_barrier(0);
                int o29 = abase_i + 1972; asm volatile("" : "+v"(o29) : "v"(Tr[26]));
                const f32x4 r29_0 = *(const LAS f32x4*)(Aab + o29 + 0); const f32x4 r29_1 = *(const LAS f32x4*)(Aab + o29 + 4); const f32x4 r29_2 = *(const LAS f32x4*)(Aab + o29 + 8); const f32x4 r29_3 = *(const LAS f32x4*)(Aab + o29 + 12); const f32x4 r29_4 = *(const LAS f32x4*)(Aab + o29 + 16); const f32x4 r29_5 = *(const LAS f32x4*)(Aab + o29 + 20); const f32x4 r29_6 = *(const LAS f32x4*)(Aab + o29 + 24); const f32x4 r29_7 = *(const LAS f32x4*)(Aab + o29 + 28);
                __builtin_amdgcn_sched_barrier(0);
                { const f32x2_t pa = (f32x2_t){r27_0[0], r27_0[1]} * TP[0] + (f32x2_t){r27_1[0], r27_1[1]} * TP[2] + (f32x2_t){r27_2[0], r27_2[1]} * TP[4] + (f32x2_t){r27_3[0], r27_3[1]} * TP[6] + (f32x2_t){r27_4[0], r27_4[1]} * TP[8] + (f32x2_t){r27_5[0], r27_5[1]} * TP[10] + (f32x2_t){r27_6[0], r27_6[1]} * TP[12]; const f32x2_t pb = (f32x2_t){r27_0[2], r27_0[3]} * TP[1] + (f32x2_t){r27_1[2], r27_1[3]} * TP[3] + (f32x2_t){r27_2[2], r27_2[3]} * TP[5] + (f32x2_t){r27_3[2], r27_3[3]} * TP[7] + (f32x2_t){r27_4[2], r27_4[3]} * TP[9] + (f32x2_t){r27_5[2], r27_5[3]} * TP[11] + (f32x2_t){r27_6[2], r27_6[3]} * TP[13]; const f32x2_t ps = pa + pb;
                  Tr[27] = (ps[0] + ps[1]) + (1.0f - fminf(fabsf(cf - 27.0f), 1.0f)); TP[13][1] = Tr[27]; }
                __builtin_amdgcn_sched_barrier(0);
                int o30 = abase_i + 2040; asm volatile("" : "+v"(o30) : "v"(Tr[27]));
                const f32x4 r30_0 = *(const LAS f32x4*)(Aab + o30 + 0); const f32x4 r30_1 = *(const LAS f32x4*)(Aab + o30 + 4); const f32x4 r30_2 = *(const LAS f32x4*)(Aab + o30 + 8); const f32x4 r30_3 = *(const LAS f32x4*)(Aab + o30 + 12); const f32x4 r30_4 = *(const LAS f32x4*)(Aab + o30 + 16); const f32x4 r30_5 = *(const LAS f32x4*)(Aab + o30 + 20); const f32x4 r30_6 = *(const LAS f32x4*)(Aab + o30 + 24); const f32x4 r30_7 = *(const LAS f32x4*)(Aab + o30 + 28);
                __builtin_amdgcn_sched_barrier(0);
                { const f32x2_t pa = (f32x2_t){r28_0[0], r28_0[1]} * TP[0] + (f32x2_t){r28_1[0], r28_1[1]} * TP[2] + (f32x2_t){r28_2[0], r28_2[1]} * TP[4] + (f32x2_t){r28_3[0], r28_3[1]} * TP[6] + (f32x2_t){r28_4[0], r28_4[1]} * TP[8] + (f32x2_t){r28_5[0], r28_5[1]} * TP[10] + (f32x2_t){r28_6[0], r28_6[1]} * TP[12]; const f32x2_t pb = (f32x2_t){r28_0[2], r28_0[3]} * TP[1] + (f32x2_t){r28_1[2], r28_1[3]} * TP[3] + (f32x2_t){r28_2[2], r28_2[3]} * TP[5] + (f32x2_t){r28_3[2], r28_3[3]} * TP[7] + (f32x2_t){r28_4[2], r28_4[3]} * TP[9] + (f32x2_t){r28_5[2], r28_5[3]} * TP[11] + (f32x2_t){r28_6[2], r28_6[3]} * TP[13]; const f32x2_t ps = pa + pb;
                  Tr[28] = (ps[0] + ps[1]) + (1.0f - fminf(fabsf(cf - 28.0f), 1.0f)); TP[14][0] = Tr[28]; }
                __builtin_amdgcn_sched_barrier(0);
                int o31 = abase_i + 2108; asm volatile("" : "+v"(o31) : "v"(Tr[28]));
                const f32x4 r31_0 = *(const LAS f32x4*)(Aab + o31 + 0); const f32x4 r31_1 = *(const LAS f32x4*)(Aab + o31 + 4); const f32x4 r31_2 = *(const LAS f32x4*)(Aab + o31 + 8); const f32x4 r31_3 = *(const LAS f32x4*)(Aab + o31 + 12); const f32x4 r31_4 = *(const LAS f32x4*)(Aab + o31 + 16); const f32x4 r31_5 = *(const LAS f32x4*)(Aab + o31 + 20); const f32x4 r31_6 = *(const LAS f32x4*)(Aab + o31 + 24); const f32x4 r31_7 = *(const LAS f32x4*)(Aab + o31 + 28);
                __builtin_amdgcn_sched_barrier(0);
                { const f32x2_t pa = (f32x2_t){r29_0[0], r29_0[1]} * TP[0] + (f32x2_t){r29_1[0], r29_1[1]} * TP[2] + (f32x2_t){r29_2[0], r29_2[1]} * TP[4] + (f32x2_t){r29_3[0], r29_3[1]} * TP[6] + (f32x2_t){r29_4[0], r29_4[1]} * TP[8] + (f32x2_t){r29_5[0], r29_5[1]} * TP[10] + (f32x2_t){r29_6[0], r29_6[1]} * TP[12] + (f32x2_t){r29_7[0], r29_7[1]} * TP[14]; const f32x2_t pb = (f32x2_t){r29_0[2], r29_0[3]} * TP[1] + (f32x2_t){r29_1[2], r29_1[3]} * TP[3] + (f32x2_t){r29_2[2], r29_2[3]} * TP[5] + (f32x2_t){r29_3[2], r29_3[3]} * TP[7] + (f32x2_t){r29_4[2], r29_4[3]} * TP[9] + (f32x2_t){r29_5[2], r29_5[3]} * TP[11] + (f32x2_t){r29_6[2], r29_6[3]} * TP[13]; const f32x2_t ps = pa + pb;
                  Tr[29] = (ps[0] + ps[1]) + (1.0f - fminf(fabsf(cf - 29.0f), 1.0f)); TP[14][1] = Tr[29]; }
                __builtin_amdgcn_sched_barrier(0);
                __builtin_amdgcn_sched_barrier(0);
                { const f32x2_t pa = (f32x2_t){r30_0[0], r30_0[1]} * TP[0] + (f32x2_t){r30_1[0], r30_1[1]} * TP[2] + (f32x2_t){r30_2[0], r30_2[1]} * TP[4] + (f32x2_t){r30_3[0], r30_3[1]} * TP[6] + (f32x2_t){r30_4[0], r30_4[1]} * TP[8] + (f32x2_t){r30_5[0], r30_5[1]} * TP[10] + (f32x2_t){r30_6[0], r30_6[1]} * TP[12] + (f32x2_t){r30_7[0], r30_7[1]} * TP[14]; const f32x2_t pb = (f32x2_t){r30_0[2], r30_0[3]} * TP[1] + (f32x2_t){r30_1[2], r30_1[3]} * TP[3] + (f32x2_t){r30_2[2], r30_2[3]} * TP[5] + (f32x2_t){r30_3[2], r30_3[3]} * TP[7] + (f32x2_t){r30_4[2], r30_4[3]} * TP[9] + (f32x2_t){r30_5[2], r30_5[3]} * TP[11] + (f32x2_t){r30_6[2], r30_6[3]} * TP[13]; const f32x2_t ps = pa + pb;
                  Tr[30] = (ps[0] + ps[1]) + (1.0f - fminf(fabsf(cf - 30.0f), 1.0f)); TP[15][0] = Tr[30]; }
                __builtin_amdgcn_sched_barrier(0);
                __builtin_amdgcn_sched_barrier(0);
                { const f32x2_t pa = (f32x2_t){r31_0[0], r31_0[1]} * TP[0] + (f32x2_t){r31_1[0], r31_1[1]} * TP[2] + (f32x2_t){r31_2[0], r31_2[1]} * TP[4] + (f32x2_t){r31_3[0], r31_3[1]} * TP[6] + (f32x2_t){r31_4[0], r31_4[1]} * TP[8] + (f32x2_t){r31_5[0], r31_5[1]} * TP[10] + (f32x2_t){r31_6[0], r31_6[1]} * TP[12] + (f32x2_t){r31_7[0], r31_7[1]} * TP[14]; const f32x2_t pb = (f32x2_t){r31_0[2], r31_0[3]} * TP[1] + (f32x2_t){r31_1[2], r31_1[3]} * TP[3] + (f32x2_t){r31_2[2], r31_2[3]} * TP[5] + (f32x2_t){r31_3[2], r31_3[3]} * TP[7] + (f32x2_t){r31_4[2], r31_4[3]} * TP[9] + (f32x2_t){r31_5[2], r31_5[3]} * TP[11] + (f32x2_t){r31_6[2], r31_6[3]} * TP[13] + (f32x2_t){r31_7[2], r31_7[3]} * TP[15]; const f32x2_t ps = pa + pb;
                  Tr[31] = (ps[0] + ps[1]) + (1.0f - fminf(fabsf(cf - 31.0f), 1.0f)); TP[15][1] = Tr[31]; }
                __builtin_amdgcn_sched_barrier(0);
            }
#pragma unroll
            for (int t = 0; t < 32; ++t) {
                Tm[(32 * hb + t) * LDP + 32 * hb + c] = (bf16_t)f2bf(Tr[t]);
            }
            if (hb == 0) {
#pragma unroll
                for (int q = 0; q < 4; ++q) { u32x4 w; w.x = pk2(Tr[8 * q], Tr[8 * q + 1]); w.y = pk2(Tr[8 * q + 2], Tr[8 * q + 3]); w.z = pk2(Tr[8 * q + 4], Tr[8 * q + 5]); w.w = pk2(Tr[8 * q + 6], Tr[8 * q + 7]);
                    *(LAS u32x4*)(TT + c * LDQ + 8 * q) = w; }
            }
            LDS_WAIT();
            f32x4 W[2][2];
#pragma unroll
            for (int mi = 0; mi < 2; ++mi)
#pragma unroll
                for (int ni = 0; ni < 2; ++ni) {
                    W[mi][ni] = (f32x4){0.f, 0.f, 0.f, 0.f};
                    MMA16(*(const LAS bf16x8*)(AbBA + (16 * mi + fr) * LDQ + fq * 8), *(const LAS bf16x8*)(TT + (16 * ni + fr) * LDQ + fq * 8), W[mi][ni]);
                    st4lds(WsT + (16 * ni + fr) * LDQ + 16 * mi + 4 * fq, W[mi][ni]);
                }
            LDS_WAIT();
#pragma unroll
            for (int mi = 0; mi < 2; ++mi)
#pragma unroll
                for (int ni = 0; ni < 2; ++ni) {
                    f32x4 r4 = (f32x4){0.f, 0.f, 0.f, 0.f};
                    MMA16(*(const LAS bf16x8*)(WsT + (16 * mi + fr) * LDQ + fq * 8), *(const LAS bf16x8*)(Tm + (32 + 16 * ni + fr) * LDP + 32 + fq * 8), r4);
                    st4lds(Tm + (32 + 16 * ni + fr) * LDP + 16 * mi + 4 * fq, r4);
                }
        }
        SBAR();
        {
            const int i0 = 16 * nio + fr;
            const bf16x8 s0 = ldfrag(Sb, i0, 0, fq), s1 = ldfrag(Sb, i0, 1, fq), v0 = ldfragT(VT, i0, 0, fq), v1 = ldfragT(VT, i0, 1, fq);
            bf16x8 fa[2][2], fk[2][2], fh[2][2]; f32x4 eg[2];
#pragma unroll
            for (int mm = 0; mm < 2; ++mm) {
                const int m0 = 16 * (mo0 + mm) + fr;
                fa[mm][0] = ldfrag(At, m0, 0, fq); fa[mm][1] = ldfrag(At, m0, 1, fq);
                fk[mm][0] = ldfrag(Aak, m0, 0, fq); fk[mm][1] = ldfrag(Aak, m0, 1, fq);
                fh[mm][0] = ldfragT(KhT, m0, 0, fq); fh[mm][1] = ldfragT(KhT, m0, 1, fq);
                eg[mm] = *(const LAS f32x4*)(EGL + 16 * (mo0 + mm) + 4 * fq);
            }
            __builtin_amdgcn_sched_barrier(0);
            f32x4 Pacc[2];
#pragma unroll
            for (int mm = 0; mm < 2; ++mm) {
                Pacc[mm] = (f32x4){0.f, 0.f, 0.f, 0.f};
                MMA16(fa[mm][0], s0, Pacc[mm]); MMA16(fa[mm][1], s1, Pacc[mm]);
                MMA16(fk[mm][0], v0, Pacc[mm]); MMA16(fk[mm][1], v1, Pacc[mm]);
                Sacc[mm] = Sacc[mm] * eg[mm];
                MMA16(fh[mm][0], v0, Sacc[mm]); MMA16(fh[mm][1], v1, Sacc[mm]);
            }
            __builtin_amdgcn_sched_barrier(0);
#pragma unroll
            for (int mm = 0; mm < 2; ++mm) st4lds(PT + i0 * LDP + 16 * (mo0 + mm) + 4 * fq, Pacc[mm]);
        }
        SBAR();
        { const int nc_ = chunk + 1 < nch ? chunk + 1 : chunk; SCAN_ISSUE(nc_); }
        {
            const int i0 = 16 * nio + fr;
            const bf16x8 p0 = ldfrag(PT, i0, 0, fq), p1 = ldfrag(PT, i0, 1, fq);
            bf16x8 ft[2][2];
#pragma unroll
            for (int mm = 0; mm < 2; ++mm) { ft[mm][0] = ldfrag(Tm, 16 * (mo0 + mm) + fr, 0, fq); ft[mm][1] = ldfrag(Tm, 16 * (mo0 + mm) + fr, 1, fq); }
            __builtin_amdgcn_sched_barrier(0);
            f32x4 Uacc[2];
#pragma unroll
            for (int mm = 0; mm < 2; ++mm) {
                Uacc[mm] = (f32x4){0.f, 0.f, 0.f, 0.f};
                MMA16(ft[mm][0], p0, Uacc[mm]); MMA16(ft[mm][1], p1, Uacc[mm]);
            }
            __builtin_amdgcn_sched_barrier(0);
#pragma unroll
            for (int mm = 0; mm < 2; ++mm) st4lds(UT + i0 * LDP + 16 * (mo0 + mm) + 4 * fq, Uacc[mm]);
        }
        SBAR();
        {
            const int i0 = 16 * nio + fr;
            const bf16x8 u0 = ldfrag(UT, i0, 0, fq), u1 = ldfrag(UT, i0, 1, fq);
            const int tl = 16 * nio + fr;
            const bf16x8 rt0 = ldfrag(Rt, tl, 0, fq), rt1 = ldfrag(Rt, tl, 1, fq), ak0 = ldfrag(Ark, tl, 0, fq), ak1 = ldfrag(Ark, tl, 1, fq), ab0 = ldfrag(Arb, tl, 0, fq), ab1 = ldfrag(Arb, tl, 1, fq);
            bf16x8 fb[2][2], fs[2][2], fv[2][2], fu[2][2];
#pragma unroll
            for (int mm = 0; mm < 2; ++mm) {
                const int m0 = 16 * (mo0 + mm) + fr;
                fb[mm][0] = ldfragT(BhT, m0, 0, fq); fb[mm][1] = ldfragT(BhT, m0, 1, fq);
                fs[mm][0] = ldfrag(Sb, m0, 0, fq); fs[mm][1] = ldfrag(Sb, m0, 1, fq);
                fv[mm][0] = ldfragT(VT, m0, 0, fq); fv[mm][1] = ldfragT(VT, m0, 1, fq);
                fu[mm][0] = ldfrag(UT, m0, 0, fq); fu[mm][1] = ldfrag(UT, m0, 1, fq);
            }
            __builtin_amdgcn_sched_barrier(0);
            f32x4 Yacc[2];
#pragma unroll
            for (int mm = 0; mm < 2; ++mm) {
                MMA16(fb[mm][0], u0, Sacc[mm]); MMA16(fb[mm][1], u1, Sacc[mm]);
                Yacc[mm] = (f32x4){0.f, 0.f, 0.f, 0.f};
                MMA16(fs[mm][0], rt0, Yacc[mm]); MMA16(fs[mm][1], rt1, Yacc[mm]);
                MMA16(fv[mm][0], ak0, Yacc[mm]); MMA16(fv[mm][1], ak1, Yacc[mm]);
                MMA16(fu[mm][0], ab0, Yacc[mm]); MMA16(fu[mm][1], ab1, Yacc[mm]);
            }
            __builtin_amdgcn_sched_barrier(0);
            SBAR();
            const int ypos = chunk * 64 + tl, yt = dir ? T - 1 - ypos : ypos;
            const size_t yoff = (size_t)(row_base + yt) * DM + h * 64;
#pragma unroll
            for (int mm = 0; mm < 2; ++mm) {
                st4lds(Sb + i0 * LDP + 16 * (mo0 + mm) + 4 * fq, Sacc[mm]);
                const int ic = 16 * (mo0 + mm) + 4 * fq;
                if (mode == 2) {
                    const int tloc = dir ? yt : yt - 2048;
                    st4bf((bf16_t*)(a.ws + WS_ZB) + ((size_t)((b * 16 + h) * 2 + dir) * 2048 + tloc) * 64 + ic, Yacc[mm]);
                } else if (ysc != 0.f) {
                    st4bf((dir == 0 ? (bf16_t*)a.out + YF_OFF : (bf16_t*)(a.ws + WS_H)) + yoff + ic, Yacc[mm]);
                }
            }
        }
    }
    if (!lat) {
        const int i = 16 * nio + fr;
#pragma unroll
        for (int mm = 0; mm < 2; ++mm)
            *(f32x4*)(a.out + (size_t)NTOK * DM + ((((size_t)b * 2 + dir) * 16 + h) * 64 + i) * 64 + 16 * (mo0 + mm) + 4 * fq) = Sacc[mm];
    } else if (mode == 0 && cend < T / 64) {
        const int i = 16 * nio + fr;
#pragma unroll
        for (int mm = 0; mm < 2; ++mm)
            st4bf((bf16_t*)(a.ws + WS_SAB) + ((size_t)((b * 16 + h) * 2 + dir) * 64 + i) * 64 + 16 * (mo0 + mm) + 4 * fq, Sacc[mm]);
    }
    __syncthreads();
}
__device__ __forceinline__ void phase_scan(const Args& a, LAS unsigned char* lds) {
    const int nb = gridDim.x, bx = blockIdx.x;
    for (int it = 0;; ++it) {
        int lat, c, cbeg = 0, cend, mode = 0;
        if (nb >= 256) {
            if (bx < 192) { if (it) break; lat = 1; c = bx & 63; const int role = bx >> 6; cbeg = role ? 32 : 0; cend = role ? 64 : 32; mode = role; }
            else { c = (bx - 192) + it * (nb - 192); if (c >= 512) break; lat = 0; cend = 4; }
        } else if (nb >= 128) {
            if (bx < 64) { if (it) break; lat = 1; c = bx; cend = 64; }
            else { c = (bx - 64) + it * (nb - 64); if (c >= 512) break; lat = 0; cend = 4; }
        } else {
            const int task = bx + it * nb; if (task >= 64 + 512) break;
            lat = task < 64; c = lat ? task : task - 64; cend = lat ? 64 : 4;
        }
        scan_chain(a, lds, lat, c >> 5, (c >> 1) & 15, c & 1, 1.0f, cbeg, cend, mode);
    }
}
__device__ __forceinline__ void phase_fixup(const Args& a) {
    const int tid = threadIdx.x, lane = tid & 63, wv = tid >> 6, gw = blockIdx.x * 8 + wv, ngw = gridDim.x * 8, fr = lane & 15, fq = lane >> 4;
    const bf16_t* SAB = (const bf16_t*)(a.ws + WS_SAB); const bf16_t* ZB = (const bf16_t*)(a.ws + WS_ZB);
    for (int wt = gw; wt < 64 * 32; wt += ngw) {
        const int chain = wt >> 5, blk = wt & 31, dir = chain & 1, h = (chain >> 1) & 15, b = chain >> 5;
        const bf16_t* ap[4]; const bf16_t* bp[4]; f32x4 acc[4][4];
#pragma unroll
        for (int mi = 0; mi < 4; ++mi)
#pragma unroll
            for (int ni = 0; ni < 4; ++ni) acc[mi][ni] = (f32x4){0.f, 0.f, 0.f, 0.f};
#pragma unroll
        for (int mi = 0; mi < 4; ++mi) ap[mi] = SAB + ((size_t)chain * 64 + 16 * mi + fr) * 64;
#pragma unroll
        for (int ni = 0; ni < 4; ++ni) bp[ni] = ZB + ((size_t)chain * 2048 + blk * 64 + 16 * ni + fr) * 64;
        wave_mma<4, 4, 2, 2>(ap, bp, acc, fq);
#pragma unroll
        for (int ni = 0; ni < 4; ++ni) {
            const int tloc = blk * 64 + 16 * ni + fr, t = dir ? tloc : 2048 + tloc;
            const size_t yoff = (size_t)(NTOK_C + b * 4096 + t) * DM + h * 64;
#pragma unroll
            for (int mi = 0; mi < 4; ++mi) {
                const int ic = 16 * mi + 4 * fq;
                bf16_t* p = (dir == 0 ? (bf16_t*)a.out + YF_OFF : (bf16_t*)(a.ws + WS_H)) + yoff + ic; const u32x2 w = *(const u32x2*)p;
                f32x4 o; o[0] = bflo(w.x) + acc[mi][ni][0]; o[1] = bfhi(w.x) + acc[mi][ni][1]; o[2] = bflo(w.y) + acc[mi][ni][2]; o[3] = bfhi(w.y) + acc[mi][ni][3];
                st4bf(p, o);
            }
        }
    }
}

__device__ __forceinline__ void phase_gn(const Args& a) {
    const int tid = threadIdx.x;
    bf16_t* U = (bf16_t*)(a.ws + WS_U);
    const bf16_t* YB = (const bf16_t*)(a.ws + WS_H);
    const bf16_t* YF = (const bf16_t*)a.out + YF_OFF;
    const bf16_t* BON = (const bf16_t*)a.out + BON_OFF;
    for (int idx = blockIdx.x * 512 + tid; idx < NTOK * 128; idx += gridDim.x * 512) {
        const int row = idx >> 7, c0 = (idx & 127) * 8;
        const u32x4 yfw = __builtin_nontemporal_load((const u32x4*)(YF + (size_t)row * DM + c0)), ybw = __builtin_nontemporal_load((const u32x4*)(YB + (size_t)row * DM + c0));
        const u32x4 bw = __builtin_nontemporal_load((const u32x4*)(BON + (size_t)row * DM + c0)), gw = __builtin_nontemporal_load((const u32x4*)(U + (size_t)row * LDU + C_GR + c0));
        const f32x4 lg0 = *(const f32x4*)(a.in[17] + c0), lg1 = *(const f32x4*)(a.in[17] + c0 + 4);
        const f32x4 lb0 = *(const f32x4*)(a.in[18] + c0), lb1 = *(const f32x4*)(a.in[18] + c0 + 4);
        float y[8], sm = 0.f;
#pragma unroll
        for (int e = 0; e < 8; ++e) { y[e] = bfel(yfw, e) + bfel(ybw, e); sm += y[e]; }
        sm += __shfl_xor(sm, 1); sm += __shfl_xor(sm, 2); sm += __shfl_xor(sm, 4);
        const float mean = sm * (1.0f / 64.0f);
        float vs = 0.f;
#pragma unroll
        for (int e = 0; e < 8; ++e) { y[e] -= mean; vs += y[e] * y[e]; }
        vs += __shfl_xor(vs, 1); vs += __shfl_xor(vs, 2); vs += __shfl_xor(vs, 4);
        const float rstd = rsqrtf(vs * (1.0f / 64.0f) + GN_EPS);
        float o[8];
#pragma unroll
        for (int e = 0; e < 8; ++e) { const float yn = y[e] * rstd * (e < 4 ? lg0[e] : lg1[e - 4]) + (e < 4 ? lb0[e] : lb1[e - 4]); o[e] = (yn + bfel(bw, e)) * bfel(gw, e); }
        *(u32x4*)(U + (size_t)row * LDU + C_GR + c0) = pack8(o);
    }
}

__device__ __forceinline__ void phase_final(const Args& a) {
    const int tid = threadIdx.x, lane = tid & 63, wv = tid >> 6, gw = blockIdx.x * 8 + wv, ngw = gridDim.x * 8;
    const float* fg = a.in[22];
    for (int row = gw; row < NTOK; row += ngw) {
        float* xr = a.out + (size_t)row * DM;
        f32x4 v[4]; float ss = 0.f;
#pragma unroll
        for (int j = 0; j < 4; ++j) { v[j] = *(const f32x4*)(xr + lane * 4 + 256 * j); ss += (v[j][0] * v[j][0] + v[j][1] * v[j][1]) + (v[j][2] * v[j][2] + v[j][3] * v[j][3]); }
        const float rstd = rsqrtf(wave_sum(ss) * (1.0f / DM) + RMS_EPS);
#pragma unroll
        for (int j = 0; j < 4; ++j) { const f32x4 g4 = *(const f32x4*)(fg + lane * 4 + 256 * j); *(f32x4*)(xr + lane * 4 + 256 * j) = v[j] * rstd * g4; }
    }
}

#define XB_TMO      128
#define XB_XCNT(j)  (256  + 64 * (j))
#define XB_XSUB(j)  (1280 + 64 * (j))
#define XB_XGEN(j)  (2304 + 64 * (j))
#define XB_TOP      3328
#define XB_TOPGEN   3392
#define XCD_BAR_WORDS 3456
#define XB_SPIN_CAP (1u << 18)
__device__ __forceinline__ unsigned xb_ld(unsigned* p)              { return __hip_atomic_load(p, __ATOMIC_RELAXED, __HIP_MEMORY_SCOPE_AGENT); }
__device__ __forceinline__ unsigned xb_add(unsigned* p, unsigned v) { return __hip_atomic_fetch_add(p, v, __ATOMIC_RELAXED, __HIP_MEMORY_SCOPE_AGENT); }
__device__ __forceinline__ unsigned xb_xcc_id() { return (unsigned)__builtin_amdgcn_s_getreg((3 << 11) | 20) & 0xFu; }
#define XB_SPIN(cond, bar) do { unsigned _sp = 0; while (cond) { __builtin_amdgcn_s_sleep(1); \
    if ((++_sp & 255u) == 0u) { if (xb_ld(&(bar)[XB_TMO])) break; if (_sp > XB_SPIN_CAP) { atomicAdd(&(bar)[XB_TMO], 1u); break; } } } } while (0)
struct XcdBarrier { unsigned* bar; unsigned x; volatile LAS unsigned* st; };
__device__ __forceinline__ XcdBarrier xcd_barrier_post(unsigned* bar, volatile LAS unsigned* st) {
    XcdBarrier b; b.bar = bar; b.x = xb_xcc_id(); b.st = st;
    if (threadIdx.x == 0) (void)xb_add(&bar[XB_XCNT(b.x)], 1u);
    return b;
}
__device__ __forceinline__ void xcd_barrier_complete(unsigned* bar, unsigned x, unsigned& nloc, unsigned& nx) {
    const unsigned G = gridDim.x * gridDim.y * gridDim.z;
    unsigned sum, cnt, mine, sp = 0u;
    for (;;) {
        sum = 0u; cnt = 0u; mine = 0u;
#pragma unroll
        for (unsigned j = 0; j < 16; ++j) { const unsigned c = xb_ld(&bar[XB_XCNT(j)]); sum += c; cnt += (c > 0u) ? 1u : 0u; mine = (j == x) ? c : mine; }
        if (sum == G) break;
        __builtin_amdgcn_s_sleep(1);
        if ((++sp & 255u) == 0u) { if (xb_ld(&bar[XB_TMO])) break; if (sp > XB_SPIN_CAP) { atomicAdd(&bar[XB_TMO], 1u); break; } }
    }
    nloc = mine > 0u ? mine : 1u; nx = cnt > 0u ? cnt : 1u;
}
__device__ __forceinline__ void xcd_barrier(const XcdBarrier& b) {
    asm volatile("s_waitcnt vmcnt(0)" ::: "memory");
    __syncthreads();
    if (threadIdx.x == 0) {
        unsigned* bar = b.bar;
        __builtin_amdgcn_s_waitcnt(0);
        unsigned nloc = b.st[0], nx = b.st[1];
        if (nloc == 0u) { xcd_barrier_complete(bar, b.x, nloc, nx); b.st[0] = nloc; b.st[1] = nx; }
        const unsigned old = xb_add(&bar[XB_XSUB(b.x)], 1u);
        const unsigned gen = old / nloc;
        if (old + 1u == (gen + 1u) * nloc) {
            __builtin_amdgcn_fence(__ATOMIC_RELEASE, "agent");
            asm volatile("s_waitcnt vmcnt(0)" ::: "memory");
            const unsigned og = xb_add(&bar[XB_TOP], 1u);
            const unsigned tg = og / nx;
            if (og + 1u == (tg + 1u) * nx) xb_add(&bar[XB_TOPGEN], 1u);
            else XB_SPIN(xb_ld(&bar[XB_TOPGEN]) == tg, bar);
            __builtin_amdgcn_fence(__ATOMIC_ACQUIRE, "agent");
            xb_add(&bar[XB_XGEN(b.x)], 1u);
            asm volatile("s_waitcnt vmcnt(0)" ::: "memory");
        } else {
            XB_SPIN(xb_ld(&bar[XB_XGEN(b.x)]) == gen, bar);
            __builtin_amdgcn_fence(__ATOMIC_ACQUIRE, "agent");
            asm volatile("s_waitcnt vmcnt(0)" ::: "memory");
        }
    }
    __syncthreads();
}

__global__ void __launch_bounds__(512) mega(Args a) {
    extern __shared__ __attribute__((aligned(16))) unsigned char lds_raw[];
    LAS unsigned char* lds = (LAS unsigned char*)lds_raw;
    unsigned char* ws = a.ws;
    bf16_t* U = (bf16_t*)(ws + WS_U);
    if (threadIdx.x < 4) ((LAS unsigned*)(lds + LDS_XB))[threadIdx.x] = 0u;
    __syncthreads();
    XcdBarrier xbar; xbar.bar = (unsigned*)(ws + WS_BAR); xbar.x = 0; xbar.st = (volatile LAS unsigned*)(lds + LDS_XB);
    if (a.ph_hi - a.ph_lo > 1) xbar = xcd_barrier_post((unsigned*)(ws + WS_BAR), (volatile LAS unsigned*)(lds + LDS_XB));
#define PH_BEGIN(k) if (a.ph_lo <= (k) && (k) < a.ph_hi) { if (a.ph_lo < (k)) { if (a.ph_lo == 0x7fff0000) cg::this_grid().sync(); else xcd_barrier(xbar); }
#define PH_END }
#ifndef REPMASK
#define REPMASK 0
#endif
#define NREP(k) (((REPMASK >> (k)) & 1) ? 2 : 1)
    PH_BEGIN(0) for (int r_ = 0; r_ < NREP(0); ++r_) { __syncthreads(); phase0(a, lds); } PH_END
    PH_BEGIN(1) for (int r_ = 0; r_ < NREP(1); ++r_) { __syncthreads(); phase0_conv(a, lds); __syncthreads(); phase1(a, lds); } PH_END
    PH_BEGIN(2)
        pg8::StaticOrder S; S.init(NTOK, LDU, gridDim.x, blockIdx.x);
        pg8::Gemm g{(const bf16_t*)(ws + WS_H), (const bf16_t*)(ws + WS_WINT), NTOK, LDU, 1024, 1024, 1024};
        Epi1 E{U};
#ifndef REP_PH2
#define REP_PH2 1
#endif
#pragma unroll 1
        for (int rep_ = 0; rep_ < REP_PH2; ++rep_) { if (rep_) __syncthreads(); pg8::gemm_phase(lds, g, S, E); }
        __syncthreads();
        if (gridDim.x == 256) { if (blockIdx.x >= 112) conv_rest(a, lds, blockIdx.x - 112, 144); } else conv_rest(a, lds, blockIdx.x, gridDim.x);
    PH_END
    PH_BEGIN(3) for (int r_ = 0; r_ < NREP(3); ++r_) fourier_l1(a, lds); PH_END
    PH_BEGIN(4) for (int r_ = 0; r_ < NREP(4); ++r_) fourier_l2(a, lds); phase_premix(a); PH_END
    PH_BEGIN(5) for (int r_ = 0; r_ < NREP(5); ++r_) fourier_l3(a, lds); __syncthreads(); PH_END
    if (a.ph_lo <= 6 && 6 < a.ph_hi) { if (a.ph_lo == 6) {} else if (!(a.ph_lo <= 5)) xcd_barrier(xbar);
#ifndef SCAN_REPS
#define SCAN_REPS 1
#endif
        for (int rep = 0; rep < SCAN_REPS; ++rep) {
            if (rep) {
                cg::this_grid().sync();
                { f32x4* yo = (f32x4*)a.out; for (int i = blockIdx.x * 512 + threadIdx.x; i < NTOK * DM / 4; i += gridDim.x * 512) yo[i] = (f32x4){0.f, 0.f, 0.f, 0.f}; }
                cg::this_grid().sync();
            }
            phase_scan(a, lds);
        }
    PH_END
    PH_BEGIN(7) if (gridDim.x >= 256 && a.ph_hi - a.ph_lo > 1) { phase_fixup(a); xcd_barrier(xbar); } phase_gn(a); PH_END
    PH_BEGIN(8)
        pg8::StaticOrder S; S.init(NTOK, 1024, gridDim.x, blockIdx.x);
#pragma unroll 1
        for (int r_ = 0; r_ < NREP(8); ++r_) {
        __syncthreads();
        {
            pg8::Gemm g{U + C_XF, (const bf16_t*)(ws + WS_WPF), NTOK, 1024, 512, LDU, 512};
            Epi2<0> E{U};
            pg8::gemm_phase(lds, g, S, E);
        }
        {
            pg8::Gemm g{U + C_GR, (const bf16_t*)(ws + WS_WPR), NTOK, 1024, 1024, LDU, 1024};
            Epi2<1> E{U};
            pg8::gemm_phase(lds, g, S, E);
        }
        }
    PH_END
    PH_BEGIN(9)
        pg8::StaticOrder S; S.init(NTOK, 1024, gridDim.x, blockIdx.x);
        pg8::Gemm g{U + C_MERGED, (const bf16_t*)(ws + WS_WOUT), NTOK, 1024, 1024, LDU, 1024};
        Epi3 E{a.in[0], a.in[1], (const float*)(ws + WS_MODF), a.out};
#pragma unroll 1
        for (int r_ = 0; r_ < NREP(9); ++r_) { __syncthreads(); pg8::gemm_phase(lds, g, S, E); }
#ifdef SYNC_EXTRA
        for (int r_ = 0; r_ < SYNC_EXTRA; ++r_) cg::this_grid().sync();
#endif
    PH_END
    PH_BEGIN(10) phase_final(a); PH_END
}

extern "C" void kernel_launch(void* const* d_in, const int* in_sizes, int n_in, void* d_out, int out_size, void* d_ws, size_t ws_size, hipStream_t stream) {
    static int grid = 0;
    if (grid == 0) {
        if (n_in != 23 || ws_size < WS_END) { fprintf(stderr, "kernel_launch: unexpected n_in %d / ws_size %zu (need %zu)\n", n_in, ws_size, (size_t)WS_END); grid = -1; return; }
        int dev = 0, cus = 0, per_cu = 0;
        hipGetDevice(&dev);
        hipDeviceGetAttribute(&cus, hipDeviceAttributeMultiprocessorCount, dev);
        if (hipFuncSetAttribute((const void*)mega, hipFuncAttributeMaxDynamicSharedMemorySize, LDS_BYTES) != hipSuccess) { fprintf(stderr, "kernel_launch: hipFuncSetAttribute failed\n"); grid = -1; return; }
        if (hipOccupancyMaxActiveBlocksPerMultiprocessor(&per_cu, (const void*)mega, 512, LDS_BYTES) != hipSuccess || per_cu < 1) { fprintf(stderr, "kernel_launch: occupancy query says %d\n", per_cu); per_cu = 1; }
        (void)hipGetLastError();
        grid = cus;
    }
    if (grid < 0) return;
    Args a{};
    for (int i = 0; i < 23; ++i) a.in[i] = (const float*)d_in[i];
    a.out = (float*)d_out; a.ws = (unsigned char*)d_ws;
    (void)hipMemsetAsync((unsigned char*)d_ws + WS_BAR, 0, 16384, stream);
#if MULTI_LAUNCH
    for (int ph = 0; ph < NPH; ++ph) {
        a.ph_lo = ph; a.ph_hi = ph + 1;
        hipLaunchKernelGGL(mega, dim3(grid), dim3(512), LDS_BYTES, stream, a);
    }
#else
    a.ph_lo = 0; a.ph_hi = NPH;
    void* args[] = {&a};
    hipError_t e = hipLaunchCooperativeKernel((void*)mega, dim3(grid), dim3(512), args, LDS_BYTES, stream);
    if (e != hipSuccess) fprintf(stderr, "cooperative launch failed: %s (grid %d)\n", hipGetErrorString(e), grid);
#endif
}
```
